# Optimizing an MI355X kernel written in HIP

```python
import math
import jax, jax.numpy as jnp
from jax import lax
import numpy as np

D_MODEL = 1024
BATCH = 8
SEQ = 8192
DEPTH = 4

HEAD_DIM = 64
GROUP_W = D_MODEL // 4
HEADS_PER_MIXER = GROUP_W // HEAD_DIM
MIX_W = 4 * GROUP_W
NORM_EPS = 1e-6
GDN_CONV = 4
GDN_CHUNK = 64
SGU_CHUNK = 128
SGU_LN_EPS = 1e-5
SC_CONV = 3
RW_DECAY_LORA = 64
RW_AAA_LORA = 64
RW_GATE_LORA = 128
RW_GN_EPS = 64e-5
RW_IN_W = 3 * GROUP_W + RW_DECAY_LORA + RW_AAA_LORA + RW_GATE_LORA
IN_SIZES = (3 * GROUP_W, GROUP_W, HEADS_PER_MIXER, HEADS_PER_MIXER, GROUP_W, GROUP_W,
            GROUP_W, GROUP_W, GROUP_W, RW_IN_W)
IN_W = sum(IN_SIZES)
N_GROUPS = 8
EXPERTS_PER_GROUP = 8
N_EXPERTS = N_GROUPS * EXPERTS_PER_GROUP
TOP_K = 2
D_EXPERT = 256
MOE_BLOCK = 128

kernel_name = "hybrid_headgroup_gdn_sgu_conv_rwkv7_hmoe"

F32 = jnp.float32


def _split(p, sizes):
    idx, s = [], 0
    for n in sizes[:-1]:
        s += n
        idx.append(s)
    return jnp.split(p, idx, axis=-1)


def rmsnorm(x, g):
    xf = x.astype(F32)
    y = xf * lax.rsqrt(jnp.mean(xf * xf, -1, keepdims=True) + NORM_EPS)
    return (y * g.astype(F32)).astype(x.dtype)


def modulate(h, shift, scale):
    return h * (1.0 + scale[:, None, :]) + shift[:, None, :]


def causal_conv(x, w):
    k = w.shape[0]
    return lax.conv_general_dilated(x, w[:, None, :].astype(x.dtype), window_strides=(1,),
                                    padding=[(k - 1, 0)], dimension_numbers=('NWC', 'WIO', 'NWC'),
                                    feature_group_count=x.shape[-1])


def token_shift(x):
    return jnp.pad(x[:, :-1], ((0, 0), (1, 0), (0, 0)))


def l2norm(x):
    return x * lax.rsqrt(jnp.sum(x * x, -1, keepdims=True) + 1e-6)


def gated_delta_chunked(q, k, v, g, beta):
    bn, s, h, dh = q.shape
    c = GDN_CHUNK
    n = s // c

    def chunks(t):
        return jnp.moveaxis(t.reshape(bn, n, c, h, -1), 3, 1)

    q = chunks(q) * (dh ** -0.5)
    k = chunks(k)
    v = chunks(v)
    gc = jnp.cumsum(jnp.moveaxis(g.reshape(bn, n, c, h), 3, 1), axis=-1)
    beta = jnp.moveaxis(beta.reshape(bn, n, c, h), 3, 1)
    pos = jnp.arange(c)
    causal = pos[:, None] >= pos[None, :]
    strict = pos[:, None] > pos[None, :]
    decay = jnp.exp(jnp.where(causal, gc[..., :, None] - gc[..., None, :], -jnp.inf))
    k_beta = k * beta[..., None]
    a_mat = jnp.where(strict, jnp.einsum('bhnid,bhnjd->bhnij', k_beta, k) * decay, 0.0)
    rhs = jnp.concatenate([v * beta[..., None], k_beta * jnp.exp(gc)[..., None]], -1)
    sol = lax.linalg.triangular_solve(a_mat, rhs, left_side=True, lower=True, unit_diagonal=True)
    u, w = sol[..., :dh], sol[..., dh:]
    attn = jnp.einsum('bhnid,bhnjd->bhnij', q, k) * decay
    q_dec = q * jnp.exp(gc)[..., None]
    k_tail = k * jnp.exp(gc[..., -1:] - gc)[..., None]
    chunk_dec = jnp.exp(gc[..., -1])

    def step(state, inp):
        u_i, w_i, a_i, qd_i, kt_i, cd_i = inp
        v_new = u_i - jnp.einsum('bhck,bhkv->bhcv', w_i, state)
        o = jnp.einsum('bhck,bhkv->bhcv', qd_i, state) + jnp.einsum('bhij,bhjv->bhiv', a_i, v_new)
        state = state * cd_i[..., None, None] + jnp.einsum('bhck,bhcv->bhkv', kt_i, v_new)
        return state, o

    xs = tuple(jnp.moveaxis(t, 2, 0) for t in (u, w, attn, q_dec, k_tail, chunk_dec))
    _, o = lax.scan(step, jnp.zeros((bn, h, dh, dh), F32), xs)
    return jnp.transpose(o, (1, 0, 3, 2, 4)).reshape(bn, s, h, dh)


def gdn_mixer(qkv, z, a, b, conv_w, a_log, dt_bias, norm_g):
    bn, s, _ = qkv.shape
    h, n = HEADS_PER_MIXER, HEAD_DIM
    qkv = jax.nn.silu(causal_conv(qkv, conv_w)).astype(F32)
    q, k, v = (t.reshape(bn, s, h, n) for t in jnp.split(qkv, 3, axis=-1))
    q = l2norm(q)
    k = l2norm(k)
    g = -jnp.exp(a_log.astype(F32)) * jax.nn.softplus(a.astype(F32) + dt_bias.astype(F32))
    beta = jax.nn.sigmoid(b.astype(F32))
    o = gated_delta_chunked(q, k, v, g, beta)
    o = o * lax.rsqrt(jnp.mean(o * o, -1, keepdims=True) + NORM_EPS) * norm_g.astype(F32)
    o = o.reshape(bn, s, GROUP_W) * jax.nn.silu(z.astype(F32))
    return o.astype(z.dtype)


def sgu_mixer(u, v, ln_g, ln_b, w_s, b_s):
    bn, s, _ = u.shape
    t, h = SGU_CHUNK, HEADS_PER_MIXER
    u = jax.nn.gelu(u)
    vf = jax.nn.gelu(v).astype(F32)
    mean = jnp.mean(vf, -1, keepdims=True)
    var = jnp.mean(jnp.square(vf - mean), -1, keepdims=True)
    v = ((vf - mean) * lax.rsqrt(var + SGU_LN_EPS) * ln_g.astype(F32) + ln_b.astype(F32)).astype(u.dtype)
    v = v.reshape(bn, s // t, t, h, HEAD_DIM)
    ws = jnp.where(jnp.tril(jnp.ones((t, t), bool)), w_s, 0.0).astype(u.dtype)
    mixed = jnp.einsum('hts,bnshc->bnthc', ws, v) + b_s.T[None, None, :, :, None]
    return (u.reshape(bn, s // t, t, h, HEAD_DIM) * mixed).reshape(bn, s, GROUP_W)


def short_conv_mixer(gate_b, gate_c, hx, conv_w):
    return gate_b * causal_conv(gate_c * hx, conv_w)


def rwkv7_scan(r, w, k, v, za, zb):
    bn, s, h, n = r.shape
    xs = tuple(jnp.moveaxis(t, 1, 0) for t in (r, w, k, v, za, zb))

    def step(state, inp):
        r_t, w_t, k_t, v_t, a_t, b_t = inp
        sa = jnp.einsum('bhvk,bhk->bhv', state, a_t)
        state = (state * w_t[:, :, None, :] + sa[..., None] * b_t[:, :, None, :]
                 + v_t[..., None] * k_t[:, :, None, :])
        return state, jnp.einsum('bhvk,bhk->bhv', state, r_t)

    _, y = lax.scan(step, jnp.zeros((bn, h, n, n), F32), xs)
    return jnp.moveaxis(y, 0, 1)


def rwkv7_mixer(p, mu, w0, w_up, a0, a_up, g_up, k_k, k_a, r_k, gn_g, gn_b):
    bn, s, _ = p.shape
    g_w, h, n = GROUP_W, HEADS_PER_MIXER, HEAD_DIM
    p = p + (token_shift(p) - p) * mu
    r, k, v, xw, xa, xg = _split(p, (g_w, g_w, g_w, RW_DECAY_LORA, RW_AAA_LORA, RW_GATE_LORA))
    w_log = -jax.nn.softplus(-(w0 + jnp.tanh(xw) @ w_up).astype(F32)) - 0.5
    decay = jnp.exp(-jnp.exp(w_log))
    a = jax.nn.sigmoid((a0 + xa @ a_up).astype(F32))
    gate = jax.nn.sigmoid(xg) @ g_up

    def heads(t):
        return t.astype(F32).reshape(bn, s, h, n)

    kf = k.astype(F32)
    kk = heads(kf * k_k.astype(F32))
    kk = kk * lax.rsqrt(jnp.sum(kk * kk, -1, keepdims=True) + 1e-12)
    k_mod = heads(kf * (1.0 + (a - 1.0) * k_a.astype(F32)))
    a_h = heads(a)
    r_h = heads(r)
    v_h = heads(v)
    y = rwkv7_scan(r_h, heads(decay), k_mod, v_h, -kk, kk * a_h)
    mean = jnp.mean(y, -1, keepdims=True)
    var = jnp.mean(jnp.square(y - mean), -1, keepdims=True)
    y = (y - mean) * lax.rsqrt(var + RW_GN_EPS)
    y = y * gn_g.astype(F32).reshape(h, n) + gn_b.astype(F32).reshape(h, n)
    y = y + jnp.sum(r_h * k_mod * r_k.astype(F32), -1, keepdims=True) * v_h
    return (y.reshape(bn, s, g_w) * gate.astype(F32)).astype(p.dtype)


def expert_dispatch(h, eidx, gates, w_gate, w_up, w_down):
    t, d = h.shape
    a_n = t * TOP_K
    flat_e = eidx.reshape(a_n)
    flat_tok = jnp.repeat(jnp.arange(t, dtype=jnp.int32), TOP_K)
    flat_g = gates.reshape(a_n)
    order = jnp.argsort(flat_e)
    se = flat_e[order]
    counts = jnp.bincount(flat_e, length=N_EXPERTS)
    start = jnp.cumsum(counts) - counts
    padded = (counts + MOE_BLOCK - 1) // MOE_BLOCK * MOE_BLOCK
    pad_end = jnp.cumsum(padded)
    pad_start = pad_end - padded
    dest = pad_start[se] + jnp.arange(a_n, dtype=jnp.int32) - start[se]
    p_rows = (a_n + MOE_BLOCK - 1) // MOE_BLOCK * MOE_BLOCK + N_EXPERTS * MOE_BLOCK
    n_blk = p_rows // MOE_BLOCK
    row_tok = jnp.full((p_rows,), t, jnp.int32).at[dest].set(flat_tok[order])
    row_g = jnp.zeros((p_rows,), h.dtype).at[dest].set(flat_g[order])
    blk_e = jnp.minimum(jnp.searchsorted(pad_end, jnp.arange(n_blk) * MOE_BLOCK, side='right'),
                        N_EXPERTS - 1)
    h_pad = jnp.concatenate([h, jnp.zeros((1, d), h.dtype)], 0)

    def run(args):
        tok, e, g = args
        xb = h_pad[tok]
        hid = jax.nn.silu(xb @ w_gate[e]) * (xb @ w_up[e])
        return (hid @ w_down[e]) * g[:, None]

    y = lax.map(run, (row_tok.reshape(n_blk, MOE_BLOCK), blk_e, row_g.reshape(n_blk, MOE_BLOCK)))
    out = jnp.zeros((t + 1, d), h.dtype).at[row_tok].add(y.reshape(p_rows, d))
    return out[:t]


def hier_moe(h, w_group, b_group, w_router, b_router, w_gate, w_up, w_down):
    bn, s, d = h.shape
    t = bn * s
    hf = h.reshape(t, d)
    glog = (hf @ w_group + b_group).astype(F32)
    gprob = jax.nn.softmax(glog, axis=-1)
    gsel = jnp.argmax(glog, axis=-1).astype(jnp.int32)
    p_group = jnp.take_along_axis(gprob, gsel[:, None], axis=-1)
    elog = (hf @ w_router + b_router).astype(F32).reshape(t, N_GROUPS, EXPERTS_PER_GROUP)
    elog = jnp.take_along_axis(elog, gsel[:, None, None], axis=1)[:, 0]
    top_v, top_i = lax.top_k(elog, TOP_K)
    gates = jax.nn.softmax(top_v, axis=-1) * p_group
    eidx = gsel[:, None] * EXPERTS_PER_GROUP + top_i.astype(jnp.int32)
    y = expert_dispatch(hf, eidx, gates.astype(h.dtype), w_gate, w_up, w_down)
    return y.reshape(bn, s, d)


def setup_inputs(seed: int = 0) -> dict:
    key = jax.random.key(seed)
    keys = jax.random.split(key, 48)
    cnt = [0]
    L, D, G, H, N = DEPTH, D_MODEL, GROUP_W, HEADS_PER_MIXER, HEAD_DIM

    def nk():
        cnt[0] += 1
        return keys[cnt[0] - 1]

    def nrm(shape, scale):
        return jax.random.normal(nk(), shape, F32) * scale

    def gain(shape):
        return 1.0 + nrm(shape, 0.02)

    def unif(shape, lo, hi):
        return jax.random.uniform(nk(), shape, F32, lo, hi)

    x = nrm((BATCH, SEQ, D), 1.0)
    c = nrm((BATCH, D), 1.0)
    ada_w = nrm((L, D, 6 * D), 0.5 * D ** -0.5)
    ada_b = nrm((L, 6 * D), 0.02)
    mix_norm_g = gain((L, D))
    ffn_norm_g = gain((L, D))
    w_in = nrm((L, D, IN_W), D ** -0.5)
    w_out = nrm((L, MIX_W, D), MIX_W ** -0.5)
    gdn_conv_w = nrm((L, GDN_CONV, 3 * G), GDN_CONV ** -0.5)
    gdn_a_log = jnp.log(unif((L, H), 1.0, 16.0))
    dt = jnp.exp(unif((L, H), math.log(1e-3), math.log(1e-1)))
    gdn_dt_bias = dt + jnp.log(-jnp.expm1(-dt))
    gdn_norm_g = gain((L, N))
    sgu_ln_g = gain((L, G))
    sgu_ln_b = nrm((L, G), 0.02)
    sgu_w = nrm((L, H, SGU_CHUNK, SGU_CHUNK), SGU_CHUNK ** -0.5)
    sgu_b = gain((L, H, SGU_CHUNK))
    sc_conv_w = nrm((L, SC_CONV, G), SC_CONV ** -0.5)
    rw_mu = unif((L, RW_IN_W), 0.0, 1.0)
    rw_w0 = unif((L, G), -4.0, 1.0)
    rw_w_up = nrm((L, RW_DECAY_LORA, G), 0.5 * RW_DECAY_LORA ** -0.5)
    rw_a0 = nrm((L, G), 0.5)
    rw_a_up = nrm((L, RW_AAA_LORA, G), RW_AAA_LORA ** -0.5)
    rw_g_up = nrm((L, RW_GATE_LORA, G), RW_GATE_LORA ** -0.5)
    rw_k_k = 0.85 + nrm((L, G), 0.02)
    rw_k_a = gain((L, G))
    rw_r_k = nrm((L, H, N), 0.1)
    rw_gn_g = gain((L, G))
    rw_gn_b = nrm((L, G), 0.02)
    moe_w_group = nrm((L, D, N_GROUPS), D ** -0.5)
    moe_b_group = nrm((L, N_GROUPS), 0.01)
    moe_w_router = nrm((L, D, N_EXPERTS), D ** -0.5)
    moe_b_router = nrm((L, N_EXPERTS), 0.01)
    moe_w_gate = nrm((L, N_EXPERTS, D, D_EXPERT), D ** -0.5)
    moe_w_up = nrm((L, N_EXPERTS, D, D_EXPERT), D ** -0.5)
    moe_w_down = nrm((L, N_EXPERTS, D_EXPERT, D), D_EXPERT ** -0.5)
    final_norm_g = gain((D,))
    return {'x': x, 'c': c, 'ada_w': ada_w, 'ada_b': ada_b, 'mix_norm_g': mix_norm_g,
            'ffn_norm_g': ffn_norm_g, 'w_in': w_in, 'w_out': w_out, 'gdn_conv_w': gdn_conv_w,
            'gdn_a_log': gdn_a_log, 'gdn_dt_bias': gdn_dt_bias, 'gdn_norm_g': gdn_norm_g,
            'sgu_ln_g': sgu_ln_g, 'sgu_ln_b': sgu_ln_b, 'sgu_w': sgu_w, 'sgu_b': sgu_b,
            'sc_conv_w': sc_conv_w, 'rw_mu': rw_mu, 'rw_w0': rw_w0, 'rw_w_up': rw_w_up,
            'rw_a0': rw_a0, 'rw_a_up': rw_a_up, 'rw_g_up': rw_g_up, 'rw_k_k': rw_k_k,
            'rw_k_a': rw_k_a, 'rw_r_k': rw_r_k, 'rw_gn_g': rw_gn_g, 'rw_gn_b': rw_gn_b,
            'moe_w_group': moe_w_group, 'moe_b_group': moe_b_group, 'moe_w_router': moe_w_router,
            'moe_b_router': moe_b_router, 'moe_w_gate': moe_w_gate, 'moe_w_up': moe_w_up,
            'moe_w_down': moe_w_down, 'final_norm_g': final_norm_g}


def reference(x, c, ada_w, ada_b, mix_norm_g, ffn_norm_g, w_in, w_out, gdn_conv_w, gdn_a_log,
              gdn_dt_bias, gdn_norm_g, sgu_ln_g, sgu_ln_b, sgu_w, sgu_b, sc_conv_w, rw_mu, rw_w0,
              rw_w_up, rw_a0, rw_a_up, rw_g_up, rw_k_k, rw_k_a, rw_r_k, rw_gn_g, rw_gn_b,
              moe_w_group, moe_b_group, moe_w_router, moe_b_router, moe_w_gate, moe_w_up,
              moe_w_down, final_norm_g):
    c_act = jax.nn.silu(c)
    for l in range(DEPTH):
        mod = c_act @ ada_w[l] + ada_b[l]
        sh_m, sc_m, gt_m, sh_f, sc_f, gt_f = jnp.split(mod, 6, axis=-1)
        h = modulate(rmsnorm(x, mix_norm_g[l]), sh_m, sc_m)
        p = h @ w_in[l]
        qkv, z, ga, gb, su, sv, cb, cc, ch, rp = _split(p, IN_SIZES)
        o_a = gdn_mixer(qkv, z, ga, gb, gdn_conv_w[l], gdn_a_log[l], gdn_dt_bias[l], gdn_norm_g[l])
        o_b = sgu_mixer(su, sv, sgu_ln_g[l], sgu_ln_b[l], sgu_w[l], sgu_b[l])
        o_c = short_conv_mixer(cb, cc, ch, sc_conv_w[l])
        o_d = rwkv7_mixer(rp, rw_mu[l], rw_w0[l], rw_w_up[l], rw_a0[l], rw_a_up[l], rw_g_up[l],
                          rw_k_k[l], rw_k_a[l], rw_r_k[l], rw_gn_g[l], rw_gn_b[l])
        mixed = jnp.concatenate([o_a, o_b, o_c, o_d], axis=-1) @ w_out[l]
        x = x + gt_m[:, None, :] * mixed
        h = modulate(rmsnorm(x, ffn_norm_g[l]), sh_f, sc_f)
        y = hier_moe(h, moe_w_group[l], moe_b_group[l], moe_w_router[l], moe_b_router[l],
                     moe_w_gate[l], moe_w_up[l], moe_w_down[l])
        x = x + gt_f[:, None, :] * y
    return rmsnorm(x, final_norm_g)
```

```cpp
#include <hip/hip_runtime.h>
#include <stdint.h>
#include <stdio.h>

typedef unsigned short bf16_t;
typedef short bf16x8 __attribute__((ext_vector_type(8)));
typedef float f32x4 __attribute__((ext_vector_type(4)));
typedef unsigned u32x4 __attribute__((ext_vector_type(4)));
typedef unsigned u32x2 __attribute__((ext_vector_type(2)));

#define T_TOK 65536
#define SEQ 8192
#define DM 1024
#define NLAYER 4
#define RW_EARLY 64
#define PW 3392
#define PWV 3336
#define PC_Q 0
#define PC_K 256
#define PC_V 512
#define PC_Z 768
#define PC_SU 1024
#define PC_SV 1280
#define PC_CB 1536
#define PC_CC 1792
#define PC_CH 2048
#define PC_RW 2304
#define PC_GA 3328
#define PC_GB 3332
#define WIN_ROWS 3584
#define RT_ROWS 256
#define MAXROWS 147456
#define MAXTILES 576

constexpr size_t OFF_BAR   = 0;
constexpr size_t OFF_CNT   = 16384;
constexpr size_t ZERO_BYTES = 32768;
constexpr size_t OFF_MOD   = 32768;
constexpr size_t OFF_WIN   = OFF_MOD + 786432;
constexpr size_t OFF_WOUT  = OFF_WIN + (size_t)4 * WIN_ROWS * 1024 * 2;
constexpr size_t OFF_SGUW  = OFF_WOUT + (size_t)4 * 1024 * 1024 * 2;
constexpr size_t OFF_LWU   = OFF_SGUW + 524288;
constexpr size_t OFF_LAU   = OFF_LWU + 131072;
constexpr size_t OFF_LGU   = OFF_LAU + 131072;
constexpr size_t OFF_ROUTW = OFF_LGU + 262144;
constexpr size_t OFF_GCD   = OFF_ROUTW + (size_t)4 * RT_ROWS * 1024 * 2;
constexpr size_t OFF_WGU   = OFF_GCD + 16384;
constexpr size_t OFF_WD    = OFF_WGU + (size_t)64 * 512 * 1024 * 2;
constexpr size_t OFF_H     = OFF_WD + (size_t)64 * 1024 * 256 * 2;
constexpr size_t OFF_P     = OFF_H + (size_t)T_TOK * 1024 * 2;
constexpr size_t OFF_MIX   = OFF_P + (size_t)T_TOK * PW * 2;
constexpr size_t OFF_RW    = OFF_MIX + (size_t)T_TOK * 1024 * 2;
constexpr size_t RW_ARR    = (size_t)T_TOK * 256 * 2;
constexpr size_t OFF_YR    = OFF_RW + 7 * RW_ARR;
constexpr size_t OFF_CE    = OFF_YR + RW_ARR;
constexpr size_t OFF_GAB   = OFF_CE + 2 * RW_ARR;
constexpr size_t OFF_GW    = OFF_GAB + (size_t)T_TOK * 8 * 4;
constexpr size_t WS_NEED   = OFF_GW + 4 * 8 * 1024 * 4;
constexpr size_t PO_LOGIT  = 0;
constexpr size_t PO_TOKINF = 20971520;
constexpr size_t PO_CBASE  = PO_TOKINF + 1048576;
constexpr size_t PO_ROWTOK = PO_CBASE + 65536;
constexpr size_t PO_ROWG   = PO_ROWTOK + 589824;
constexpr size_t PO_TILEE  = PO_ROWG + 589824;
constexpr size_t PO_HID    = 33554432;
constexpr size_t PO_Y      = PO_HID + (size_t)MAXROWS * 256 * 2 + 1048576;
static_assert(PO_TILEE + 4096 <= PO_HID, "moe tmp overlap");
static_assert(PO_Y + (size_t)2 * T_TOK * 1024 * 2 <= (size_t)T_TOK * PW * 2, "moe tmp too large");

#define LDS_BYTES 163840
#define LDS_XB_OFF (163840 - 256)
#define GDN_U1 0
#define TIME_DUP 0
#define DBG_NO_MOE 0
#define DBG_NO_RWKV 0
#define DBG_RWKV_Y0 0
#define DBG_RWKV_NOSCAN 0
#define DBG_RWKV_OUT 0
#define DBG_NO_GDN 0

struct Params {
    const float* in[36];
    float* out;
    char* ws;
};

#define XB_TMO      128
#define XB_XCNT(j)  (256  + 64 * (j))
#define XB_XSUB(j)  (1280 + 64 * (j))
#define XB_XGEN(j)  (2304 + 64 * (j))
#define XB_TOP      3328
#define XB_TOPGEN   3392
#define XCD_BAR_WORDS 3456
#define XB_SPIN_CAP (1u << 22)
#define LAS __attribute__((address_space(3)))

__device__ __forceinline__ unsigned xb_ld(unsigned* p)              { return __hip_atomic_load(p, __ATOMIC_RELAXED, __HIP_MEMORY_SCOPE_AGENT); }
__device__ __forceinline__ unsigned xb_add(unsigned* p, unsigned v) { return __hip_atomic_fetch_add(p, v, __ATOMIC_RELAXED, __HIP_MEMORY_SCOPE_AGENT); }
__device__ __forceinline__ unsigned xb_xcc_id() { return (unsigned)__builtin_amdgcn_s_getreg((3 << 11) | 20) & 0xFu; }
#define XB_SPIN(cond, bar) do { unsigned _sp = 0; while (cond) { __builtin_amdgcn_s_sleep(1); \
    if ((++_sp & 255u) == 0u) { if (xb_ld(&(bar)[XB_TMO])) break; if (_sp > XB_SPIN_CAP) { atomicAdd(&(bar)[XB_TMO], 1u); break; } } } } while (0)

struct XcdBarrier { unsigned* bar; unsigned x; volatile LAS unsigned* st; };

__device__ __forceinline__ XcdBarrier xcd_barrier_post(unsigned* bar, volatile LAS unsigned* st) {
    XcdBarrier b; b.bar = bar; b.x = xb_xcc_id(); b.st = st;
    if (threadIdx.x == 0) (void)xb_add(&bar[XB_XCNT(b.x)], 1u);
    return b;
}
__device__ __forceinline__ void xcd_barrier_complete(unsigned* bar, unsigned x, unsigned& nloc, unsigned& nx) {
    const unsigned G = gridDim.x * gridDim.y * gridDim.z;
    unsigned sum, cnt, mine, sp = 0u;
    for (;;) {
        sum = 0u; cnt = 0u; mine = 0u;
#pragma unroll
        for (unsigned j = 0; j < 16; ++j) { const unsigned c = xb_ld(&bar[XB_XCNT(j)]); sum += c; cnt += (c > 0u) ? 1u : 0u; mine = (j == x) ? c : mine; }
        if (sum == G) break;
        __builtin_amdgcn_s_sleep(1);
        if ((++sp & 255u) == 0u) { if (xb_ld(&bar[XB_TMO])) break; if (sp > XB_SPIN_CAP) { atomicAdd(&bar[XB_TMO], 1u); break; } }
    }
    nloc = mine > 0u ? mine : 1u; nx = cnt > 0u ? cnt : 1u;
}
__device__ __forceinline__ void xcd_barrier(const XcdBarrier& b) {
    asm volatile("s_waitcnt vmcnt(0)" ::: "memory");
    __syncthreads();
    if (threadIdx.x == 0) {
        unsigned blo_ = (unsigned)(unsigned long long)b.bar, bhi_ = (unsigned)((unsigned long long)b.bar >> 32), bx_ = b.x;
        asm volatile("" : "+v"(blo_), "+v"(bhi_), "+v"(bx_));
        unsigned* bar = (unsigned*)(__attribute__((address_space(1))) unsigned*)(((unsigned long long)(unsigned)__builtin_amdgcn_readfirstlane(bhi_) << 32) | (unsigned)__builtin_amdgcn_readfirstlane(blo_));
        const unsigned bx = (unsigned)__builtin_amdgcn_readfirstlane(bx_);
        __builtin_amdgcn_s_waitcnt(0);
        unsigned nloc = b.st[0], nx = b.st[1];
        if (nloc == 0u) { xcd_barrier_complete(bar, bx, nloc, nx); b.st[0] = nloc; b.st[1] = nx; }
        const unsigned old = xb_add(&bar[XB_XSUB(bx)], 1u);
        const unsigned gen = old / nloc;
        if (old + 1u == (gen + 1u) * nloc) {
            __builtin_amdgcn_fence(__ATOMIC_RELEASE, "agent");
            asm volatile("s_waitcnt vmcnt(0)" ::: "memory");
            const unsigned og = xb_add(&bar[XB_TOP], 1u);
            const unsigned tg = og / nx;
            if (og + 1u == (tg + 1u) * nx) xb_add(&bar[XB_TOPGEN], 1u);
            else XB_SPIN(xb_ld(&bar[XB_TOPGEN]) == tg, bar);
            __builtin_amdgcn_fence(__ATOMIC_ACQUIRE, "agent");
            xb_add(&bar[XB_XGEN(bx)], 1u);
            asm volatile("s_waitcnt vmcnt(0)" ::: "memory");
        } else {
            XB_SPIN(xb_ld(&bar[XB_XGEN(bx)]) == gen, bar);
            __builtin_amdgcn_fence(__ATOMIC_ACQUIRE, "agent");
            asm volatile("s_waitcnt vmcnt(0)" ::: "memory");
        }
    }
    __syncthreads();
}

__device__ __forceinline__ float bf2f(unsigned v) { return __uint_as_float(v << 16); }
__device__ __forceinline__ float bflo(unsigned v) { return __uint_as_float(v << 16); }
__device__ __forceinline__ float bfhi(unsigned v) { return __uint_as_float(v & 0xffff0000u); }
typedef float f32x2 __attribute__((ext_vector_type(2)));
typedef __bf16 bf16x2_t __attribute__((ext_vector_type(2)));
__device__ __forceinline__ unsigned pk2(float lo, float hi) { const f32x2 v = {lo, hi}; const bf16x2_t b = __builtin_convertvector(v, bf16x2_t); return __builtin_bit_cast(unsigned, b); }
__device__ __forceinline__ bf16_t f2bf(float f) { return (bf16_t)(pk2(f, 0.f) & 0xffffu); }
__device__ __forceinline__ float fexp_(float x) { return __builtin_amdgcn_exp2f(x * 1.4426950408889634f); }
__device__ __forceinline__ float flog_(float x) { return __builtin_amdgcn_logf(x) * 0.6931471805599453f; }
__device__ __forceinline__ float rcpf_(float x) { return __builtin_amdgcn_rcpf(x); }
__device__ __forceinline__ float sigmoidf_(float x) { return rcpf_(1.0f + fexp_(-x)); }
__device__ __forceinline__ float siluf_(float x) { return x * rcpf_(1.0f + fexp_(-x)); }
__device__ __forceinline__ float tanhf_(float y) { return 1.0f - 2.0f * rcpf_(1.0f + fexp_(2.0f * y)); }
__device__ __forceinline__ float geluf_(float x) { return 0.5f * x * (1.0f + tanhf_(0.7978845608028654f * (x + 0.044715f * x * x * x))); }
__device__ __forceinline__ float softplusf_(float x) { return fmaxf(x, 0.f) + flog_(1.0f + fexp_(-fabsf(x))); }
__device__ __forceinline__ void lds_barrier() { asm volatile("s_waitcnt lgkmcnt(0)" ::: "memory"); __builtin_amdgcn_s_barrier(); asm volatile("" ::: "memory"); }

template <int CTRL> __device__ __forceinline__ float dpp_f(float v) {
    return __int_as_float(__builtin_amdgcn_update_dpp(0, __float_as_int(v), CTRL, 0xf, 0xf, true));
}
__device__ __forceinline__ float rowsum16(float v) {
    v += dpp_f<0x128>(v); v += dpp_f<0x124>(v); v += dpp_f<0x122>(v); v += dpp_f<0x121>(v); return v;
}
__device__ __forceinline__ float wave_sum(float v) {
    v = rowsum16(v); v += __shfl_xor(v, 16); v += __shfl_xor(v, 32); return v;
}
__device__ __forceinline__ f32x4 mfma16(bf16x8 a, bf16x8 b, f32x4 c) { return __builtin_amdgcn_mfma_f32_16x16x32_bf16(a, b, c, 0, 0, 0); }
__device__ __forceinline__ bf16x8 ld_frag(const bf16_t* p) { return *(const bf16x8*)p; }
__device__ __forceinline__ void unpack8(const u32x4& v, float* f) {
    f[0] = bflo(v.x); f[1] = bfhi(v.x); f[2] = bflo(v.y); f[3] = bfhi(v.y); f[4] = bflo(v.z); f[5] = bfhi(v.z); f[6] = bflo(v.w); f[7] = bfhi(v.w);
}
__device__ __forceinline__ u32x4 pack8(const float* f) { u32x4 o; o.x = pk2(f[0], f[1]); o.y = pk2(f[2], f[3]); o.z = pk2(f[4], f[5]); o.w = pk2(f[6], f[7]); return o; }

template <class RowMap>
__device__ __forceinline__ void tr_tile(const int tid, float* tile, const float* __restrict__ src, int ld, int k0, int n0, int Ndim,
                                        bf16_t* __restrict__ dst, int dst_ld, RowMap rm) {
#pragma unroll
    for (int j = 0; j < 2; ++j) {
        const int kk = (tid >> 4) + 32 * j, n4 = (tid & 15) * 4;
        float4 v = make_float4(0.f, 0.f, 0.f, 0.f);
        if (n0 + n4 < Ndim) v = *(const float4*)(src + (size_t)(k0 + kk) * ld + n0 + n4);
        tile[kk * 65 + n4 + 0] = v.x; tile[kk * 65 + n4 + 1] = v.y; tile[kk * 65 + n4 + 2] = v.z; tile[kk * 65 + n4 + 3] = v.w;
    }
    lds_barrier();
    const int nn = tid >> 3, kc = (tid & 7) * 8;
    if (n0 + nn < Ndim) {
        float f[8];
#pragma unroll
        for (int i = 0; i < 8; ++i) f[i] = tile[(kc + i) * 65 + nn];
        *(u32x4*)(dst + (size_t)rm(n0 + nn) * dst_ld + k0 + kc) = pack8(f);
    }
    lds_barrier();
}
struct TrJob { const float* src; int ld, k0, n0, Ndim; bf16_t* dst; int dst_ld, mode  , up; };
__device__ __forceinline__ int trjob_row(const TrJob& j, int n) { return j.mode ? ((n >> 5) * 64 + j.up * 32 + (n & 31)) : n; }
__device__ __forceinline__ void tr_pair(const int tid, float* tileA, float* tileB, const TrJob& a, const TrJob& b, const bool haveB) {
    float4 va[2], vb[2];
#pragma unroll
    for (int j = 0; j < 2; ++j) {
        const int kk = (tid >> 4) + 32 * j, n4 = (tid & 15) * 4;
        va[j] = (a.n0 + n4 < a.Ndim) ? *(const float4*)(a.src + (size_t)(a.k0 + kk) * a.ld + a.n0 + n4) : make_float4(0.f, 0.f, 0.f, 0.f);
        vb[j] = (haveB && b.n0 + n4 < b.Ndim) ? *(const float4*)(b.src + (size_t)(b.k0 + kk) * b.ld + b.n0 + n4) : make_float4(0.f, 0.f, 0.f, 0.f);
    }
#pragma unroll
    for (int j = 0; j < 2; ++j) {
        const int kk = (tid >> 4) + 32 * j, n4 = (tid & 15) * 4;
        tileA[kk * 65 + n4 + 0] = va[j].x; tileA[kk * 65 + n4 + 1] = va[j].y; tileA[kk * 65 + n4 + 2] = va[j].z; tileA[kk * 65 + n4 + 3] = va[j].w;
        tileB[kk * 65 + n4 + 0] = vb[j].x; tileB[kk * 65 + n4 + 1] = vb[j].y; tileB[kk * 65 + n4 + 2] = vb[j].z; tileB[kk * 65 + n4 + 3] = vb[j].w;
    }
    lds_barrier();
    const int nn = tid >> 3, kc = (tid & 7) * 8;
    if (a.n0 + nn < a.Ndim) {
        float f[8];
#pragma unroll
        for (int i = 0; i < 8; ++i) f[i] = tileA[(kc + i) * 65 + nn];
        *(u32x4*)(a.dst + (size_t)trjob_row(a, a.n0 + nn) * a.dst_ld + a.k0 + kc) = pack8(f);
    }
    if (haveB && b.n0 + nn < b.Ndim) {
        float f[8];
#pragma unroll
        for (int i = 0; i < 8; ++i) f[i] = tileB[(kc + i) * 65 + nn];
        *(u32x4*)(b.dst + (size_t)trjob_row(b, b.n0 + nn) * b.dst_ld + b.k0 + kc) = pack8(f);
    }
    lds_barrier();
}
struct RmId { __device__ int operator()(int n) const { return n; } };
struct RmOff { int off; __device__ int operator()(int n) const { return n + off; } };
struct RmWin { __device__ int operator()(int n) const { return n < 1024 ? n : (n < 1032 ? 3328 + (n - 1024) : n - 8); } };
struct RmGate { int up; __device__ int operator()(int j) const { return (j >> 7) * 256 + up * 128 + (j & 127); } };

namespace g8 {
constexpr int BM = 256, BK = 64, HALF = 128, HTB = HALF * BK * 2, STAGE_BYTES = 8 * HTB, NXCD = 8, WGM = 8;
__device__ __forceinline__ int lds_byte(int r, int c) { const int st = (r >> 4) * 2 + (c >> 5), rr = r & 15, cc = c & 31, ob = rr * 64 + cc * 2; return st * 1024 + (ob ^ (((ob >> 9) & 1) << 5)); }
__device__ __forceinline__ void stage_rc(int b, int& R, int& C) { const int st = b / 1024, sb = b % 1024, swz = sb ^ (((sb >> 9) & 1) << 5); R = (st >> 1) * 16 + swz / 64; C = (st & 1) * 32 + (swz % 64) / 2; }
__device__ __forceinline__ int perm32(int rho) { const int n = rho >> 4, i = rho & 15; return 8 * (i >> 2) + 4 * n + (i & 3); }
struct Unit { int pm, pn; };
struct StaticOrder {
    int nM, nN, nwg, G, c;
    __device__ void init(int M, int N, int G_, int c_) { nM = M / BM; nN = N / BM; nwg = nM * nN; G = G_; c = c_; }
    __device__ bool next(int i, Unit& u) const {
        const long L = (long)i * G + c; if (L >= nwg) return false;
        int wgid = (int)L; { const int q = nwg / NXCD, r = nwg % NXCD, xcd = wgid % NXCD, off = wgid / NXCD; wgid = (xcd < r ? xcd * (q + 1) : r * (q + 1) + (xcd - r) * q) + off; }
        const int nig = WGM * nN, gid = wgid / nig, fm = gid * WGM, gsz = (nM - fm) < WGM ? (nM - fm) : WGM;
        u.pm = fm + ((wgid % nig) % gsz); u.pn = (wgid % nig) / gsz; return true;
    }
    __device__ const int* rows(const Unit&) const { return nullptr; }
};
struct OneUnit { int pm; __device__ bool next(int i, Unit& u) const { if (i > 0) return false; u.pm = pm; u.pn = 0; return true; } __device__ const int* rows(const Unit&) const { return nullptr; } };
template <int NT> struct MoeOrder {
    int ntiles, x, j, nj; const int* tile_e; const int* rowtok;
    int tab;
    __device__ void prime(int lane) { const int v = j + lane * nj, rt = (v / NT) * 8 + x; tab = (rt < ntiles) ? tile_e[rt] : 0; }
    __device__ bool next(int i, Unit& u) const {
        const int v = j + i * nj, rtl = v / NT, nt = v - rtl * NT, rt = rtl * 8 + x;
        if (rt >= ntiles) return false;
        u.pm = rt; u.pn = __builtin_amdgcn_readlane(tab, i) * NT + nt; return true;
    }
    __device__ const int* rows(const Unit& u) const { return rowtok + u.pm * 256; }
};
}
template <class Epi, class Sched, bool GATHER>
__device__ __forceinline__ void gemm8(const int tid  , LAS unsigned char* lds, const char* Abase, const char* Btbase, const int K, const Sched& S, const Epi& E, const unsigned hrow_off, const unsigned zero_off) {
    using namespace g8;
    const int wid = __builtin_amdgcn_readfirstlane(tid >> 6), lane = tid & 63, wr = wid >> 2, wc = wid & 3, fr = lane & 15, fq = lane >> 4;
    const int nt = K / BK;
    unsigned voffA[2], voffB[2];
#pragma unroll
    for (int i = 0; i < 2; ++i) { int R, C; stage_rc(tid * 16 + i * 8192, R, C); const int Rb = Epi::PERM ? (64 * (R >> 5) + perm32(R & 31)) : R;
        voffA[i] = (unsigned)(R * K + C) * 2u; voffB[i] = (unsigned)(Rb * K + C) * 2u; }
    const size_t kstep = (size_t)(BK * 2);
    const size_t hstep = (size_t)HALF * K * 2;
    const size_t bhstep = Epi::PERM ? (size_t)32 * K * 2 : hstep;
    const size_t tstep = 2 * hstep;
    const unsigned ldsw = (unsigned)wid * 1024u;
    const int aoff = lds_byte(wr * 64 + fr, fq * 8), boff = lds_byte(wc * 32 + fr, fq * 8);
#define G8_SA(b, h) (((b) * 2 + (h)) * HTB)
#define G8_SB(b, h) ((4 + (b) * 2 + (h)) * HTB)
#define G8_STAGE(bufoff, gbase, voff) do { _Pragma("unroll") for (int _i = 0; _i < 2; ++_i) \
        __builtin_amdgcn_global_load_lds((const __attribute__((address_space(1))) unsigned*)((const char*)(gbase) + (voff)[_i]), (LAS unsigned*)(lds + (bufoff) + ldsw + _i * 8192), 16, 0, 0); } while (0)
#define G8_STAGE_A(bufoff, NX, h, kb) do { if (GATHER) { if (NX) { G8_STAGE(bufoff, Abase + (kb), ngv[h]); } else { G8_STAGE(bufoff, Abase + (kb), cgv[h]); } } \
        else { G8_STAGE(bufoff, ((NX) ? nA : cA) + (size_t)(h) * hstep + (kb), voffA); } } while (0)
#define G8_LDA(dst, b, h) do { _Pragma("unroll") for (int m = 0; m < 4; ++m) _Pragma("unroll") for (int k = 0; k < 2; ++k) dst[m][k] = *(const LAS bf16x8*)(lds + G8_SA(b, h) + aoff + m * 2048 + k * 1024); } while (0)
#define G8_LDB(dst, b, h) do { _Pragma("unroll") for (int n = 0; n < 2; ++n) _Pragma("unroll") for (int k = 0; k < 2; ++k) dst[n][k] = *(const LAS bf16x8*)(lds + G8_SB(b, h) + boff + n * 2048 + k * 1024); } while (0)
#define G8_MMA(ai, bj, At, Bt) do { __builtin_amdgcn_s_setprio(1); _Pragma("unroll") for (int m = 0; m < 4; ++m) _Pragma("unroll") for (int n = 0; n < 2; ++n) _Pragma("unroll") for (int k = 0; k < 2; ++k) \
        acc[ai][bj][m][n] = __builtin_amdgcn_mfma_f32_16x16x32_bf16(Bt[n][k], At[m][k], acc[ai][bj][m][n], 0, 0, 0); __builtin_amdgcn_s_setprio(0); } while (0)
#define G8_WAIT_V(n) asm volatile("s_waitcnt vmcnt(" #n ")" ::: "memory")
#define G8_WAIT_L(n) asm volatile("s_waitcnt lgkmcnt(" #n ")" ::: "memory")
#define G8_BAR __builtin_amdgcn_s_barrier()
#define G8_SCHED __builtin_amdgcn_sched_barrier(0)
    Unit cur, nxt; int ui = 0;
    if (!S.next(0, cur)) return;
    f32x4 acc[2][2][4][2];
#pragma unroll
    for (int a = 0; a < 2; ++a)
#pragma unroll
        for (int b = 0; b < 2; ++b)
#pragma unroll
            for (int m = 0; m < 4; ++m)
#pragma unroll
                for (int n = 0; n < 2; ++n) acc[a][b][m][n] = (f32x4){0.f, 0.f, 0.f, 0.f};
    bf16x8 At[4][2], B0[2][2], B1[2][2];
    unsigned cgv[2][2], ngv[2][2];
    auto gather_off = [&](const Unit& u, unsigned (&gv)[2][2]) {
        const int* rl = S.rows(u);
#pragma unroll
        for (int h = 0; h < 2; ++h)
#pragma unroll
            for (int i = 0; i < 2; ++i) { int R, C; stage_rc(tid * 16 + i * 8192, R, C);
                const int v = rl[h * 128 + R]; gv[h][i] = (v < 0 ? zero_off : hrow_off + (unsigned)(v >> 1) * 2048u) + (unsigned)C * 2u; }
    };
    const char* cA = GATHER ? Abase : Abase + (size_t)cur.pm * tstep; const char* cB = Btbase + (size_t)cur.pn * tstep;
    const char* nA = cA;
    typename Epi::Pre pre; E.prefetch(cur, wr, fr, pre);
    if (GATHER) { gather_off(cur, cgv);
#pragma unroll
        for (int h = 0; h < 2; ++h) { ngv[h][0] = cgv[h][0]; ngv[h][1] = cgv[h][1]; } }
    G8_STAGE(G8_SB(0, 0), cB, voffB); G8_STAGE_A(G8_SA(0, 0), false, 0, (size_t)0); G8_STAGE(G8_SB(0, 1), cB + bhstep, voffB); G8_STAGE_A(G8_SA(0, 1), false, 1, (size_t)0);
    if (wr == 1) G8_BAR;
    G8_WAIT_V(4); G8_BAR;
    G8_STAGE(G8_SB(1, 0), cB + kstep, voffB); G8_STAGE_A(G8_SA(1, 0), false, 0, kstep); G8_STAGE(G8_SB(1, 1), cB + bhstep + kstep, voffB);
    G8_WAIT_V(6); G8_BAR;
    for (;;) {
        const bool has_next = S.next(ui + 1, nxt);
        const char* nB = has_next ? Btbase + (size_t)nxt.pn * tstep : cB;
        if (GATHER) { if (has_next) gather_off(nxt, ngv); }
        else nA = has_next ? Abase + (size_t)nxt.pm * tstep : cA;
#pragma unroll 1
        for (int t = 0; t < nt; t += 2) {
            const bool last = (t == nt - 2);
            const size_t k1 = (size_t)(t + 1) * kstep;
            const size_t k2 = last ? (size_t)0 : (size_t)(t + 2) * kstep, k3 = k2 + kstep;
            const char* b2 = (last ? nB : cB) + k2; const char* b3 = b2 + kstep;
            G8_LDB(B0, 0, 0); G8_SCHED; G8_LDA(At, 0, 0); G8_STAGE_A(G8_SA(1, 1), false, 1, k1);
            G8_WAIT_L(8); G8_BAR; G8_WAIT_L(0); G8_MMA(0, 0, At, B0); G8_BAR; G8_SCHED;
            G8_LDB(B1, 0, 1); G8_STAGE(G8_SB(0, 0), b2, voffB);
            G8_BAR; G8_WAIT_L(0); G8_MMA(0, 1, At, B1); G8_BAR;
            G8_LDA(At, 0, 1); if (last) { G8_STAGE_A(G8_SA(0, 0), true, 0, k2); } else { G8_STAGE_A(G8_SA(0, 0), false, 0, k2); }
            G8_BAR; G8_WAIT_L(0); G8_MMA(1, 0, At, B0); G8_BAR; G8_SCHED;
            G8_STAGE(G8_SB(0, 1), b2 + bhstep, voffB);
            G8_WAIT_V(6); G8_BAR; G8_MMA(1, 1, At, B1); G8_BAR;
            G8_LDB(B0, 1, 0); G8_SCHED; G8_LDA(At, 1, 0); if (last) { G8_STAGE_A(G8_SA(0, 1), true, 1, k2); } else { G8_STAGE_A(G8_SA(0, 1), false, 1, k2); }
            G8_WAIT_L(8); G8_BAR; G8_WAIT_L(0); G8_MMA(0, 0, At, B0); G8_BAR; G8_SCHED;
            G8_LDB(B1, 1, 1); G8_STAGE(G8_SB(1, 0), b3, voffB);
            G8_BAR; G8_WAIT_L(0); G8_MMA(0, 1, At, B1); G8_BAR;
            G8_LDA(At, 1, 1); if (last) { G8_STAGE_A(G8_SA(1, 0), true, 0, k3); } else { G8_STAGE_A(G8_SA(1, 0), false, 0, k3); }
            G8_BAR; G8_WAIT_L(0); G8_MMA(1, 0, At, B0); G8_BAR; G8_SCHED;
            G8_STAGE(G8_SB(1, 1), b3 + bhstep, voffB);
            G8_WAIT_V(6); G8_BAR; G8_MMA(1, 1, At, B1); G8_BAR;
        }
        E(acc, cur, wr, wc, fr, fq, pre);
        if (!has_next) break;
#pragma unroll
        for (int a = 0; a < 2; ++a)
#pragma unroll
            for (int b = 0; b < 2; ++b)
#pragma unroll
                for (int m = 0; m < 4; ++m)
#pragma unroll
                    for (int n = 0; n < 2; ++n) acc[a][b][m][n] = (f32x4){0.f, 0.f, 0.f, 0.f};
        cur = nxt; cB = nB; ++ui;
        E.prefetch(cur, wr, fr, pre);
        if (GATHER) {
#pragma unroll
            for (int h = 0; h < 2; ++h) { cgv[h][0] = ngv[h][0]; cgv[h][1] = ngv[h][1]; }
        } else cA = nA;
    }
    G8_WAIT_V(0);
    if (wr == 0) G8_BAR;
    G8_BAR;
}

template <int NOSTORE = 0  >
struct Ep8Inproj {
    static constexpr bool PERM = true;
    bf16_t* P;
    struct Pre {}; __device__ __forceinline__ void prefetch(const g8::Unit&, int, int, Pre&) const {}
    __device__ __forceinline__ void operator()(const f32x4 (&acc)[2][2][4][2], const g8::Unit& u, int wr, int wc, int fr, int fq, const Pre&) const {
#pragma unroll
        for (int ai = 0; ai < 2; ++ai)
#pragma unroll
            for (int m = 0; m < 4; ++m) {
                bf16_t* rowp = P + (size_t)(u.pm * 256 + ai * 128 + wr * 64 + m * 16 + fr) * PW;
#pragma unroll
                for (int bj = 0; bj < 2; ++bj) {
                    const int col = u.pn * 256 + wc * 64 + bj * 32 + fq * 8;
                    u32x4 o; o.x = pk2(acc[ai][bj][m][0][0], acc[ai][bj][m][0][1]); o.y = pk2(acc[ai][bj][m][0][2], acc[ai][bj][m][0][3]);
                    o.z = pk2(acc[ai][bj][m][1][0], acc[ai][bj][m][1][1]); o.w = pk2(acc[ai][bj][m][1][2], acc[ai][bj][m][1][3]);
                    if (!NOSTORE || o.x == 0x7fc12345u) *(u32x4*)(rowp + col) = o;
                }
            }
    }
};
struct Ep8Outproj {
    static constexpr bool PERM = true;
    const float* xin; const bf16_t* xb; bf16_t* xbo; const float* modl;
    struct Pre {}; __device__ __forceinline__ void prefetch(const g8::Unit&, int, int, Pre&) const {}
    __device__ __forceinline__ void operator()(const f32x4 (&acc)[2][2][4][2], const g8::Unit& u, int wr, int wc, int fr, int fq, const Pre&) const {
        const float* gt = modl + (size_t)((u.pm * 256) >> 13) * 6144 + 2 * 1024;
        if (xin) {
#pragma unroll
            for (int bj = 0; bj < 2; ++bj) {
                const int col = u.pn * 256 + wc * 64 + bj * 32 + fq * 8;
                const float4 g0 = *(const float4*)(gt + col), g1 = *(const float4*)(gt + col + 4);
                const float gg[8] = {g0.x, g0.y, g0.z, g0.w, g1.x, g1.y, g1.z, g1.w};
#pragma unroll
                for (int ai = 0; ai < 2; ++ai)
#pragma unroll
                    for (int m = 0; m < 4; ++m) {
                        const size_t off = (size_t)(u.pm * 256 + ai * 128 + wr * 64 + m * 16 + fr) * 1024 + col;
                        float x[8];
                        { const float4 a = *(const float4*)(xin + off), b4 = *(const float4*)(xin + off + 4); x[0] = a.x; x[1] = a.y; x[2] = a.z; x[3] = a.w; x[4] = b4.x; x[5] = b4.y; x[6] = b4.z; x[7] = b4.w; }
#pragma unroll
                        for (int n = 0; n < 2; ++n)
#pragma unroll
                            for (int r = 0; r < 4; ++r) x[n * 4 + r] += gg[n * 4 + r] * acc[ai][bj][m][n][r];
                        *(u32x4*)(xbo + off) = pack8(x);
                    }
            }
            return;
        }
        const size_t rbase = (size_t)(u.pm * 256 + wr * 64 + fr) * 1024 + u.pn * 256 + wc * 64 + fq * 8;
        u32x4 xr[2][2][4];
#pragma unroll
        for (int bj = 0; bj < 2; ++bj)
#pragma unroll
            for (int ai = 0; ai < 2; ++ai)
#pragma unroll
                for (int m = 0; m < 4; ++m) xr[bj][ai][m] = *(const u32x4*)(xb + rbase + (size_t)(ai * 128 + m * 16) * 1024 + bj * 32);
        __builtin_amdgcn_sched_barrier(0);
#pragma unroll
        for (int bj = 0; bj < 2; ++bj) {
            const int col = u.pn * 256 + wc * 64 + bj * 32 + fq * 8;
            const float4 g0 = *(const float4*)(gt + col), g1 = *(const float4*)(gt + col + 4);
            const float gg[8] = {g0.x, g0.y, g0.z, g0.w, g1.x, g1.y, g1.z, g1.w};
#pragma unroll
            for (int ai = 0; ai < 2; ++ai)
#pragma unroll
                for (int m = 0; m < 4; ++m) {
                    float x[8];
                    unpack8(xr[bj][ai][m], x);
#pragma unroll
                    for (int n = 0; n < 2; ++n)
#pragma unroll
                        for (int r = 0; r < 4; ++r) x[n * 4 + r] += gg[n * 4 + r] * acc[ai][bj][m][n][r];
                    *(u32x4*)(xbo + rbase + (size_t)(ai * 128 + m * 16) * 1024 + bj * 32) = pack8(x);
                }
        }
    }
};
struct Ep8Logit {
    static constexpr bool PERM = false;
    float* Lg;
    struct Pre {}; __device__ __forceinline__ void prefetch(const g8::Unit&, int, int, Pre&) const {}
    __device__ __forceinline__ void operator()(const f32x4 (&acc)[2][2][4][2], const g8::Unit& u, int wr, int wc, int fr, int fq, const Pre&) const {
#pragma unroll
        for (int ai = 0; ai < 2; ++ai)
#pragma unroll
            for (int m = 0; m < 4; ++m) {
                float* rowp = Lg + (size_t)(u.pm * 256 + ai * 128 + wr * 64 + m * 16 + fr) * 80;
#pragma unroll
                for (int n = 0; n < 2; ++n) {
                    const int col = wc * 32 + n * 16 + fq * 4;
                    if (col < 80) *(float4*)(rowp + col) = make_float4(acc[ai][0][m][n][0], acc[ai][0][m][n][1], acc[ai][0][m][n][2], acc[ai][0][m][n][3]);
                }
            }
    }
};
struct Ep8Moe1 {
    static constexpr bool PERM = true;
    bf16_t* Hd;
    struct Pre {}; __device__ __forceinline__ void prefetch(const g8::Unit&, int, int, Pre&) const {}
    __device__ __forceinline__ void operator()(const f32x4 (&acc)[2][2][4][2], const g8::Unit& u, int wr, int wc, int fr, int fq, const Pre&) const {
        const int jb = (u.pn & 1) * 128;
#pragma unroll
        for (int ai = 0; ai < 2; ++ai)
#pragma unroll
            for (int m = 0; m < 4; ++m) {
                bf16_t* rowp = Hd + (size_t)(u.pm * 256 + ai * 128 + wr * 64 + m * 16 + fr) * 256 + jb + wc * 32 + fq * 8;
                float h[8];
#pragma unroll
                for (int n = 0; n < 2; ++n)
#pragma unroll
                    for (int r = 0; r < 4; ++r) h[n * 4 + r] = siluf_(acc[ai][0][m][n][r]) * acc[ai][1][m][n][r];
                *(u32x4*)rowp = pack8(h);
            }
    }
};
template <int LINEAR = 0  >
struct Ep8Moe2 {
    static constexpr bool PERM = true;
    bf16_t* Y; const int* rowtok; const float* rowg;
    struct Pre { int v[8]; float g[8]; };
    __device__ __forceinline__ void prefetch(const g8::Unit& u, int wr, int fr, Pre& q) const {
#pragma unroll
        for (int ai = 0; ai < 2; ++ai)
#pragma unroll
            for (int m = 0; m < 4; ++m) {
                const int row = u.pm * 256 + ai * 128 + wr * 64 + m * 16 + fr;
                q.v[ai * 4 + m] = LINEAR ? (row % (2 * T_TOK)) : rowtok[row];
                q.g[ai * 4 + m] = LINEAR ? 1.0f : rowg[row];
            }
    }
    __device__ __forceinline__ void operator()(const f32x4 (&acc)[2][2][4][2], const g8::Unit& u, int wr, int wc, int fr, int fq, const Pre& q) const {
        const int n0 = (u.pn & 3) * 256;
#pragma unroll
        for (int ai = 0; ai < 2; ++ai)
#pragma unroll
            for (int m = 0; m < 4; ++m) {
                const int v = q.v[ai * 4 + m];
                if (v >= 0) {
                    const float g = q.g[ai * 4 + m];
                    bf16_t* yp = Y + ((size_t)(v & 1) * T_TOK + (size_t)(v >> 1)) * 1024 + n0 + wc * 64 + fq * 8;
#pragma unroll
                    for (int bj = 0; bj < 2; ++bj) {
                        u32x4 o; o.x = pk2(g * acc[ai][bj][m][0][0], g * acc[ai][bj][m][0][1]); o.y = pk2(g * acc[ai][bj][m][0][2], g * acc[ai][bj][m][0][3]);
                        o.z = pk2(g * acc[ai][bj][m][1][0], g * acc[ai][bj][m][1][1]); o.w = pk2(g * acc[ai][bj][m][1][2], g * acc[ai][bj][m][1][3]);
                        *(u32x4*)(yp + bj * 32) = o;
                    }
                }
            }
    }
};

#define MOD ((float*)(ws + OFF_MOD))
#define WIN ((bf16_t*)(ws + OFF_WIN))
#define WOUT ((bf16_t*)(ws + OFF_WOUT))
#define SGUW ((bf16_t*)(ws + OFF_SGUW))
#define LWU ((bf16_t*)(ws + OFF_LWU))
#define LAU ((bf16_t*)(ws + OFF_LAU))
#define LGU ((bf16_t*)(ws + OFF_LGU))
#define ROUTW ((bf16_t*)(ws + OFF_ROUTW))
#define GCD ((float*)(ws + OFF_GCD))
#define WGU ((bf16_t*)(ws + OFF_WGU))
#define WD ((bf16_t*)(ws + OFF_WD))
#define Hb ((bf16_t*)(ws + OFF_H))
#define GAB ((float*)(ws + OFF_GAB))
#define GW ((float*)(ws + OFF_GW))
__device__ __forceinline__ int gdn_slot(int u) { return (u & ~127) | (((u & 127) + 4 * (u >> 7)) & 127); }
#define Pb ((bf16_t*)(ws + OFF_P))
#define MIX ((bf16_t*)(ws + OFF_MIX))
#define RW_E ((bf16_t*)(ws + OFF_RW))
#define RW_CE ((float*)(ws + OFF_CE))
#define RW_KK ((bf16_t*)(ws + OFF_RW + 1 * RW_ARR))
#define RW_ZB ((bf16_t*)(ws + OFF_RW + 2 * RW_ARR))
#define RW_KM ((bf16_t*)(ws + OFF_RW + 3 * RW_ARR))
#define RW_R ((bf16_t*)(ws + OFF_RW + 4 * RW_ARR))
#define RW_V ((bf16_t*)(ws + OFF_RW + 5 * RW_ARR))
#define RW_G ((bf16_t*)(ws + OFF_RW + 6 * RW_ARR))
#define YR ((bf16_t*)(ws + OFF_YR))
#define LOGIT ((float*)(ws + OFF_P + PO_LOGIT))
#define TOKINF ((uint4*)(ws + OFF_P + PO_TOKINF))
#define CBASE ((unsigned*)(ws + OFF_P + PO_CBASE))
#define ROWTOK ((int*)(ws + OFF_P + PO_ROWTOK))
#define ROWG ((float*)(ws + OFF_P + PO_ROWG))
#define TILEE ((int*)(ws + OFF_P + PO_TILEE))
#define HID ((bf16_t*)(ws + OFF_P + PO_HID))
#define YB ((bf16_t*)(ws + OFF_P + PO_Y))
#define x_in INP(0)
#define xo (p.out)
#define XB ((bf16_t*)((char*)p.out + (size_t)T_TOK * 1024 * 2))
#define XB_LAST ((bf16_t*)(ws + OFF_RW))
#define XB_MID(l) ((l) == NLAYER - 1 ? XB_LAST : XB)
#define INP(k) (p.in[k])

__device__ __forceinline__ void ph_norm1(const Params& p, const int l_in) {
    extern __shared__ __attribute__((aligned(16))) char smem[];
    int tid_ = threadIdx.x; asm volatile("" : "+v"(tid_));
    int blk_ = blockIdx.x; asm volatile("" : "+s"(blk_));
    unsigned long long w64_ = (unsigned long long)p.ws; asm volatile("" : "+s"(w64_));
    char* ws_ = (char*)(__attribute__((address_space(1))) char*)w64_;
    int l_ = l_in; asm volatile("" : "+v"(l_)); const int l = __builtin_amdgcn_readfirstlane(l_);
    const int tid = tid_, lane = tid & 63, w = tid >> 6;
    int grid_ = gridDim.x; asm volatile("" : "+s"(grid_));
    const int blk = blk_, grid = grid_;
    const int fr = lane & 15, fq = lane >> 4;
    char* const ws = ws_;
    const float* const modl = MOD + (size_t)l * 8 * 6144;
    (void)lane; (void)w; (void)fr; (void)fq; (void)modl; (void)smem; (void)blk; (void)grid;
        const float* gn = INP(4) + l * 1024;
        const float* modp = (l > 0) ? (MOD + (size_t)(l - 1) * 8 * 6144) : nullptr;
        const int gw = blk * 8 + w, nw = grid * 8;
        unsigned gwp[8][8];
    #pragma unroll
        for (int o = 0; o < 8; ++o)
    #pragma unroll
            for (int j = 0; j < 4; ++j) { const float4 w4 = *(const float4*)(GW + (size_t)l * 8192 + o * 1024 + j * 256 + lane * 4); gwp[o][j * 2] = pk2(w4.x, w4.y); gwp[o][j * 2 + 1] = pk2(w4.z, w4.w); }
        for (int r0 = gw * 32; r0 < T_TOK; r0 += nw * 32) {
            const int b = r0 >> 13;
            float gs[16], sh[16], gf[16];
    #pragma unroll
            for (int j = 0; j < 4; ++j) {
                const int c = j * 256 + lane * 4;
                const float4 g4 = *(const float4*)(gn + c);
                const float4 sc4 = *(const float4*)(modl + b * 6144 + 1024 + c);
                const float4 sh4 = *(const float4*)(modl + b * 6144 + c);
                gs[j * 4 + 0] = g4.x * (1.f + sc4.x); gs[j * 4 + 1] = g4.y * (1.f + sc4.y); gs[j * 4 + 2] = g4.z * (1.f + sc4.z); gs[j * 4 + 3] = g4.w * (1.f + sc4.w);
                sh[j * 4 + 0] = sh4.x; sh[j * 4 + 1] = sh4.y; sh[j * 4 + 2] = sh4.z; sh[j * 4 + 3] = sh4.w;
                if (l > 0) { const float4 f4 = *(const float4*)(modp + b * 6144 + 5 * 1024 + c); gf[j * 4 + 0] = f4.x; gf[j * 4 + 1] = f4.y; gf[j * 4 + 2] = f4.z; gf[j * 4 + 3] = f4.w; }
                else { gf[j * 4 + 0] = 0.f; gf[j * 4 + 1] = 0.f; gf[j * 4 + 2] = 0.f; gf[j * 4 + 3] = 0.f; }
            }
            u32x2 cxb[4], cy0[4], cy1[4];
            float4 cxf[4];
            if (l > 0) {
    #pragma unroll
                for (int j = 0; j < 4; ++j) { const size_t o_ = (size_t)r0 * 1024 + j * 256 + lane * 4; cxb[j] = *(const u32x2*)(XB + o_); cy0[j] = *(const u32x2*)(YB + o_); cy1[j] = *(const u32x2*)(YB + (size_t)T_TOK * 1024 + o_); }
            } else {
    #pragma unroll
                for (int j = 0; j < 4; ++j) cxf[j] = *(const float4*)(x_in + (size_t)r0 * 1024 + j * 256 + lane * 4);
            }
            for (int r = r0; r < r0 + 32; ++r) {
                float xv[16]; float ss = 0.f;
                u32x2 nxb[4], ny0[4], ny1[4];
                float4 nxf[4];
                if (l > 0) {
                    const int rn = (r + 1 < r0 + 32) ? r + 1 : r;
    #pragma unroll
                    for (int j = 0; j < 4; ++j) { const size_t o_ = (size_t)rn * 1024 + j * 256 + lane * 4; nxb[j] = *(const u32x2*)(XB + o_); ny0[j] = *(const u32x2*)(YB + o_); ny1[j] = *(const u32x2*)(YB + (size_t)T_TOK * 1024 + o_); }
                } else {
                    const int rn = (r + 1 < r0 + 32) ? r + 1 : r;
    #pragma unroll
                    for (int j = 0; j < 4; ++j) nxf[j] = *(const float4*)(x_in + (size_t)rn * 1024 + j * 256 + lane * 4);
                }
    #pragma unroll
                for (int j = 0; j < 4; ++j) {
                    const int c = j * 256 + lane * 4;
                    float4 v;
                    if (l == 0) v = cxf[j];
                    else {
                        const u32x2 xb = cxb[j];
                        const u32x2 y0 = cy0[j];
                        const u32x2 y1 = cy1[j];
                        v.x = bflo(xb.x) + gf[j * 4 + 0] * (bflo(y0.x) + bflo(y1.x)); v.y = bfhi(xb.x) + gf[j * 4 + 1] * (bfhi(y0.x) + bfhi(y1.x));
                        v.z = bflo(xb.y) + gf[j * 4 + 2] * (bflo(y0.y) + bflo(y1.y)); v.w = bfhi(xb.y) + gf[j * 4 + 3] * (bfhi(y0.y) + bfhi(y1.y));
                        u32x2 xn; xn.x = pk2(v.x, v.y); xn.y = pk2(v.z, v.w);
                        *(u32x2*)(XB + (size_t)r * 1024 + c) = xn;
                    }
                    xv[j * 4 + 0] = v.x; xv[j * 4 + 1] = v.y; xv[j * 4 + 2] = v.z; xv[j * 4 + 3] = v.w;
                    ss += v.x * v.x + v.y * v.y + v.z * v.z + v.w * v.w;
                }
                ss = wave_sum(ss);
                const float rs = rsqrtf(ss * (1.0f / 1024.0f) + 1e-6f);
    #pragma unroll
                for (int i = 0; i < 16; ++i) xv[i] = xv[i] * rs * gs[i] + sh[i];
                unsigned hp[8];
    #pragma unroll
                for (int j = 0; j < 4; ++j) {
                    const int c = j * 256 + lane * 4;
                    u32x2 o;
                    o.x = pk2(xv[j * 4 + 0], xv[j * 4 + 1]);
                    o.y = pk2(xv[j * 4 + 2], xv[j * 4 + 3]);
                    *(u32x2*)(Hb + (size_t)r * 1024 + c) = o;
                    hp[j * 2] = o.x; hp[j * 2 + 1] = o.y;
                }
                float gd[8];
    #pragma unroll
                for (int o = 0; o < 8; ++o) {
                    float s = 0.f;
    #pragma unroll
                    for (int i = 0; i < 8; ++i) s = __builtin_amdgcn_fdot2_f32_bf16(__builtin_bit_cast(bf16x2_t, hp[i]), __builtin_bit_cast(bf16x2_t, gwp[o][i]), s, false);
                    gd[o] = s;
                }
    #pragma unroll
                for (int i = 0; i < 4; ++i) { const float keep = (lane & 1) ? gd[4 + i] : gd[i], send = (lane & 1) ? gd[i] : gd[4 + i]; gd[i] = keep + dpp_f<0xB1>(send); }
    #pragma unroll
                for (int i = 0; i < 2; ++i) { const float keep = (lane & 2) ? gd[2 + i] : gd[i], send = (lane & 2) ? gd[i] : gd[2 + i]; gd[i] = keep + dpp_f<0x4E>(send); }
                { const float keep = (lane & 4) ? gd[1] : gd[0], send = (lane & 4) ? gd[0] : gd[1]; gd[0] = keep + dpp_f<0x124>(send); }
                gd[0] += dpp_f<0x128>(gd[0]); gd[0] += __shfl_xor(gd[0], 16); gd[0] += __shfl_xor(gd[0], 32);
                if (lane < 8) GAB[(size_t)r * 8 + (((lane & 1) << 2) | (lane & 2) | ((lane >> 2) & 1))] = gd[0];
                if (l > 0) {
    #pragma unroll
                    for (int j = 0; j < 4; ++j) { cxb[j] = nxb[j]; cy0[j] = ny0[j]; cy1[j] = ny1[j]; }
                } else {
    #pragma unroll
                    for (int j = 0; j < 4; ++j) cxf[j] = nxf[j];
                }
            }
        }
}

template <int NOSTORE = 0>
__device__ __forceinline__ void ph_inproj(const Params& p, const int l_in) {
    extern __shared__ __attribute__((aligned(16))) char smem[];
    int tid_ = threadIdx.x; asm volatile("" : "+v"(tid_));
    int blk_ = blockIdx.x; asm volatile("" : "+s"(blk_));
    unsigned long long w64_ = (unsigned long long)p.ws; asm volatile("" : "+s"(w64_));
    char* ws_ = (char*)(__attribute__((address_space(1))) char*)w64_;
    int l_ = l_in; asm volatile("" : "+v"(l_)); const int l = __builtin_amdgcn_readfirstlane(l_);
    const int tid = tid_, lane = tid & 63, w = tid >> 6;
    int grid_ = gridDim.x; asm volatile("" : "+s"(grid_));
    const int blk = blk_, grid = grid_;
    const int fr = lane & 15, fq = lane >> 4;
    char* const ws = ws_;
    const float* const modl = MOD + (size_t)l * 8 * 6144;
    (void)lane; (void)w; (void)fr; (void)fq; (void)modl; (void)smem; (void)blk; (void)grid;
        g8::StaticOrder S; S.init(T_TOK, 3328, grid, blk);
        Ep8Inproj<NOSTORE> ep{Pb};
        gemm8<Ep8Inproj<NOSTORE>, g8::StaticOrder, false>(tid, (LAS unsigned char*)smem, (const char*)Hb, (const char*)(WIN + (size_t)l * WIN_ROWS * 1024), 1024, S, ep, 0u, 0u);
}

template <int SKIPST = 0  >
__device__ __forceinline__ void ph_rwprep(const Params& p, const int l_in, const int part = 2, const int first_in = -1, const int stride_in = 0) {
    extern __shared__ __attribute__((aligned(16))) char smem[];
    int tid_ = threadIdx.x; asm volatile("" : "+v"(tid_));
    int blk_ = blockIdx.x; asm volatile("" : "+s"(blk_));
    unsigned long long w64_ = (unsigned long long)p.ws; asm volatile("" : "+s"(w64_));
    char* ws_ = (char*)(__attribute__((address_space(1))) char*)w64_;
    int l_ = l_in; asm volatile("" : "+v"(l_)); const int l = __builtin_amdgcn_readfirstlane(l_);
    const int tid = tid_, lane = tid & 63, w = tid >> 6;
    int grid_ = gridDim.x; asm volatile("" : "+s"(grid_));
    const int blk = blk_, grid = grid_;
    const int fr = lane & 15, fq = lane >> 4;
    char* const ws = ws_;
    const float* const modl = MOD + (size_t)l * 8 * 6144;
    (void)lane; (void)w; (void)fr; (void)fq; (void)modl; (void)smem; (void)blk; (void)grid;
        bf16_t* X = (bf16_t*)smem;
        float* Kf = (float*)(smem + 33792);
        float* RS = (float*)(smem + 33792 + 65536);
        float* MU = (float*)(smem + 33792 + 65536 + 1024);
        for (int i = tid; i < 1024; i += 512) MU[i] = INP(17)[l * 1024 + i];
        lds_barrier();
        const float* w0 = INP(18) + l * 256; const float* a0 = INP(20) + l * 256;
        const float* kkp = INP(23) + l * 256; const float* kap = INP(24) + l * 256;
        const int nidx = part == 2 ? 1024 : (part == 0 ? 8 * RW_EARLY : 8 * (128 - RW_EARLY));
        int idx0_ = first_in < 0 ? blk : first_in; asm volatile("" : "+s"(idx0_));
        const int idxs = first_in < 0 ? grid : stride_in;
        for (int idx = idx0_; idx < nidx; idx += idxs) {
            const int tile = part == 2 ? idx : (part == 0 ? (idx / RW_EARLY) * 128 + idx % RW_EARLY : (idx / (128 - RW_EARLY)) * 128 + RW_EARLY + idx % (128 - RW_EARLY));
            const int t0 = tile * 64;
            {
                const int tok = tid >> 3, sub = tid & 7;
                const size_t t = (size_t)t0 + tok;
                const bool hasprev = ((t & (SEQ - 1)) != 0);
                const bf16_t* pc = Pb + t * PW + PC_RW;
                u32x4 cua[16], pua[16];
    #pragma unroll
                for (int it = 0; it < 16; ++it) cua[it] = *(const u32x4*)(pc + it * 64 + sub * 8);
    #pragma unroll
                for (int it = 0; it < 16; ++it) pua[it] = hasprev ? *(const u32x4*)(pc - PW + it * 64 + sub * 8) : (u32x4){0u, 0u, 0u, 0u};
    #pragma unroll
                for (int it = 0; it < 16; ++it) {
                    const int c = it * 64 + sub * 8;
                    const u32x4 cu = cua[it], pu = pua[it];
                    float cf[8], pf[8], ps[8];
                    unpack8(cu, cf); unpack8(pu, pf);
                    const float4 m0 = *(const float4*)(MU + c), m1 = *(const float4*)(MU + c + 4);
                    const float mm[8] = {m0.x, m0.y, m0.z, m0.w, m1.x, m1.y, m1.z, m1.w};
    #pragma unroll
                    for (int i = 0; i < 8; ++i) ps[i] = cf[i] + (pf[i] - cf[i]) * mm[i];
                    if (it < 4) { *(u32x4*)(RW_R + t * 256 + c) = pack8(ps); }
                    else if (it < 8) {
    #pragma unroll
                        for (int i = 0; i < 8; ++i) Kf[tok * 256 + (c - 256) + i] = ps[i];
                    }
                    else if (it < 12) { *(u32x4*)(RW_V + t * 256 + (c - 512)) = pack8(ps); }
                    else if (it == 12) {
    #pragma unroll
                        for (int i = 0; i < 8; ++i) ps[i] = tanhf_(ps[i]);
                        *(u32x4*)(X + tok * 264 + (c - 768)) = pack8(ps);
                    }
                    else if (it == 13) { *(u32x4*)(X + tok * 264 + 64 + (c - 832)) = pack8(ps); }
                    else {
    #pragma unroll
                        for (int i = 0; i < 8; ++i) ps[i] = sigmoidf_(ps[i]);
                        *(u32x4*)(X + tok * 264 + 128 + (c - 896)) = pack8(ps);
                    }
                }
            }
            lds_barrier();
            {
                const int tok = tid >> 3, sub = tid & 7, hd = sub >> 1, hf = sub & 1;
                float s = 0.f;
                for (int i = 0; i < 32; ++i) { const int ch = hd * 64 + hf * 32 + i; const float v = Kf[tok * 256 + ch] * kkp[ch]; s += v * v; }
                s += __shfl_xor(s, 1);
                if (hf == 0) RS[tok * 4 + hd] = rsqrtf(s + 1e-12f);
            }
            lds_barrier();
            {
#pragma unroll 1
                for (int mh = 0; mh < 2; ++mh) {
                f32x4 aw[2][2], aa[2][2], ag[2][2];
    #pragma unroll
                for (int m = 0; m < 2; ++m)
    #pragma unroll
                    for (int n = 0; n < 2; ++n) { aw[m][n] = (f32x4){0.f, 0.f, 0.f, 0.f}; aa[m][n] = aw[m][n]; ag[m][n] = aw[m][n]; }
    #pragma unroll
                for (int ks = 0; ks < 2; ++ks) {
                    bf16x8 bx[2], bxa[2];
    #pragma unroll
                    for (int m = 0; m < 2; ++m) { bx[m] = ld_frag(X + ((mh * 2 + m) * 16 + fr) * 264 + ks * 32 + fq * 8); bxa[m] = ld_frag(X + ((mh * 2 + m) * 16 + fr) * 264 + 64 + ks * 32 + fq * 8); }
    #pragma unroll
                    for (int n = 0; n < 2; ++n) {
                        const int chr = w * 32 + g8::perm32(n * 16 + fr);
                        const bf16x8 fw = ld_frag(LWU + ((size_t)l * 256 + chr) * 64 + ks * 32 + fq * 8);
                        const bf16x8 fa = ld_frag(LAU + ((size_t)l * 256 + chr) * 64 + ks * 32 + fq * 8);
    #pragma unroll
                        for (int m = 0; m < 2; ++m) { aw[m][n] = mfma16(fw, bx[m], aw[m][n]); aa[m][n] = mfma16(fa, bxa[m], aa[m][n]); }
                    }
                }
    #pragma unroll
                for (int ks = 0; ks < 4; ++ks) {
                    bf16x8 bx[2];
    #pragma unroll
                    for (int m = 0; m < 2; ++m) bx[m] = ld_frag(X + ((mh * 2 + m) * 16 + fr) * 264 + 128 + ks * 32 + fq * 8);
    #pragma unroll
                    for (int n = 0; n < 2; ++n) {
                        const int chr = w * 32 + g8::perm32(n * 16 + fr);
                        const bf16x8 fg = ld_frag(LGU + ((size_t)l * 256 + chr) * 128 + ks * 32 + fq * 8);
    #pragma unroll
                        for (int m = 0; m < 2; ++m) ag[m][n] = mfma16(fg, bx[m], ag[m][n]);
                    }
                }
                {
                    const int ch0 = w * 32 + fq * 8;
                    float w0a[8], a0a[8], kka[8], kaa[8];
    #pragma unroll
                    for (int n = 0; n < 2; ++n) {
                        const float4 w04 = *(const float4*)(w0 + ch0 + 4 * n), a04 = *(const float4*)(a0 + ch0 + 4 * n), kk4 = *(const float4*)(kkp + ch0 + 4 * n), ka4 = *(const float4*)(kap + ch0 + 4 * n);
                        w0a[4 * n] = w04.x; w0a[4 * n + 1] = w04.y; w0a[4 * n + 2] = w04.z; w0a[4 * n + 3] = w04.w;
                        a0a[4 * n] = a04.x; a0a[4 * n + 1] = a04.y; a0a[4 * n + 2] = a04.z; a0a[4 * n + 3] = a04.w;
                        kka[4 * n] = kk4.x; kka[4 * n + 1] = kk4.y; kka[4 * n + 2] = kk4.z; kka[4 * n + 3] = kk4.w;
                        kaa[4 * n] = ka4.x; kaa[4 * n + 1] = ka4.y; kaa[4 * n + 2] = ka4.z; kaa[4 * n + 3] = ka4.w;
                    }
                    float e2[2][8];
    #pragma unroll
                    for (int m = 0; m < 2; ++m) {
                        const int tok = (mh * 2 + m) * 16 + fr;
                        const size_t t = (size_t)t0 + tok;
                        const float rs = RS[tok * 4 + (ch0 >> 6)];
                        float e[8], kkv[8], zb[8], km[8], gg[8];
    #pragma unroll
                        for (int n = 0; n < 2; ++n)
    #pragma unroll
                            for (int r = 0; r < 4; ++r) {
                                const int q = 4 * n + r;
                                const float zw = w0a[q] + aw[m][n][r];
                                const float wlog = -softplusf_(-zw) - 0.5f;
                                e[q] = -fexp_(wlog);
                                const float a = sigmoidf_(a0a[q] + aa[m][n][r]);
                                const float kv = Kf[tok * 256 + ch0 + q];
                                kkv[q] = kv * kka[q] * rs;
                                km[q] = kv * (1.0f + (a - 1.0f) * kaa[q]);
                                zb[q] = kkv[q] * a;
                                gg[q] = ag[m][n][r];
                            }
    #pragma unroll
                        for (int q = 0; q < 8; ++q) e2[m][q] = e[q];
                        if (SKIPST) { if (e[0] + kkv[1] + zb[2] + km[3] + gg[0] == 123.456f) RS[0] = 1.f; continue; }
                        *(u32x4*)(RW_KK + t * 256 + ch0) = pack8(kkv);
                        *(u32x4*)(RW_ZB + t * 256 + ch0) = pack8(zb);
                        *(u32x4*)(RW_KM + t * 256 + ch0) = pack8(km);
                        *(u32x4*)(RW_G + t * 256 + ch0) = pack8(gg);
                    }
                    if (!SKIPST) {
    #pragma unroll
                        for (int q = 0; q < 8; ++q) {
                            float x0 = e2[0][q], x1 = e2[1][q];
                            const float tot0 = rowsum16(x0);
                            x0 += dpp_f<0x111>(x0); x0 += dpp_f<0x112>(x0); x0 += dpp_f<0x114>(x0); x0 += dpp_f<0x118>(x0);
                            x1 += dpp_f<0x111>(x1); x1 += dpp_f<0x112>(x1); x1 += dpp_f<0x114>(x1); x1 += dpp_f<0x118>(x1);
                            e2[0][q] = x0; e2[1][q] = x1 + tot0;
                        }
    #pragma unroll
                        for (int m = 0; m < 2; ++m) {
                            float* cp = RW_CE + ((size_t)t0 + (mh * 2 + m) * 16 + fr) * 256 + ch0;
                            *(float4*)cp = make_float4(e2[m][0], e2[m][1], e2[m][2], e2[m][3]); *(float4*)(cp + 4) = make_float4(e2[m][4], e2[m][5], e2[m][6], e2[m][7]);
                        }
                    }
                }
                }
            }
            lds_barrier();
        }
}

__device__ __forceinline__ void ph_conv(const Params& p, const int l_in, const int b_first, const int b_count) {
    extern __shared__ __attribute__((aligned(16))) char smem[];
    int tid_ = threadIdx.x; asm volatile("" : "+v"(tid_));
    int blk_ = blockIdx.x; asm volatile("" : "+s"(blk_));
    unsigned long long w64_ = (unsigned long long)p.ws; asm volatile("" : "+s"(w64_));
    char* ws_ = (char*)(__attribute__((address_space(1))) char*)w64_;
    int l_ = l_in; asm volatile("" : "+v"(l_)); const int l = __builtin_amdgcn_readfirstlane(l_);
    const int tid = tid_, lane = tid & 63, w = tid >> 6;
    int grid_ = gridDim.x; asm volatile("" : "+s"(grid_));
    const int blk = blk_, grid = grid_;
    const int fr = lane & 15, fq = lane >> 4;
    char* const ws = ws_;
    const float* const modl = MOD + (size_t)l * 8 * 6144;
    (void)lane; (void)w; (void)fr; (void)fq; (void)modl; (void)smem; (void)blk; (void)grid;
        const float* cw = INP(16) + l * 3 * 256;
        for (int item = b_first * 512 + tid; item < T_TOK * 32; item += b_count * 512) {
            const size_t t = (size_t)(item >> 5); const int c8 = (item & 31) * 8;
            const int pos = (int)(t & (SEQ - 1));
            const bf16_t* pr = Pb + t * PW;
            float acc[8];
    #pragma unroll
            for (int i = 0; i < 8; ++i) acc[i] = 0.f;
            u32x4 ra[3], rb[3];
    #pragma unroll
            for (int k = 0; k < 3; ++k) {
                const int back = (pos >= 2 - k) ? 2 - k : 0;
                ra[k] = *(const u32x4*)(pr - (size_t)back * PW + PC_CC + c8);
                rb[k] = *(const u32x4*)(pr - (size_t)back * PW + PC_CH + c8);
            }
            const u32x4 rg = *(const u32x4*)(pr + PC_CB + c8);
    #pragma unroll
            for (int k = 0; k < 3; ++k) {
                const float msk = (pos >= 2 - k) ? 1.f : 0.f;
                float a[8], b[8];
                unpack8(ra[k], a); unpack8(rb[k], b);
                const float4 w0 = *(const float4*)(cw + k * 256 + c8), w1 = *(const float4*)(cw + k * 256 + c8 + 4);
                const float ww[8] = {w0.x * msk, w0.y * msk, w0.z * msk, w0.w * msk, w1.x * msk, w1.y * msk, w1.z * msk, w1.w * msk};
    #pragma unroll
                for (int i = 0; i < 8; ++i) acc[i] += ww[i] * a[i] * b[i];
            }
            float g[8]; unpack8(rg, g);
    #pragma unroll
            for (int i = 0; i < 8; ++i) acc[i] *= g[i];
            *(u32x4*)(MIX + t * 1024 + 512 + c8) = pack8(acc);
        }
}

__device__ __forceinline__ void ph_sgu(const Params& p, const int l_in, const int b_first, const int b_count) {
    extern __shared__ __attribute__((aligned(16))) char smem[];
    int tid_ = threadIdx.x; asm volatile("" : "+v"(tid_));
    int blk_ = blockIdx.x; asm volatile("" : "+s"(blk_));
    unsigned long long w64_ = (unsigned long long)p.ws; asm volatile("" : "+s"(w64_));
    char* ws_ = (char*)(__attribute__((address_space(1))) char*)w64_;
    int l_ = l_in; asm volatile("" : "+v"(l_)); const int l = __builtin_amdgcn_readfirstlane(l_);
    const int tid = tid_, lane = tid & 63, w = tid >> 6;
    int grid_ = gridDim.x; asm volatile("" : "+s"(grid_));
    const int blk = blk_, grid = grid_;
    const int fr = lane & 15, fq = lane >> 4;
    char* const ws = ws_;
    const float* const modl = MOD + (size_t)l * 8 * 6144;
    (void)lane; (void)w; (void)fr; (void)fq; (void)modl; (void)smem; (void)blk; (void)grid;
        bf16_t* VT = (bf16_t*)smem;
        const float* lng = INP(12) + l * 256; const float* lnb = INP(13) + l * 256;
        const float* sb = INP(15) + (size_t)l * 4 * 128;
        for (int ci = b_first; ci < 512; ci += b_count) {
            const size_t t0 = (size_t)ci * 128;
            {
                const float4 g4 = *(const float4*)(lng + lane * 4), b4 = *(const float4*)(lnb + lane * 4);
                u32x2 raws[16];
    #pragma unroll
                for (int i = 0; i < 16; ++i) raws[i] = *(const u32x2*)(Pb + (t0 + w * 16 + i) * PW + PC_SV + lane * 4);
    #pragma unroll
                for (int i = 0; i < 16; ++i) {
                    const int s = w * 16 + i;
                    const u32x2 raw = raws[i];
                    float g[4] = {geluf_(bflo(raw.x)), geluf_(bfhi(raw.x)), geluf_(bflo(raw.y)), geluf_(bfhi(raw.y))};
                    const float mean = wave_sum(g[0] + g[1] + g[2] + g[3]) * (1.0f / 256.0f);
                    float d[4] = {g[0] - mean, g[1] - mean, g[2] - mean, g[3] - mean};
                    const float var = wave_sum(d[0] * d[0] + d[1] * d[1] + d[2] * d[2] + d[3] * d[3]) * (1.0f / 256.0f);
                    const float rs = rsqrtf(var + 1e-5f);
                    VT[(lane * 4 + 0) * 136 + s] = f2bf(d[0] * rs * g4.x + b4.x);
                    VT[(lane * 4 + 1) * 136 + s] = f2bf(d[1] * rs * g4.y + b4.y);
                    VT[(lane * 4 + 2) * 136 + s] = f2bf(d[2] * rs * g4.z + b4.z);
                    VT[(lane * 4 + 3) * 136 + s] = f2bf(d[3] * rs * g4.w + b4.w);
                }
            }
            lds_barrier();
            {
                const int hd = w >> 1;
                const bf16_t* Wh = SGUW + ((size_t)(l * 4 + hd)) * 128 * 128;
                u32x2 rawu[8][2];
    #pragma unroll
                for (int m = 0; m < 8; ++m)
    #pragma unroll
                    for (int n = 0; n < 2; ++n) rawu[m][n] = *(const u32x2*)(Pb + (t0 + m * 16 + fr) * PW + PC_SU + w * 32 + n * 16 + fq * 4);
                f32x4 acc[8][2];
    #pragma unroll
                for (int m = 0; m < 8; ++m) { acc[m][0] = (f32x4){0.f, 0.f, 0.f, 0.f}; acc[m][1] = acc[m][0]; }
    #pragma unroll
                for (int ks = 0; ks < 4; ++ks) {
                    const bf16x8 a0 = ld_frag(VT + (w * 32 + fr) * 136 + ks * 32 + fq * 8);
                    const bf16x8 a1 = ld_frag(VT + (w * 32 + 16 + fr) * 136 + ks * 32 + fq * 8);
    #pragma unroll
                    for (int m = 0; m < 8; ++m) {
                        if (ks <= (m >> 1)) {
                            const bf16x8 bw = ld_frag(Wh + (size_t)(m * 16 + fr) * 128 + ks * 32 + fq * 8);
                            acc[m][0] = mfma16(a0, bw, acc[m][0]); acc[m][1] = mfma16(a1, bw, acc[m][1]);
                        }
                    }
                }
    #pragma unroll
                for (int m = 0; m < 8; ++m) {
                    const int tok = m * 16 + fr;
                    const float bias = sb[hd * 128 + tok];
    #pragma unroll
                    for (int n = 0; n < 2; ++n) {
                        const int ch0 = w * 32 + n * 16 + fq * 4;
                        const u32x2 raw = rawu[m][n];
                        u32x2 o;
                        o.x = pk2(geluf_(bflo(raw.x)) * (acc[m][n][0] + bias), geluf_(bfhi(raw.x)) * (acc[m][n][1] + bias));
                        o.y = pk2(geluf_(bflo(raw.y)) * (acc[m][n][2] + bias), geluf_(bfhi(raw.y)) * (acc[m][n][3] + bias));
                        *(u32x2*)(MIX + (t0 + tok) * 1024 + 256 + ch0) = o;
                    }
                }
            }
            lds_barrier();
        }
}

template <int SKIP = 0  >
__device__ __forceinline__ void ph_gdn1(const Params& p, const int l_in, const int u_first, const int u_stride, const int u_end) {
    extern __shared__ __attribute__((aligned(16))) char smem[];
    int tid_ = threadIdx.x; asm volatile("" : "+v"(tid_));
    int blk_ = blockIdx.x; asm volatile("" : "+s"(blk_));
    unsigned long long w64_ = (unsigned long long)p.ws; asm volatile("" : "+s"(w64_));
    char* ws_ = (char*)(__attribute__((address_space(1))) char*)w64_;
    int l_ = l_in; asm volatile("" : "+v"(l_)); const int l = __builtin_amdgcn_readfirstlane(l_);
    const int tid = tid_, lane = tid & 63, w = tid >> 6;
    int grid_ = gridDim.x; asm volatile("" : "+s"(grid_));
    const int blk = blk_, grid = grid_;
    const int fr = lane & 15, fq = lane >> 4;
    char* const ws = ws_;
    const float* const modl = MOD + (size_t)l * 8 * 6144;
    (void)lane; (void)w; (void)fr; (void)fq; (void)modl; (void)smem; (void)blk; (void)grid;
        bf16_t* Qb = (bf16_t*)(smem);
        bf16_t* Kb = (bf16_t*)(smem + 9216);
        bf16_t* AT = (bf16_t*)(smem + 18432);
        bf16_t* UT = (bf16_t*)(smem + 27648);
        bf16_t* WT = (bf16_t*)(smem + 36864);
        bf16_t* KTT = (bf16_t*)(smem + 46080);
        float* XS = (float*)(smem + 55296);
        bf16_t* AmB = (bf16_t*)(smem + 88064);
        float* Ad = (float*)(smem + 97280);
        float* Tb = (float*)(smem + 101376);
        float* gcs = (float*)(smem + 105472);
        float* beta = gcs + 64; float* eg = gcs + 128; float* graw = gcs + 192;
        float* CW = (float*)(smem + 106496);
        for (int i = tid; i < 4 * 768; i += 512) CW[i] = INP(8)[(size_t)l * 4 * 768 + i];
        const float alog_all[4] = {INP(9)[l * 4 + 0], INP(9)[l * 4 + 1], INP(9)[l * 4 + 2], INP(9)[l * 4 + 3]};
        const float dtb_all[4] = {INP(10)[l * 4 + 0], INP(10)[l * 4 + 1], INP(10)[l * 4 + 2], INP(10)[l * 4 + 3]};
        lds_barrier();
        for (int u = u_first; u < u_end; u += u_stride) {
            int tidu_ = tid; asm volatile("" : "+v"(tidu_));
            const int tid = tidu_, lane = tid & 63, w = tid >> 6, fr = lane & 15, fq = lane >> 4;
            const int b = u >> 9, hd = (u >> 7) & 3, nch = u & 127;
            const size_t t0 = (size_t)b * SEQ + (size_t)nch * 64;
            {
                const int i = tid >> 3, sub = tid & 7;
                const int pos = nch * 64 + i;
                const bf16_t* pr = Pb + (t0 + i) * PW;
                float q[8], k[8], v[8];
    #pragma unroll
                for (int e = 0; e < 8; ++e) { q[e] = 0.f; k[e] = 0.f; v[e] = 0.f; }
                u32x4 rq_[4], rk_[4], rv_[4];
    #pragma unroll
                for (int j = 0; j < 4; ++j) {
                    const int back = (pos >= 3 - j) ? 3 - j : 0;
                    const bf16_t* pp = pr - (size_t)back * PW + hd * 64 + sub * 8;
                    rq_[j] = *(const u32x4*)(pp + PC_Q); rk_[j] = *(const u32x4*)(pp + PC_K); rv_[j] = *(const u32x4*)(pp + PC_V);
                }
                const float ga_raw = GAB[(t0 + i) * 8 + hd], gb_raw = GAB[(t0 + i) * 8 + 4 + hd];
    #pragma unroll
                for (int j = 0; j < 4; ++j) {
                    const float msk = (pos >= 3 - j && !(SKIP & 2)) ? 1.f : 0.f;
                    float a[8], bb[8], c[8];
                    unpack8(rq_[j], a); unpack8(rk_[j], bb); unpack8(rv_[j], c);
                    const float* wq = CW + j * 768 + hd * 64 + sub * 8;
                    const float4 q0 = *(const float4*)(wq), q1 = *(const float4*)(wq + 4);
                    const float4 k0 = *(const float4*)(wq + 256), k1 = *(const float4*)(wq + 260);
                    const float4 v0 = *(const float4*)(wq + 512), v1 = *(const float4*)(wq + 516);
                    const float wqa[8] = {q0.x, q0.y, q0.z, q0.w, q1.x, q1.y, q1.z, q1.w};
                    const float wka[8] = {k0.x, k0.y, k0.z, k0.w, k1.x, k1.y, k1.z, k1.w};
                    const float wva[8] = {v0.x, v0.y, v0.z, v0.w, v1.x, v1.y, v1.z, v1.w};
    #pragma unroll
                    for (int e = 0; e < 8; ++e) { q[e] += msk * wqa[e] * a[e]; k[e] += msk * wka[e] * bb[e]; v[e] += msk * wva[e] * c[e]; }
                }
                float sq = 0.f, sk = 0.f;
    #pragma unroll
                for (int e = 0; e < 8; ++e) { q[e] = siluf_(q[e]); k[e] = siluf_(k[e]); v[e] = siluf_(v[e]); sq += q[e] * q[e]; sk += k[e] * k[e]; }
                sq += __shfl_xor(sq, 1); sq += __shfl_xor(sq, 2); sq += __shfl_xor(sq, 4);
                sk += __shfl_xor(sk, 1); sk += __shfl_xor(sk, 2); sk += __shfl_xor(sk, 4);
                const float rq = rsqrtf(sq + 1e-6f) * 0.125f, rk = rsqrtf(sk + 1e-6f);
    #pragma unroll
                for (int e = 0; e < 8; ++e) { q[e] *= rq; k[e] *= rk; }
                *(u32x4*)(Qb + i * 72 + sub * 8) = pack8(q);
                *(u32x4*)(Kb + i * 72 + sub * 8) = pack8(k);
                *(float4*)(XS + i * 128 + 64 + sub * 8) = make_float4(k[0], k[1], k[2], k[3]); *(float4*)(XS + i * 128 + 64 + sub * 8 + 4) = make_float4(k[4], k[5], k[6], k[7]);
                *(float4*)(XS + i * 128 + sub * 8) = make_float4(v[0], v[1], v[2], v[3]); *(float4*)(XS + i * 128 + sub * 8 + 4) = make_float4(v[4], v[5], v[6], v[7]);
                if (sub == 0) {
                    const float a = ga_raw, bb = gb_raw;
                    const float alg = hd == 0 ? alog_all[0] : hd == 1 ? alog_all[1] : hd == 2 ? alog_all[2] : alog_all[3];
                    const float dtb = hd == 0 ? dtb_all[0] : hd == 1 ? dtb_all[1] : hd == 2 ? dtb_all[2] : dtb_all[3];
                    graw[i] = -fexp_(alg) * softplusf_(a + dtb);
                    beta[i] = sigmoidf_(bb);
                }
            }
            lds_barrier();
            if (w == 0) {
                float g = graw[lane];
    #pragma unroll
                for (int o = 1; o < 64; o <<= 1) { const float tt = __shfl_up(g, o); if (lane >= o) g += tt; }
                gcs[lane] = g; eg[lane] = fexp_(g);
            }
            lds_barrier();
            {
    #pragma unroll
                for (int q2 = 0; q2 < 2; ++q2) {
                    const int ti = w * 2 + q2, mt = ti >> 2, nt = ti & 3;
                    f32x4 ckk = (f32x4){0.f, 0.f, 0.f, 0.f}, cqk = ckk;
                    if (nt <= mt) {
    #pragma unroll
                        for (int ks = 0; ks < 2; ++ks) {
                            const bf16x8 fk = ld_frag(Kb + (mt * 16 + fr) * 72 + ks * 32 + fq * 8);
                            const bf16x8 fqv = ld_frag(Qb + (mt * 16 + fr) * 72 + ks * 32 + fq * 8);
                            const bf16x8 fb = ld_frag(Kb + (nt * 16 + fr) * 72 + ks * 32 + fq * 8);
                            ckk = mfma16(fk, fb, ckk); cqk = mfma16(fqv, fb, cqk);
                        }
                    }
                    const int jj = nt * 16 + fr;
                    const float gj = gcs[jj];
    #pragma unroll
                    for (int r = 0; r < 4; ++r) {
                        const int ii = mt * 16 + fq * 4 + r;
                        const float dec = (ii >= jj) ? fexp_(gcs[ii] - gj) : 0.f;
                        const float aval = (ii > jj) ? beta[ii] * ckk[r] * dec : 0.f;
                        AmB[ii * 72 + jj] = f2bf(-aval);
                        if (mt == nt) Ad[mt * 256 + (ii & 15) * 16 + (jj & 15)] = aval;
                        AT[ii * 72 + jj] = f2bf((ii >= jj) ? cqk[r] * dec : 0.f);
                    }
                }
            }
            lds_barrier();
            if (w == 0) {
                const int b = lane >> 4, c = lane & 15;
                const float* ad = Ad + b * 256;
                float x[16];
    #pragma unroll
                for (int i = 0; i < 16; ++i) {
                    float a = (i == c) ? 1.f : 0.f;
    #pragma unroll
                    for (int j = 0; j < i; ++j) a -= ad[i * 16 + j] * x[j];
                    x[i] = a;
                }
    #pragma unroll
                for (int i = 0; i < 16; ++i) Tb[b * 256 + i * 16 + c] = x[i];
            } else {
                const float glast = gcs[63];
                for (int idx = tid - 64; idx < 4096; idx += 448) {
                    const int d = idx & 63, j = idx >> 6;
                    KTT[d * 72 + j] = f2bf(bf2f(Kb[j * 72 + d]) * fexp_(glast - gcs[j]));
                }
                if (tid == 64) __hip_atomic_store(&GCD[u], fexp_(glast), __ATOMIC_RELAXED, __HIP_MEMORY_SCOPE_AGENT);
            }
            lds_barrier();
            if (!(SKIP & 1)) {
                const int cidx = w * 16 + fr;
                bf16_t* xt = (cidx < 64) ? (UT + cidx * 72) : (WT + (cidx - 64) * 72);
                const bf16x8 zf = {0, 0, 0, 0, 0, 0, 0, 0};
    #pragma unroll
                for (int b = 0; b < 4; ++b) {
                    f32x4 G;
    #pragma unroll
                    for (int r = 0; r < 4; ++r) { const int i = b * 16 + fq * 4 + r; float v = beta[i] * XS[i * 128 + cidx]; if (cidx >= 64) v *= eg[i]; G[r] = v; }
    #pragma unroll
                    for (int ks = 0; ks < (b + 1) / 2; ++ks) {
                        const int k0 = ks * 32 + fq * 8;
                        const bool ok = k0 < b * 16;
                        const bf16x8 af = ok ? ld_frag(AmB + (b * 16 + fr) * 72 + k0) : zf;
                        const bf16x8 bfv = ok ? ld_frag(xt + k0) : zf;
                        G = mfma16(af, bfv, G);
                    }
                    f32x4 X = (f32x4){0.f, 0.f, 0.f, 0.f};
    #pragma unroll
                    for (int ks = 0; ks < 4; ++ks) X = __builtin_amdgcn_mfma_f32_16x16x4f32(Tb[b * 256 + fr * 16 + fq * 4 + ks], G[ks], X, 0, 0, 0);
                    u32x2 o; o.x = pk2(X[0], X[1]); o.y = pk2(X[2], X[3]);
                    *(u32x2*)(xt + b * 16 + fq * 4) = o;
                }
            }
            lds_barrier();
            if (!(SKIP & 4)) {
                bf16_t* ub = Hb + (size_t)gdn_slot(u) * 16384;
                const int prod = w >> 1, half = w & 1;
                const bf16_t* Xs = (prod == 0 || prod == 2) ? KTT : AT;
                const bf16_t* Ys = (prod == 0 || prod == 1) ? WT : UT;
                f32x4 acc[2][4];
    #pragma unroll
                for (int m = 0; m < 2; ++m)
    #pragma unroll
                    for (int n = 0; n < 4; ++n) acc[m][n] = (f32x4){0.f, 0.f, 0.f, 0.f};
    #pragma unroll
                for (int ks = 0; ks < 2; ++ks) {
                    bf16x8 fx[2], fy[4];
    #pragma unroll
                    for (int m = 0; m < 2; ++m) fx[m] = ld_frag(Xs + ((half * 2 + m) * 16 + fr) * 72 + ks * 32 + fq * 8);
    #pragma unroll
                    for (int n = 0; n < 4; ++n) fy[n] = ld_frag(Ys + (n * 16 + fr) * 72 + ks * 32 + fq * 8);
                    if (prod != 2) {
    #pragma unroll
                        for (int m = 0; m < 2; ++m)
    #pragma unroll
                            for (int n = 0; n < 4; ++n) acc[m][n] = mfma16(fy[n], fx[m], acc[m][n]);
                    } else {
    #pragma unroll
                        for (int m = 0; m < 2; ++m)
    #pragma unroll
                            for (int n = 0; n < 4; ++n) acc[m][n] = mfma16(fx[m], fy[n], acc[m][n]);
                    }
                }
    #pragma unroll
                for (int m = 0; m < 2; ++m) {
                    const int mt = half * 2 + m;
    #pragma unroll
                    for (int n = 0; n < 4; ++n) {
                        u32x2 o;
                        if (prod == 0) {
                            o.x = pk2(-acc[m][n][0], -acc[m][n][1]); o.y = pk2(-acc[m][n][2], -acc[m][n][3]);
                            *(u32x2*)(ub + (mt * 2 + (n >> 1)) * 512 + lane * 8 + (n & 1) * 4) = o;
                        } else if (prod == 1) {
                            const int ii = mt * 16 + fr; const float e = eg[ii];
                            const u32x2 qv = *(const u32x2*)(Qb + ii * 72 + n * 16 + fq * 4);
                            o.x = pk2(bflo(qv.x) * e - acc[m][n][0], bfhi(qv.x) * e - acc[m][n][1]); o.y = pk2(bflo(qv.y) * e - acc[m][n][2], bfhi(qv.y) * e - acc[m][n][3]);
                            *(u32x2*)(ub + 4096 + (mt * 2 + (n >> 1)) * 512 + lane * 8 + (n & 1) * 4) = o;
                        } else if (prod == 2) {
                            o.x = pk2(acc[m][n][0], acc[m][n][1]); o.y = pk2(acc[m][n][2], acc[m][n][3]);
                            *(u32x2*)(ub + 8192 + (n * 2 + (mt >> 1)) * 512 + lane * 8 + (mt & 1) * 4) = o;
                        } else {
                            o.x = pk2(acc[m][n][0], acc[m][n][1]); o.y = pk2(acc[m][n][2], acc[m][n][3]);
                            *(u32x2*)(ub + 12288 + (n * 2 + (mt >> 1)) * 512 + lane * 8 + (mt & 1) * 4) = o;
                        }
                    }
                }
            }
            lds_barrier();
        }
}

template <int MODE  >
__device__ __forceinline__ void ph_scan(const Params& p, const int l_in) {
    extern __shared__ __attribute__((aligned(16))) char smem[];
    int tid_ = threadIdx.x; asm volatile("" : "+v"(tid_));
    int blk_ = blockIdx.x; asm volatile("" : "+s"(blk_));
    unsigned long long w64_ = (unsigned long long)p.ws; asm volatile("" : "+s"(w64_));
    char* ws_ = (char*)(__attribute__((address_space(1))) char*)w64_;
    int l_ = l_in; asm volatile("" : "+v"(l_)); const int l = __builtin_amdgcn_readfirstlane(l_);
    const int tid = tid_, lane = tid & 63, w = tid >> 6;
    int grid_ = gridDim.x; asm volatile("" : "+s"(grid_));
    const int blk = blk_, grid = grid_;
    const int fr = lane & 15, fq = lane >> 4;
    char* const ws = ws_;
    const float* const modl = MOD + (size_t)l * 8 * 6144;
    (void)lane; (void)w; (void)fr; (void)fq; (void)modl; (void)smem; (void)blk; (void)grid;
        unsigned* const late_cnt = (unsigned*)(ws + OFF_CNT) + 1024 + l * 64;
        if (blk >= 128 && MODE == 0 && grid == 256) {
            ph_rwprep(p, l, 1, blk - 128, 128);
            asm volatile("s_waitcnt vmcnt(0)" ::: "memory");
            __syncthreads();
            if (tid == 0) {
                __builtin_amdgcn_fence(__ATOMIC_RELEASE, "agent");
                asm volatile("s_waitcnt vmcnt(0)" ::: "memory");
                __hip_atomic_fetch_add(late_cnt, 1u, __ATOMIC_RELAXED, __HIP_MEMORY_SCOPE_AGENT);
            }
        }
        if (blk >= 128 && !DBG_NO_GDN && MODE != 1 && MODE < 8) {
            if (MODE != 3 && MODE != 5) { ph_conv(p, l, blk - 128, grid - 128); ph_sgu(p, l, blk - 128, grid - 128); }
            if (MODE != 4) ph_gdn1(p, l, GDN_U1 + blk - 128, grid - 128, 4096);
            unsigned* sb = (unsigned*)(ws + OFF_CNT) + l * 64;
            asm volatile("s_waitcnt vmcnt(0)" ::: "memory");
            __syncthreads();
            if (tid == 0) {
                __builtin_amdgcn_fence(__ATOMIC_RELEASE, "agent");
                asm volatile("s_waitcnt vmcnt(0)" ::: "memory");
                __hip_atomic_fetch_add(sb, 1u, __ATOMIC_RELAXED, __HIP_MEMORY_SCOPE_AGENT);
                if (blk < 160) {
                    unsigned sp = 0;
                    while (__hip_atomic_load(sb, __ATOMIC_RELAXED, __HIP_MEMORY_SCOPE_AGENT) < (unsigned)(grid - 128)) { __builtin_amdgcn_s_sleep(2); if (++sp > (1u << 24)) break; }
                    __builtin_amdgcn_fence(__ATOMIC_ACQUIRE, "agent");
                    asm volatile("s_waitcnt vmcnt(0)" ::: "memory");
                }
            }
            __syncthreads();
        }
        for (int role = blk; role < 160; role += grid) {
            if (role < 128) {
                if (DBG_NO_RWKV || DBG_RWKV_NOSCAN || (MODE >= 2 && MODE != 11)) continue;
                const int bh = role >> 2, rg = role & 3, b = bh >> 2, hd = bh & 3;
                const size_t tb = (size_t)b * SEQ;
                constexpr int SST = 340;
                float* ybuf = (float*)smem;
                float* tilebuf = ybuf + 2 * 8192;
                static_assert(2 * 33 * SST * 4 + 2 * 8192 * 4 <= LDS_XB_OFF, "RWKV scan LDS image overlaps the grid barrier's LDS words");
                f32x2 sA = {0.f, 0.f}, sB = {0.f, 0.f}; float dcur = 0.f;
                const int kq = lane & 15, rsub = lane >> 4;
                int li = tid - 256;
                struct LT { float4 c0, c1; u32x4 kraw, zraw, mraw, rraw; unsigned vv; };
                auto fetch_tile = [&](int tt_, LT& x) {
                    const int tt = tt_ < 256 ? tt_ : 255;
                    const int s = li >> 3, part = li & 7;
                    const size_t tbase = (tb + (size_t)tt * 32) * 256;
                    const unsigned vo16 = (unsigned)((s * 256 + hd * 64 + part * 8) * 2), vo32 = vo16 * 2u, vov = (unsigned)((s * 256 + hd * 64 + rg * 16 + part * 2) * 2);
                    x.c0 = *(const float4*)((const char*)(RW_CE + tbase) + vo32); x.c1 = *(const float4*)((const char*)(RW_CE + tbase + 4) + vo32);
                    x.kraw = *(const u32x4*)((const char*)(RW_KK + tbase + 256) + vo16);
                    x.zraw = *(const u32x4*)((const char*)(RW_ZB + tbase) + vo16); x.mraw = *(const u32x4*)((const char*)(RW_KM + tbase) + vo16); x.rraw = *(const u32x4*)((const char*)(RW_R + tbase) + vo16);
                    x.vv = *(const unsigned*)((const char*)(RW_V + tbase) + vov);
                };
                auto commit_tile = [&](int tt, int buf, const LT& x) {
                    const int s = li >> 3, part = li & 7;
                    const int pos = tt * 32 + s;
                    float* dst = tilebuf + (size_t)buf * (33 * SST) + s * SST;
                    const float4 c0 = x.c0, c1 = x.c1;
                    u32x4 kraw = x.kraw;
                    if (!(pos + 1 < SEQ)) kraw = (u32x4){0u, 0u, 0u, 0u};
                    const u32x4 zraw = x.zraw, mraw = x.mraw, rraw = x.rraw;
                    const unsigned vv = x.vv;
                    const float ce[8] = {c0.x, c0.y, c0.z, c0.w, c1.x, c1.y, c1.z, c1.w};
                    float P[8], kn[8], f[8], o[8];
    #pragma unroll
                    for (int i = 0; i < 8; ++i) P[i] = fexp_(ce[i]);
                    unpack8(kraw, kn);
    #pragma unroll
                    for (int i = 0; i < 8; ++i) o[i] = P[i] * kn[i];
                    *(float4*)(dst + part * 8) = make_float4(o[0], o[1], o[2], o[3]); *(float4*)(dst + part * 8 + 4) = make_float4(o[4], o[5], o[6], o[7]);
                    unpack8(rraw, f);
    #pragma unroll
                    for (int i = 0; i < 8; ++i) o[i] = f[i] * P[i];
                    *(float4*)(dst + 192 + part * 8) = make_float4(o[0], o[1], o[2], o[3]); *(float4*)(dst + 192 + part * 8 + 4) = make_float4(o[4], o[5], o[6], o[7]);
                    if (s == 31) { float* pl = tilebuf + (size_t)buf * (33 * SST) + 32 * SST + part * 8;
                        *(float4*)pl = make_float4(P[0], P[1], P[2], P[3]); *(float4*)(pl + 4) = make_float4(P[4], P[5], P[6], P[7]); }
    #pragma unroll
                    for (int i = 0; i < 8; ++i) P[i] = fexp_(-ce[i]);
                    float al = 0.f, be = 0.f;
                    unpack8(zraw, f);
    #pragma unroll
                    for (int i = 0; i < 8; ++i) { al += f[i] * kn[i]; o[i] = f[i] * P[i]; }
                    *(float4*)(dst + 64 + part * 8) = make_float4(o[0], o[1], o[2], o[3]); *(float4*)(dst + 64 + part * 8 + 4) = make_float4(o[4], o[5], o[6], o[7]);
                    unpack8(mraw, f);
    #pragma unroll
                    for (int i = 0; i < 8; ++i) { be += f[i] * kn[i]; o[i] = f[i] * P[i]; }
                    *(float4*)(dst + 128 + part * 8) = make_float4(o[0], o[1], o[2], o[3]); *(float4*)(dst + 128 + part * 8 + 4) = make_float4(o[4], o[5], o[6], o[7]);
                    al += __shfl_xor(al, 1); al += __shfl_xor(al, 2); al += __shfl_xor(al, 4);
                    be += __shfl_xor(be, 1); be += __shfl_xor(be, 2); be += __shfl_xor(be, 4);
                    {
                        const float v0 = bflo(vv), v1 = bfhi(vv);
                        *(float4*)(dst + 256 + part * 8) = make_float4(v0, al, v0 * be * (1.0f / 32.0f), 0.f);
                        *(float4*)(dst + 256 + part * 8 + 4) = make_float4(v1, al, v1 * be * (1.0f / 32.0f), 0.f);
                    }
                };
                auto flush_y = [&](int tt, int buf) {
                    const int s = li >> 3, part = li & 7;
                    const float* yb = ybuf + buf * 8192 + s * 256 + part * 32;
                    float y2[2];
    #pragma unroll
                    for (int r = 0; r < 2; ++r) {
                        const float4 a = *(const float4*)(yb + r * 16), b4 = *(const float4*)(yb + r * 16 + 4), c4 = *(const float4*)(yb + r * 16 + 8), d4 = *(const float4*)(yb + r * 16 + 12);
                        y2[r] = ((a.x + a.y) + (a.z + a.w)) + ((b4.x + b4.y) + (b4.z + b4.w)) + ((c4.x + c4.y) + (c4.z + c4.w)) + ((d4.x + d4.y) + (d4.z + d4.w));
                    }
                    *(unsigned*)((char*)(YR + ((size_t)(bh * 4 + rg) * SEQ + (size_t)tt * 32) * 16) + (unsigned)((s * 16 + part * 2) * 2)) = pk2(y2[0], y2[1]);
                };
                LT R0;
                if (w >= 4) { fetch_tile(0, R0); commit_tile(0, 0, R0); fetch_tile(1, R0); }
                lds_barrier();
                if (w < 4) __builtin_amdgcn_s_setprio(3);
                for (int tt = 0; tt < 256; ++tt) {
                    const int buf = tt & 1;
                    if (w >= 4 && MODE == 11) {
                    } else if (w >= 4) {
                        asm volatile("" : "+v"(li));
                        if (MODE == 0 && grid == 256 && tt == 2 * RW_EARLY - 4) {
                            unsigned sp = 0;
                            while (__hip_atomic_load(late_cnt, __ATOMIC_RELAXED, __HIP_MEMORY_SCOPE_AGENT) < 128u) { __builtin_amdgcn_s_sleep(2); if (++sp > (1u << 24)) break; }
                            __builtin_amdgcn_fence(__ATOMIC_ACQUIRE, "agent");
                        }
                        if (tt + 1 < 256) commit_tile(tt + 1, buf ^ 1, R0);
                        fetch_tile(tt + 2, R0);
                        if (tt > 0) flush_y(tt - 1, buf ^ 1);
                    } else {
                        const int lr = w * 4 + rsub;
                        int o_vec = (2 * 8192 + buf * (33 * SST) + kq * 4) * 4, o_rec = (2 * 8192 + buf * (33 * SST) + 256 + lr * 4) * 4, o_y = (buf * 8192 + lr * 16 + kq) * 4;
                        asm volatile("" : "+v"(o_vec), "+v"(o_rec), "+v"(o_y));
                        const float* tv = (const float*)(smem + o_vec); const float* trc = (const float*)(smem + o_rec); float* yb = (float*)(smem + o_y);
                        float4 cu = *(const float4*)(tv), czb = *(const float4*)(tv + 64), ckm = *(const float4*)(tv + 128), cr = *(const float4*)(tv + 192);
                        typedef float f32x3_t __attribute__((ext_vector_type(3)));
                        f32x3_t crec = *(const f32x3_t*)(trc);
    #pragma unroll 8
                        for (int s = 0; s < 32; ++s) {
                            const int sn = ((s + 1) & 31) * SST;
                            const float4 nu = *(const float4*)(tv + sn), nzb = *(const float4*)(tv + sn + 64), nkm = *(const float4*)(tv + sn + 128), nr = *(const float4*)(tv + sn + 192);
                            const f32x3_t nrec = *(const f32x3_t*)(trc + sn);
                            __builtin_amdgcn_sched_barrier(0);
                            const f32x2 uA = {cu.x, cu.y}, uB = {cu.z, cu.w}, zA = {czb.x, czb.y}, zB = {czb.z, czb.w}, kA = {ckm.x, ckm.y}, kB = {ckm.z, ckm.w};
                            const f32x2 rA = {cr.x, cr.y}, rB = {cr.z, cr.w};
                            const f32x2 gg = {crec.z, crec.z};
                            const f32x2 ep = sA * uA + (sB * uB + gg);
                            const float e = rowsum16(ep.x + ep.y);
                            const f32x2 nd = {-dcur, -dcur}, vv = {crec.x, crec.x};
                            const f32x2 tA = kA * vv + sA, tB = kB * vv + sB;
                            sA = zA * nd + tA;
                            sB = zB * nd + tB;
                            const f32x2 yp = sA * rA + sB * rB;
                            yb[s * 256] = yp.x + yp.y;
                            dcur = e - dcur * crec.y;
                            cu = nu; czb = nzb; ckm = nkm; cr = nr; crec = nrec;
                            __builtin_amdgcn_sched_barrier(0);
                        }
                        {
                            const float4 pl = *(const float4*)(tv + 32 * SST);
                            const f32x2 pA = {pl.x, pl.y}, pB = {pl.z, pl.w};
                            sA = sA * pA; sB = sB * pB;
                        }
                    }
                    lds_barrier();
                }
                __builtin_amdgcn_s_setprio(0);
                if (w >= 4 && MODE != 11) flush_y(255, 1);
                lds_barrier();
            } else {
                if (DBG_NO_GDN || MODE == 1 || MODE == 4 || MODE == 5 || MODE == 6) continue;
                const int bh = role - 128, b = bh >> 2, hd = bh & 3;
                {
                    const int c0 = w * 16;
                    const unsigned vM = (unsigned)(fr * 2048 + c0 * 2 + fq * 8);
                    f32x4 S[4];
    #pragma unroll
                    for (int t = 0; t < 4; ++t) S[t] = (f32x4){0.f, 0.f, 0.f, 0.f};
                    const int lw = tid - 256;
                    struct LU { u32x4 d[8]; float cd; };
                    auto fetch = [&](int n, LU& x) {
                        const int u = b * 512 + hd * 128 + (n < 128 ? n : 127);
                        const char* ub = (const char*)Hb + (size_t)gdn_slot(u) * 32768;
    #pragma unroll
                        for (int i = 0; i < 8; ++i) x.d[i] = *(const u32x4*)((ub + i * 4096) + (unsigned)(lw * 16));
                        x.cd = GCD[u];
                    };
                    auto iter = [&](int it, LU& x) {
                        if (w >= 4) {
                            if (it < 128) {
                                char* Ls = smem + (it & 1) * 32768;
    #pragma unroll
                                for (int i = 0; i < 8; ++i) *(u32x4*)(Ls + i * 4096 + lw * 16) = x.d[i];
                                if (lw == 0) *(float*)(smem + 65536 + (it & 1) * 16) = x.cd;
                                fetch(it + 2, x);
                            }
                        } else if (it >= 1 && it <= 128) {
                            const int n = it - 1;
                            const char* Ls = smem + (n & 1) * 32768;
                            const float cd = *(const float*)(smem + 65536 + (n & 1) * 16);
                            u32x4 nq[2], oq[2];
    #pragma unroll
                            for (int pr = 0; pr < 2; ++pr) { nq[pr] = *(const u32x4*)(Ls + 16384 + (w * 2 + pr) * 1024 + lane * 16); oq[pr] = *(const u32x4*)(Ls + 24576 + (w * 2 + pr) * 1024 + lane * 16); }
                            bf16x8 bS[2];
    #pragma unroll
                            for (int ks = 0; ks < 2; ++ks) {
                                u32x4 t4; t4.x = pk2(S[2 * ks][0], S[2 * ks][1]); t4.y = pk2(S[2 * ks][2], S[2 * ks][3]); t4.z = pk2(S[2 * ks + 1][0], S[2 * ks + 1][1]); t4.w = pk2(S[2 * ks + 1][2], S[2 * ks + 1][3]);
                                bS[ks] = __builtin_bit_cast(bf16x8, t4);
                            }
                            const size_t t0 = (size_t)b * SEQ + (size_t)n * 64;
    #pragma unroll
                            for (int mt = 0; mt < 4; ++mt) {
                                const unsigned nlo = (mt & 1) ? nq[mt >> 1].z : nq[mt >> 1].x, nhi = (mt & 1) ? nq[mt >> 1].w : nq[mt >> 1].y;
                                f32x4 sn = (f32x4){cd * S[mt][0] + bflo(nlo), cd * S[mt][1] + bfhi(nlo), cd * S[mt][2] + bflo(nhi), cd * S[mt][3] + bfhi(nhi)};
                                const bf16x8 w0 = *(const bf16x8*)(Ls + (mt * 2 + 0) * 1024 + lane * 16), w1 = *(const bf16x8*)(Ls + (mt * 2 + 1) * 1024 + lane * 16);
                                sn = mfma16(w0, bS[0], sn); sn = mfma16(w1, bS[1], sn);
                                S[mt] = sn;
                            }
    #pragma unroll
                            for (int mt = 0; mt < 4; ++mt) {
                                const unsigned olo = (mt & 1) ? oq[mt >> 1].z : oq[mt >> 1].x, ohi = (mt & 1) ? oq[mt >> 1].w : oq[mt >> 1].y;
                                f32x4 oa = (f32x4){bflo(olo), bfhi(olo), bflo(ohi), bfhi(ohi)};
                                const bf16x8 p0 = *(const bf16x8*)(Ls + 8192 + (mt * 2 + 0) * 1024 + lane * 16), p1 = *(const bf16x8*)(Ls + 8192 + (mt * 2 + 1) * 1024 + lane * 16);
                                oa = mfma16(bS[0], p0, oa); oa = mfma16(bS[1], p1, oa);
                                u32x2 ov; ov.x = pk2(oa[0], oa[1]); ov.y = pk2(oa[2], oa[3]);
                                *(u32x2*)(((char*)MIX + (t0 + mt * 16) * 2048 + hd * 128) + vM) = ov;
                            }
                        }
                        lds_barrier();
                    };
                    LU R0, R1;
                    if (w >= 4) { fetch(0, R0); fetch(1, R1); }
    #pragma unroll 1
                    for (int it = 0; it < 130; it += 2) {
                        iter(it, R0);
                        iter(it + 1, R1);
                    }
                }
                lds_barrier();
            }
        }
        {
            int cw, ncw;
            if (grid > 160) { cw = blk - 160; ncw = grid - 160; } else { cw = blk; ncw = grid; }
            float* tile = (float*)smem;
            if (cw >= 0 && MODE != 1 && MODE != 5 && MODE != 7 && MODE < 8) {
                auto make_job = [&](int idx) {
                    const int which = idx >> 12, rem = idx & 4095, e = rem >> 6, r2 = rem & 63;
                    TrJob j;
                    if (which < 2) { const int kt = r2 >> 2, nt = r2 & 3;
                        j.src = INP(32) + ((size_t)l * 64 + e) * 1024 * 256; if (which == 1) j.src = INP(33) + ((size_t)l * 64 + e) * 1024 * 256;
                        j.ld = 256; j.k0 = kt * 64; j.n0 = nt * 64; j.Ndim = 256; j.dst = WGU + (size_t)e * 512 * 1024; j.dst_ld = 1024; j.mode = 1; j.up = which; }
                    else { const int kt = r2 >> 4, nt = r2 & 15;
                        j.src = INP(34) + ((size_t)l * 64 + e) * 256 * 1024; j.ld = 1024; j.k0 = kt * 64; j.n0 = nt * 64; j.Ndim = 1024; j.dst = WD + (size_t)e * 1024 * 256; j.dst_ld = 256; j.mode = 0; j.up = 0; }
                    return j;
                };
                for (int idx = cw; idx < 12288; idx += 2 * ncw) {
                    const bool haveB = idx + ncw < 12288;
                    const TrJob ja = make_job(idx), jb = make_job(haveB ? idx + ncw : idx);
                    tr_pair(tid, tile, tile + 64 * 65 + 16, ja, jb, haveB);
                }
            }
        }
}

__device__ __forceinline__ void ph_post(const Params& p, const int l_in) {
    extern __shared__ __attribute__((aligned(16))) char smem[];
    int tid_ = threadIdx.x; asm volatile("" : "+v"(tid_));
    int blk_ = blockIdx.x; asm volatile("" : "+s"(blk_));
    unsigned long long w64_ = (unsigned long long)p.ws; asm volatile("" : "+s"(w64_));
    char* ws_ = (char*)(__attribute__((address_space(1))) char*)w64_;
    int l_ = l_in; asm volatile("" : "+v"(l_)); const int l = __builtin_amdgcn_readfirstlane(l_);
    const int tid = tid_, lane = tid & 63, w = tid >> 6;
    int grid_ = gridDim.x; asm volatile("" : "+s"(grid_));
    const int blk = blk_, grid = grid_;
    const int fr = lane & 15, fq = lane >> 4;
    char* const ws = ws_;
    const float* const modl = MOD + (size_t)l * 8 * 6144;
    (void)lane; (void)w; (void)fr; (void)fq; (void)modl; (void)smem; (void)blk; (void)grid;
        const float* ng = INP(11) + l * 64;
        const float* gng = INP(26) + l * 256; const float* gnb = INP(27) + l * 256; const float* rk = INP(25) + l * 256;
        const int ch = lane * 4;
        const float4 ng4 = *(const float4*)(ng + (ch & 63));
        const float4 gg4 = *(const float4*)(gng + ch), gb4 = *(const float4*)(gnb + ch), rk4 = *(const float4*)(rk + ch);
        struct PostIn { u32x2 ov, zv, yv, rv, kv, vv, gv; };
        auto load_in = [&](size_t t) {
            PostIn q;
            q.ov = *(const u32x2*)(MIX + t * 1024 + ch);
            q.zv = *(const u32x2*)(Pb + t * PW + PC_Z + ch);
            q.yv = *(const u32x2*)(YR + ((size_t)(((t >> 13) * 4 + (lane >> 4)) * 4 + ((lane & 15) >> 2)) * SEQ + (t & (SEQ - 1))) * 16 + (lane & 3) * 4);
            q.rv = *(const u32x2*)(RW_R + t * 256 + ch);
            q.kv = *(const u32x2*)(RW_KM + t * 256 + ch);
            q.vv = *(const u32x2*)(RW_V + t * 256 + ch);
            q.gv = *(const u32x2*)(RW_G + t * 256 + ch);
            return q;
        };
        const size_t tstride = (size_t)grid * 8;
        size_t t = (size_t)blk * 8 + w;
        PostIn cur = load_in(t < T_TOK ? t : 0);
        for (; t < T_TOK; t += tstride) {
            const PostIn nxt = load_in(t + tstride < T_TOK ? t + tstride : t);
            {
                const u32x2 ov = cur.ov, zv = cur.zv;
                const float o[4] = {bflo(ov.x), bfhi(ov.x), bflo(ov.y), bfhi(ov.y)};
                const float z[4] = {bflo(zv.x), bfhi(zv.x), bflo(zv.y), bfhi(zv.y)};
                const float ms = rowsum16(o[0] * o[0] + o[1] * o[1] + o[2] * o[2] + o[3] * o[3]) * (1.0f / 64.0f);
                const float rs = rsqrtf(ms + 1e-6f);
                u32x2 r;
                r.x = pk2(o[0] * rs * ng4.x * siluf_(z[0]), o[1] * rs * ng4.y * siluf_(z[1]));
                r.y = pk2(o[2] * rs * ng4.z * siluf_(z[2]), o[3] * rs * ng4.w * siluf_(z[3]));
                *(u32x2*)(MIX + t * 1024 + ch) = r;
            }
            {
                const u32x2 yv = cur.yv, rv = cur.rv, kv = cur.kv, vv = cur.vv, gv = cur.gv;
                const float y[4] = {bflo(yv.x), bfhi(yv.x), bflo(yv.y), bfhi(yv.y)};
                const float mean = rowsum16(y[0] + y[1] + y[2] + y[3]) * (1.0f / 64.0f);
                const float d[4] = {y[0] - mean, y[1] - mean, y[2] - mean, y[3] - mean};
                const float var = rowsum16(d[0] * d[0] + d[1] * d[1] + d[2] * d[2] + d[3] * d[3]) * (1.0f / 64.0f);
                const float rs = rsqrtf(var + 64e-5f);
                const float bon = rowsum16(bflo(rv.x) * bflo(kv.x) * rk4.x + bfhi(rv.x) * bfhi(kv.x) * rk4.y + bflo(rv.y) * bflo(kv.y) * rk4.z + bfhi(rv.y) * bfhi(kv.y) * rk4.w);
                u32x2 r;
                r.x = pk2((d[0] * rs * gg4.x + gb4.x + bon * bflo(vv.x)) * bflo(gv.x), (d[1] * rs * gg4.y + gb4.y + bon * bfhi(vv.x)) * bfhi(gv.x));
                r.y = pk2((d[2] * rs * gg4.z + gb4.z + bon * bflo(vv.y)) * bflo(gv.y), (d[3] * rs * gg4.w + gb4.w + bon * bfhi(vv.y)) * bfhi(gv.y));
                *(u32x2*)(MIX + t * 1024 + 768 + ch) = r;
            }
            cur = nxt;
        }
}

template <int PROBE = 0>
__device__ __forceinline__ void ph_outproj(const Params& p, const int l_in) {
    extern __shared__ __attribute__((aligned(16))) char smem[];
    int tid_ = threadIdx.x; asm volatile("" : "+v"(tid_));
    int blk_ = blockIdx.x; asm volatile("" : "+s"(blk_));
    unsigned long long w64_ = (unsigned long long)p.ws; asm volatile("" : "+s"(w64_));
    char* ws_ = (char*)(__attribute__((address_space(1))) char*)w64_;
    int l_ = l_in; asm volatile("" : "+v"(l_)); const int l = __builtin_amdgcn_readfirstlane(l_);
    const int tid = tid_, lane = tid & 63, w = tid >> 6;
    int grid_ = gridDim.x; asm volatile("" : "+s"(grid_));
    const int blk = blk_, grid = grid_;
    const int fr = lane & 15, fq = lane >> 4;
    char* const ws = ws_;
    const float* const modl = MOD + (size_t)l * 8 * 6144;
    (void)lane; (void)w; (void)fr; (void)fq; (void)modl; (void)smem; (void)blk; (void)grid;
        g8::StaticOrder S; S.init(T_TOK, 1024, grid, blk);
        Ep8Outproj ep{(l == 0) ? x_in : (const float*)nullptr, XB, PROBE ? XB_LAST : XB_MID(l), modl};
        gemm8<Ep8Outproj, g8::StaticOrder, false>(tid, (LAS unsigned char*)smem, (const char*)MIX, (const char*)(WOUT + (size_t)l * 1024 * 1024), 1024, S, ep, 0u, 0u);
}

__device__ __forceinline__ void ph_norm2(const Params& p, const int l_in, const int own_tile  ) {
    extern __shared__ __attribute__((aligned(16))) char smem[];
    int tid_ = threadIdx.x; asm volatile("" : "+v"(tid_));
    int blk_ = blockIdx.x; asm volatile("" : "+s"(blk_));
    unsigned long long w64_ = (unsigned long long)p.ws; asm volatile("" : "+s"(w64_));
    char* ws_ = (char*)(__attribute__((address_space(1))) char*)w64_;
    int l_ = l_in; asm volatile("" : "+v"(l_)); const int l = __builtin_amdgcn_readfirstlane(l_);
    const int tid = tid_, lane = tid & 63, w = tid >> 6;
    int grid_ = gridDim.x; asm volatile("" : "+s"(grid_));
    const int blk = blk_, grid = grid_;
    const int fr = lane & 15, fq = lane >> 4;
    char* const ws = ws_;
    const float* const modl = MOD + (size_t)l * 8 * 6144;
    (void)lane; (void)w; (void)fr; (void)fq; (void)modl; (void)smem; (void)blk; (void)grid;
        const float* gn = INP(5) + l * 1024;
        const int gw = blk * 8 + w, nw = grid * 8;
        for (int r0 = (own_tile >= 0 ? own_tile * 256 + w * 32 : gw * 32); r0 < (own_tile >= 0 ? own_tile * 256 + w * 32 + 32 : T_TOK); r0 += nw * 32) {
            const int b = r0 >> 13;
            float gs[16], sh[16];
    #pragma unroll
            for (int j = 0; j < 4; ++j) {
                const int c = j * 256 + lane * 4;
                const float4 g4 = *(const float4*)(gn + c);
                const float4 sc4 = *(const float4*)(modl + b * 6144 + 4 * 1024 + c);
                const float4 sh4 = *(const float4*)(modl + b * 6144 + 3 * 1024 + c);
                gs[j * 4 + 0] = g4.x * (1.f + sc4.x); gs[j * 4 + 1] = g4.y * (1.f + sc4.y); gs[j * 4 + 2] = g4.z * (1.f + sc4.z); gs[j * 4 + 3] = g4.w * (1.f + sc4.w);
                sh[j * 4 + 0] = sh4.x; sh[j * 4 + 1] = sh4.y; sh[j * 4 + 2] = sh4.z; sh[j * 4 + 3] = sh4.w;
            }
            const bf16_t* xsrc = XB_MID(l);
            u32x2 cur[4][4], nxt[4][4];
    #pragma unroll
            for (int q = 0; q < 4; ++q)
    #pragma unroll
                for (int j = 0; j < 4; ++j) cur[q][j] = *(const u32x2*)(xsrc + (size_t)(r0 + q) * 1024 + j * 256 + lane * 4);
            for (int rg = r0; rg < r0 + 32; rg += 4) {
                const int rn = (rg + 4 < r0 + 32) ? rg + 4 : rg;
    #pragma unroll
                for (int q = 0; q < 4; ++q)
    #pragma unroll
                    for (int j = 0; j < 4; ++j) nxt[q][j] = *(const u32x2*)(xsrc + (size_t)(rn + q) * 1024 + j * 256 + lane * 4);
    #pragma unroll
                for (int q = 0; q < 4; ++q) {
                    const int r = rg + q;
                    float xv[16]; float ss = 0.f;
    #pragma unroll
                    for (int j = 0; j < 4; ++j) {
                        const u32x2 xb = cur[q][j];
                        const float4 v = make_float4(bflo(xb.x), bfhi(xb.x), bflo(xb.y), bfhi(xb.y));
                        xv[j * 4 + 0] = v.x; xv[j * 4 + 1] = v.y; xv[j * 4 + 2] = v.z; xv[j * 4 + 3] = v.w;
                        ss += v.x * v.x + v.y * v.y + v.z * v.z + v.w * v.w;
                    }
                    ss = wave_sum(ss);
                    const float rs = rsqrtf(ss * (1.0f / 1024.0f) + 1e-6f);
    #pragma unroll
                    for (int j = 0; j < 4; ++j) {
                        const int c = j * 256 + lane * 4;
                        u32x2 o;
                        o.x = pk2(xv[j * 4 + 0] * rs * gs[j * 4 + 0] + sh[j * 4 + 0], xv[j * 4 + 1] * rs * gs[j * 4 + 1] + sh[j * 4 + 1]);
                        o.y = pk2(xv[j * 4 + 2] * rs * gs[j * 4 + 2] + sh[j * 4 + 2], xv[j * 4 + 3] * rs * gs[j * 4 + 3] + sh[j * 4 + 3]);
                        *(u32x2*)(Hb + (size_t)r * 1024 + c) = o;
                    }
                }
    #pragma unroll
                for (int q = 0; q < 4; ++q)
    #pragma unroll
                    for (int j = 0; j < 4; ++j) cur[q][j] = nxt[q][j];
            }
        }
        for (int i = blk * 512 + tid; i < MAXROWS; i += grid * 512) ROWTOK[i] = -1;
}

__device__ __forceinline__ void ph_router(const Params& p, const int l_in, const int own_tile) {
    extern __shared__ __attribute__((aligned(16))) char smem[];
    int tid_ = threadIdx.x; asm volatile("" : "+v"(tid_));
    int blk_ = blockIdx.x; asm volatile("" : "+s"(blk_));
    unsigned long long w64_ = (unsigned long long)p.ws; asm volatile("" : "+s"(w64_));
    char* ws_ = (char*)(__attribute__((address_space(1))) char*)w64_;
    int l_ = l_in; asm volatile("" : "+v"(l_)); const int l = __builtin_amdgcn_readfirstlane(l_);
    const int tid = tid_, lane = tid & 63, w = tid >> 6;
    int grid_ = gridDim.x; asm volatile("" : "+s"(grid_));
    const int blk = blk_, grid = grid_;
    const int fr = lane & 15, fq = lane >> 4;
    char* const ws = ws_;
    const float* const modl = MOD + (size_t)l * 8 * 6144;
    (void)lane; (void)w; (void)fr; (void)fq; (void)modl; (void)smem; (void)blk; (void)grid;
        Ep8Logit ep{LOGIT};
        if (own_tile >= 0) { g8::OneUnit S{own_tile}; gemm8<Ep8Logit, g8::OneUnit, false>(tid, (LAS unsigned char*)smem, (const char*)Hb, (const char*)(ROUTW + (size_t)l * RT_ROWS * 1024), 1024, S, ep, 0u, 0u); }
        else { g8::StaticOrder S; S.init(T_TOK, RT_ROWS, grid, blk); gemm8<Ep8Logit, g8::StaticOrder, false>(tid, (LAS unsigned char*)smem, (const char*)Hb, (const char*)(ROUTW + (size_t)l * RT_ROWS * 1024), 1024, S, ep, 0u, 0u); }
}

__device__ __forceinline__ void ph_route1(const Params& p, const int l_in, const int own_tile) {
    extern __shared__ __attribute__((aligned(16))) char smem[];
    int tid_ = threadIdx.x; asm volatile("" : "+v"(tid_));
    int blk_ = blockIdx.x; asm volatile("" : "+s"(blk_));
    unsigned long long w64_ = (unsigned long long)p.ws; asm volatile("" : "+s"(w64_));
    char* ws_ = (char*)(__attribute__((address_space(1))) char*)w64_;
    int l_ = l_in; asm volatile("" : "+v"(l_)); const int l = __builtin_amdgcn_readfirstlane(l_);
    const int tid = tid_, lane = tid & 63, w = tid >> 6;
    int grid_ = gridDim.x; asm volatile("" : "+s"(grid_));
    const int blk = blk_, grid = grid_;
    const int fr = lane & 15, fq = lane >> 4;
    char* const ws = ws_;
    const float* const modl = MOD + (size_t)l * 8 * 6144;
    (void)lane; (void)w; (void)fr; (void)fq; (void)modl; (void)smem; (void)blk; (void)grid;
        const float* bg = INP(29) + l * 8; const float* br = INP(31) + l * 64;
        for (int c = (own_tile >= 0 ? own_tile : blk); c < (own_tile >= 0 ? own_tile + 1 : 256); c += grid) {
            int e0 = 0, e1 = 0; float g0 = 0.f, g1 = 0.f;
            const int t = c * 256 + tid;
            if (tid < 256) {
                const float* lg = LOGIT + (size_t)t * 80;
                float gl[8]; float mx = -3.0e38f; int gs = 0;
    #pragma unroll
                for (int i = 0; i < 8; ++i) { gl[i] = lg[i] + bg[i]; if (gl[i] > mx) { mx = gl[i]; gs = i; } }
                float den = 0.f;
    #pragma unroll
                for (int i = 0; i < 8; ++i) den += fexp_(gl[i] - mx);
                const float pg = 1.0f / den;
                float v1 = -3.0e38f, v2 = -3.0e38f; int i1 = 0, i2 = 0;
                for (int i = 0; i < 8; ++i) {
                    const float v = lg[8 + gs * 8 + i] + br[gs * 8 + i];
                    if (v > v1) { v2 = v1; i2 = i1; v1 = v; i1 = i; } else if (v > v2) { v2 = v; i2 = i; }
                }
                const float q1 = 1.0f / (1.0f + fexp_(v2 - v1));
                g0 = q1 * pg; g1 = (1.0f - q1) * pg;
                e0 = gs * 8 + i1; e1 = gs * 8 + i2;
            }
            unsigned r0 = 0, r1 = 0;
            unsigned* WC = (unsigned*)(smem + 2048);
            if (tid < 256) {
                const unsigned long long lower = (1ull << lane) - 1ull;
                for (int e = 0; e < 64; ++e) {
                    const unsigned long long m0 = __ballot(e0 == e), m1 = __ballot(e1 == e);
                    const unsigned below = (unsigned)__popcll(m0 & lower) + (unsigned)__popcll(m1 & lower);
                    if (e0 == e) r0 = below;
                    if (e1 == e) r1 = below;
                    if (lane == 0) WC[w * 64 + e] = (unsigned)__popcll(m0) + (unsigned)__popcll(m1);
                }
            }
            __syncthreads();
            if (tid < 256) {
                for (int ww = 0; ww < w; ++ww) { r0 += WC[ww * 64 + e0]; r1 += WC[ww * 64 + e1]; }
                TOKINF[t] = make_uint4((unsigned)e0 | ((unsigned)e1 << 8), __float_as_uint(g0), __float_as_uint(g1), r0 | (r1 << 16));
            }
            if (tid < 64) CBASE[c * 64 + tid] = WC[tid] + WC[64 + tid] + WC[128 + tid] + WC[192 + tid];
            __syncthreads();
        }
}

__device__ __forceinline__ void ph_route2(const Params& p, const int l_in) {
    extern __shared__ __attribute__((aligned(16))) char smem[];
    int tid_ = threadIdx.x; asm volatile("" : "+v"(tid_));
    int blk_ = blockIdx.x; asm volatile("" : "+s"(blk_));
    unsigned long long w64_ = (unsigned long long)p.ws; asm volatile("" : "+s"(w64_));
    char* ws_ = (char*)(__attribute__((address_space(1))) char*)w64_;
    int l_ = l_in; asm volatile("" : "+v"(l_)); const int l = __builtin_amdgcn_readfirstlane(l_);
    const int tid = tid_, lane = tid & 63, w = tid >> 6;
    int grid_ = gridDim.x; asm volatile("" : "+s"(grid_));
    const int blk = blk_, grid = grid_;
    const int fr = lane & 15, fq = lane >> 4;
    char* const ws = ws_;
    const float* const modl = MOD + (size_t)l * 8 * 6144;
    (void)lane; (void)w; (void)fr; (void)fq; (void)modl; (void)smem; (void)blk; (void)grid;
        unsigned* pst = (unsigned*)smem;
        unsigned* tot = pst + 80;
        unsigned* PRE = pst + 256;
        {
            unsigned* PS = pst + 256 + 256 * 64;
            const int e = tid & 63, part = tid >> 6;
            unsigned cv[32]; unsigned s = 0;
    #pragma unroll
            for (int i = 0; i < 32; ++i) { cv[i] = CBASE[(part * 32 + i) * 64 + e]; }
    #pragma unroll
            for (int i = 0; i < 32; ++i) s += cv[i];
            PS[part * 64 + e] = s;
            __syncthreads();
            if (tid < 64) { unsigned a = 0; for (int q = 0; q < 8; ++q) a += PS[q * 64 + tid]; tot[tid] = a; }
            for (int c = blk; c < 256; c += grid) {
                const int cp = c >> 5, ci = c & 31;
                if (part == cp) {
                    unsigned a = 0;
                    for (int q = 0; q < cp; ++q) a += PS[q * 64 + e];
    #pragma unroll
                    for (int i = 0; i < 32; ++i) a += (i < ci) ? cv[i] : 0u;
                    PRE[c * 64 + e] = a;
                }
            }
        }
        __syncthreads();
        if (tid == 0) {
            unsigned run = 0;
            for (int e = 0; e < 64; ++e) { pst[e] = run; run += (tot[e] + 255u) & ~255u; }
            pst[64] = run;
        }
        __syncthreads();
        if (blk == 0) {
            if (tid < 64) { for (unsigned tl = pst[tid] >> 8; tl < (pst[tid + 1] >> 8); ++tl) TILEE[tl] = tid; }
            if (tid == 0) TILEE[1023] = (int)(pst[64] >> 8);
        }
        for (int c = blk; c < 256; c += grid) {
            if (tid < 256) {
                const int t = c * 256 + tid;
                const uint4 ti = TOKINF[t];
                const int e0 = ti.x & 255, e1 = (ti.x >> 8) & 255;
                const unsigned r0 = pst[e0] + PRE[c * 64 + e0] + (ti.w & 0xffffu);
                const unsigned r1 = pst[e1] + PRE[c * 64 + e1] + (ti.w >> 16);
                ROWTOK[r0] = t * 2; ROWG[r0] = __uint_as_float(ti.y);
                ROWTOK[r1] = t * 2 + 1; ROWG[r1] = __uint_as_float(ti.z);
            }
        }
        __syncthreads();
}

__device__ __forceinline__ void ph_moe1(const Params& p, const int l_in) {
    extern __shared__ __attribute__((aligned(16))) char smem[];
    int tid_ = threadIdx.x; asm volatile("" : "+v"(tid_));
    int blk_ = blockIdx.x; asm volatile("" : "+s"(blk_));
    unsigned long long w64_ = (unsigned long long)p.ws; asm volatile("" : "+s"(w64_));
    char* ws_ = (char*)(__attribute__((address_space(1))) char*)w64_;
    int l_ = l_in; asm volatile("" : "+v"(l_)); const int l = __builtin_amdgcn_readfirstlane(l_);
    const int tid = tid_, lane = tid & 63, w = tid >> 6;
    int grid_ = gridDim.x; asm volatile("" : "+s"(grid_));
    const int blk = blk_, grid = grid_;
    const int fr = lane & 15, fq = lane >> 4;
    char* const ws = ws_;
    const float* const modl = MOD + (size_t)l * 8 * 6144;
    (void)lane; (void)w; (void)fr; (void)fq; (void)modl; (void)smem; (void)blk; (void)grid;
        g8::MoeOrder<2> S; S.ntiles = TILEE[1023]; S.x = blk & 7; S.j = blk >> 3; S.nj = (grid - S.x + 7) >> 3; S.tile_e = TILEE; S.rowtok = ROWTOK; S.prime(lane);
        Ep8Moe1 ep{HID};
        gemm8<Ep8Moe1, g8::MoeOrder<2>, true>(tid, (LAS unsigned char*)smem, (const char*)ws, (const char*)WGU, 1024, S, ep, (unsigned)OFF_H, (unsigned)(OFF_WIN + (size_t)PWV * 1024 * 2));
}

template <int LINEAR = 0>
__device__ __forceinline__ void ph_moe2(const Params& p, const int l_in) {
    extern __shared__ __attribute__((aligned(16))) char smem[];
    int tid_ = threadIdx.x; asm volatile("" : "+v"(tid_));
    int blk_ = blockIdx.x; asm volatile("" : "+s"(blk_));
    unsigned long long w64_ = (unsigned long long)p.ws; asm volatile("" : "+s"(w64_));
    char* ws_ = (char*)(__attribute__((address_space(1))) char*)w64_;
    int l_ = l_in; asm volatile("" : "+v"(l_)); const int l = __builtin_amdgcn_readfirstlane(l_);
    const int tid = tid_, lane = tid & 63, w = tid >> 6;
    int grid_ = gridDim.x; asm volatile("" : "+s"(grid_));
    const int blk = blk_, grid = grid_;
    const int fr = lane & 15, fq = lane >> 4;
    char* const ws = ws_;
    const float* const modl = MOD + (size_t)l * 8 * 6144;
    (void)lane; (void)w; (void)fr; (void)fq; (void)modl; (void)smem; (void)blk; (void)grid;
        g8::MoeOrder<4> S; S.ntiles = TILEE[1023]; S.x = blk & 7; S.j = blk >> 3; S.nj = (grid - S.x + 7) >> 3; S.tile_e = TILEE; S.rowtok = ROWTOK; S.prime(lane);
        Ep8Moe2<LINEAR> ep{YB, ROWTOK, ROWG};
        gemm8<Ep8Moe2<LINEAR>, g8::MoeOrder<4>, false>(tid, (LAS unsigned char*)smem, (const char*)HID, (const char*)WD, 256, S, ep, 0u, 0u);
}

__device__ __forceinline__ void ph_prologue(const Params& p, const int l_in) {
    extern __shared__ __attribute__((aligned(16))) char smem[];
    int tid_ = threadIdx.x; asm volatile("" : "+v"(tid_));
    int blk_ = blockIdx.x; asm volatile("" : "+s"(blk_));
    unsigned long long w64_ = (unsigned long long)p.ws;
    char* ws_ = (char*)(__attribute__((address_space(1))) char*)w64_;
    int l_ = l_in; asm volatile("" : "+v"(l_)); const int l = __builtin_amdgcn_readfirstlane(l_);
    const int tid = tid_, lane = tid & 63, w = tid >> 6;
    int grid_ = gridDim.x; asm volatile("" : "+s"(grid_));
    const int blk = blk_, grid = grid_;
    const int fr = lane & 15, fq = lane >> 4;
    char* const ws = ws_;
    const float* const modl = MOD + (size_t)l * 8 * 6144;
    (void)lane; (void)w; (void)fr; (void)fq; (void)modl; (void)smem; (void)blk; (void)grid;
        {
            float* cact = (float*)smem;
            float* red = (float*)(smem + 32768);
            for (int i = tid; i < 8192; i += 512) { const float c = INP(1)[i]; cact[i] = siluf_(c); }
            __syncthreads();
            const int ol = tid & 63, ks = tid >> 6;
            for (int g = blk; g < 384; g += grid) {
                const int gid = g * 64 + ol; const int l = gid / 6144, n = gid % 6144;
                const float* wp = INP(2) + (size_t)l * 1024 * 6144 + (size_t)(ks * 128) * 6144 + n;
                float acc[8];
    #pragma unroll
                for (int b = 0; b < 8; ++b) acc[b] = 0.f;
    #pragma unroll 8
                for (int k = 0; k < 128; ++k) {
                    const float wv = wp[(size_t)k * 6144];
    #pragma unroll
                    for (int b = 0; b < 8; ++b) acc[b] += cact[b * 1024 + ks * 128 + k] * wv;
                }
    #pragma unroll
                for (int b = 0; b < 8; ++b) red[(ks * 8 + b) * 64 + ol] = acc[b];
                __syncthreads();
                {
                    const int b = tid >> 6;
                    float s = 0.f;
    #pragma unroll
                    for (int q = 0; q < 8; ++q) s += red[(q * 8 + b) * 64 + ol];
                    MOD[(size_t)(l * 8 + b) * 6144 + n] = s + INP(3)[l * 6144 + n];
                }
                __syncthreads();
            }
        }
        float* tile = (float*)smem;
        for (int jb = blk; jb < 4608; jb += grid) {
            int j = jb;
            if (j < 3392) { const int l = j / 848, r = j % 848, kt = r / 53, nt = r % 53;
                tr_tile(tid, tile, INP(6) + (size_t)l * 1024 * 3336, 3336, kt * 64, nt * 64, 3336, WIN + (size_t)l * WIN_ROWS * 1024, 1024, RmWin()); continue; }
            j -= 3392;
            if (j < 1024) { const int l = j >> 8, r = j & 255, kt = r >> 4, nt = r & 15;
                tr_tile(tid, tile, INP(7) + (size_t)l * 1024 * 1024, 1024, kt * 64, nt * 64, 1024, WOUT + (size_t)l * 1024 * 1024, 1024, RmId()); continue; }
            j -= 1024;
            if (j < 16) { const int l = j >> 2, nt = j & 3;
                tr_tile(tid, tile, INP(19) + (size_t)l * 64 * 256, 256, 0, nt * 64, 256, LWU + (size_t)l * 256 * 64, 64, RmId()); continue; }
            j -= 16;
            if (j < 16) { const int l = j >> 2, nt = j & 3;
                tr_tile(tid, tile, INP(21) + (size_t)l * 64 * 256, 256, 0, nt * 64, 256, LAU + (size_t)l * 256 * 64, 64, RmId()); continue; }
            j -= 16;
            if (j < 32) { const int l = j >> 3, r = j & 7, kt = r >> 2, nt = r & 3;
                tr_tile(tid, tile, INP(22) + (size_t)l * 128 * 256, 256, kt * 64, nt * 64, 256, LGU + (size_t)l * 256 * 128, 128, RmId()); continue; }
            j -= 32;
            if (j < 64) { const int l = j >> 4, kt = j & 15;
                tr_tile(tid, tile, INP(30) + (size_t)l * 1024 * 64, 64, kt * 64, 0, 64, ROUTW + (size_t)l * RT_ROWS * 1024, 1024, RmOff{8}); continue; }
            j -= 64;
            { const int l = j >> 4, kt = j & 15;
                tr_tile(tid, tile, INP(28) + (size_t)l * 1024 * 8, 8, kt * 64, 0, 8, ROUTW + (size_t)l * RT_ROWS * 1024, 1024, RmId()); }
        }
        const int gt = blk * 512 + tid, ngt = grid * 512;
        for (int i = gt; i < 4 * (WIN_ROWS - PWV) * 128; i += ngt) { const int l = i / ((WIN_ROWS - PWV) * 128), r = i % ((WIN_ROWS - PWV) * 128); *(u32x4*)(WIN + ((size_t)l * WIN_ROWS + PWV) * 1024 + (size_t)r * 8) = (u32x4){0u, 0u, 0u, 0u}; }
        for (int i = gt; i < 4 * (RT_ROWS - 72) * 128; i += ngt) { const int l = i / ((RT_ROWS - 72) * 128), r = i % ((RT_ROWS - 72) * 128); *(u32x4*)(ROUTW + ((size_t)l * RT_ROWS + 72) * 1024 + (size_t)r * 8) = (u32x4){0u, 0u, 0u, 0u}; }
        for (int i = gt; i < 4 * 4 * 128 * 128; i += ngt) { const int s = i & 127, t = (i >> 7) & 127; SGUW[i] = (s <= t) ? f2bf(INP(14)[i]) : (bf16_t)0; }
        for (int i = gt; i < 4 * 8 * 1024; i += ngt) { const int l = i >> 13, j = (i >> 10) & 7, k = i & 1023; GW[i] = INP(6)[((size_t)l * 1024 + k) * 3336 + 1024 + j]; }
}

__device__ __forceinline__ void ph_final(const Params& p, const int l_in) {
    extern __shared__ __attribute__((aligned(16))) char smem[];
    int tid_ = threadIdx.x; asm volatile("" : "+v"(tid_));
    int blk_ = blockIdx.x; asm volatile("" : "+s"(blk_));
    unsigned long long w64_ = (unsigned long long)p.ws; asm volatile("" : "+s"(w64_));
    char* ws_ = (char*)(__attribute__((address_space(1))) char*)w64_;
    int l_ = l_in; asm volatile("" : "+v"(l_)); const int l = __builtin_amdgcn_readfirstlane(l_);
    const int tid = tid_, lane = tid & 63, w = tid >> 6;
    int grid_ = gridDim.x; asm volatile("" : "+s"(grid_));
    const int blk = blk_, grid = grid_;
    const int fr = lane & 15, fq = lane >> 4;
    char* const ws = ws_;
    const float* const modl = MOD + (size_t)l * 8 * 6144;
    (void)lane; (void)w; (void)fr; (void)fq; (void)modl; (void)smem; (void)blk; (void)grid;
        const float* gn = INP(35);
        const float* modp = MOD + (size_t)(NLAYER - 1) * 8 * 6144;
        const int gw = blk * 8 + w, nw = grid * 8;
        for (int r0 = gw * 32; r0 < T_TOK; r0 += nw * 32) {
            const int b = r0 >> 13;
            float gs[16], gf[16];
    #pragma unroll
            for (int j = 0; j < 4; ++j) {
                const int c = j * 256 + lane * 4;
                const float4 g4 = *(const float4*)(gn + c);
                const float4 f4 = *(const float4*)(modp + b * 6144 + 5 * 1024 + c);
                gs[j * 4 + 0] = g4.x; gs[j * 4 + 1] = g4.y; gs[j * 4 + 2] = g4.z; gs[j * 4 + 3] = g4.w;
                gf[j * 4 + 0] = f4.x; gf[j * 4 + 1] = f4.y; gf[j * 4 + 2] = f4.z; gf[j * 4 + 3] = f4.w;
            }
            u32x2 cxb[4], cy0[4], cy1[4];
    #pragma unroll
            for (int j = 0; j < 4; ++j) { const size_t o_ = (size_t)r0 * 1024 + j * 256 + lane * 4; cxb[j] = *(const u32x2*)(XB_LAST + o_); cy0[j] = *(const u32x2*)(YB + o_); cy1[j] = *(const u32x2*)(YB + (size_t)T_TOK * 1024 + o_); }
            for (int r = r0; r < r0 + 32; ++r) {
                float xv[16]; float ss = 0.f;
                u32x2 nxb[4], ny0[4], ny1[4];
                {
                    const int rn = (r + 1 < r0 + 32) ? r + 1 : r;
    #pragma unroll
                    for (int j = 0; j < 4; ++j) { const size_t o_ = (size_t)rn * 1024 + j * 256 + lane * 4; nxb[j] = *(const u32x2*)(XB_LAST + o_); ny0[j] = *(const u32x2*)(YB + o_); ny1[j] = *(const u32x2*)(YB + (size_t)T_TOK * 1024 + o_); }
                }
    #pragma unroll
                for (int j = 0; j < 4; ++j) {
                    const int c = j * 256 + lane * 4;
                    const u32x2 xb = cxb[j];
                    float4 v = make_float4(bflo(xb.x), bfhi(xb.x), bflo(xb.y), bfhi(xb.y));
#if !DBG_NO_MOE
                    const u32x2 y0 = cy0[j];
                    const u32x2 y1 = cy1[j];
                    v.x += gf[j * 4 + 0] * (bflo(y0.x) + bflo(y1.x)); v.y += gf[j * 4 + 1] * (bfhi(y0.x) + bfhi(y1.x));
                    v.z += gf[j * 4 + 2] * (bflo(y0.y) + bflo(y1.y)); v.w += gf[j * 4 + 3] * (bfhi(y0.y) + bfhi(y1.y));
#endif
                    xv[j * 4 + 0] = v.x; xv[j * 4 + 1] = v.y; xv[j * 4 + 2] = v.z; xv[j * 4 + 3] = v.w;
                    ss += v.x * v.x + v.y * v.y + v.z * v.z + v.w * v.w;
                }
                ss = wave_sum(ss);
                const float rs = rsqrtf(ss * (1.0f / 1024.0f) + 1e-6f);
    #pragma unroll
                for (int j = 0; j < 4; ++j) {
                    const int c = j * 256 + lane * 4;
                    float* dstp = xo + (size_t)r * 1024 + c;
                    *(float4*)dstp = make_float4(xv[j * 4 + 0] * rs * gs[j * 4 + 0], xv[j * 4 + 1] * rs * gs[j * 4 + 1], xv[j * 4 + 2] * rs * gs[j * 4 + 2], xv[j * 4 + 3] * rs * gs[j * 4 + 3]);
                }
    #pragma unroll
                for (int j = 0; j < 4; ++j) { cxb[j] = nxb[j]; cy0[j] = ny0[j]; cy1[j] = ny1[j]; }
            }
        }
}

#ifdef TEST_PHASE
#define TK(name) __global__ void __launch_bounds__(512, 2) tk_##name(Params p, int l) { ph_##name(p, l); }
TK(prologue) TK(norm1) TK(inproj) TK(post) TK(outproj) TK(route2) TK(moe1) TK(final)
#endif

__global__ void __launch_bounds__(512, 2) mega(Params p) {
    extern __shared__ __attribute__((aligned(16))) char smem_all[];
    if (threadIdx.x == 0) *(uint4*)(smem_all + LDS_XB_OFF) = make_uint4(0u, 0u, 0u, 0u);
    __syncthreads();
    XcdBarrier bar = xcd_barrier_post((unsigned*)(p.ws + OFF_BAR), (volatile LAS unsigned*)(smem_all + LDS_XB_OFF));
    ph_prologue(p, 0);
    xcd_barrier(bar);
    if (TIME_DUP == 11) { ph_prologue(p, 0); xcd_barrier(bar); ph_prologue(p, 0); xcd_barrier(bar); ph_prologue(p, 0); xcd_barrier(bar); ph_prologue(p, 0); xcd_barrier(bar); }
    for (int l = 0; l < NLAYER; ++l) {
        ph_norm1(p, l);   xcd_barrier(bar);
        ph_inproj(p, l);  xcd_barrier(bar);
        if (TIME_DUP == 1) { ph_inproj(p, l);  xcd_barrier(bar); }
        if (TIME_DUP == 32) { ph_inproj<1>(p, l);  xcd_barrier(bar); }
        if (TIME_DUP == 30) { xcd_barrier(bar); xcd_barrier(bar); xcd_barrier(bar); xcd_barrier(bar); }
#if !DBG_NO_RWKV
        ph_rwprep(p, l, gridDim.x == 256 ? 0 : 2);
#endif
        if (TIME_DUP == 7) ph_gdn1(p, l, blockIdx.x, gridDim.x, 4096);
        if (GDN_U1 > 0 && !DBG_NO_GDN) ph_gdn1(p, l, blockIdx.x, gridDim.x, GDN_U1);
        xcd_barrier(bar);
        if (TIME_DUP == 8) { ph_rwprep(p, l); xcd_barrier(bar); }
        if (TIME_DUP == 19) { ph_rwprep<1>(p, l); xcd_barrier(bar); }
        ph_scan<0>(p, l);    xcd_barrier(bar);
        if (TIME_DUP == 3) { ph_scan<0>(p, l);    xcd_barrier(bar); }
        if (TIME_DUP == 9) { ph_scan<1>(p, l);    xcd_barrier(bar); }
        if (TIME_DUP == 33) { ph_scan<11>(p, l);    xcd_barrier(bar); }
        if (TIME_DUP == 10) { ph_scan<2>(p, l);    xcd_barrier(bar); }
        if (TIME_DUP == 20) { ph_scan<3>(p, l);    xcd_barrier(bar); }
        if (TIME_DUP == 21) { ph_scan<4>(p, l);    xcd_barrier(bar); }
        if (TIME_DUP == 22) { ph_scan<5>(p, l);    xcd_barrier(bar); }
        if (TIME_DUP == 23) { ph_scan<6>(p, l);    xcd_barrier(bar); }
        if (TIME_DUP == 24) { ph_scan<7>(p, l);    xcd_barrier(bar); }
        if (TIME_DUP == 25) { ph_scan<8>(p, l);    xcd_barrier(bar); }
        if (TIME_DUP == 26) { ph_scan<9>(p, l);    xcd_barrier(bar); }
        if (TIME_DUP == 27) { ph_scan<10>(p, l);    xcd_barrier(bar); }
        ph_post(p, l);    xcd_barrier(bar);
        ph_outproj(p, l); xcd_barrier(bar);
        if (TIME_DUP == 31) { ph_outproj<1>(p, l); xcd_barrier(bar); }
#if !DBG_NO_MOE
        if (gridDim.x == 256) {
            const int own = ((int)blockIdx.x & 7) * 32 + ((int)blockIdx.x >> 3);
            ph_norm2(p, l, own);
            asm volatile("s_waitcnt vmcnt(0)" ::: "memory"); __syncthreads();
            ph_router(p, l, own);
            asm volatile("s_waitcnt vmcnt(0)" ::: "memory"); __syncthreads();
            ph_route1(p, l, own);  xcd_barrier(bar);
        } else {
            ph_norm2(p, l, -1);   xcd_barrier(bar);
            ph_router(p, l, -1);  xcd_barrier(bar);
            ph_route1(p, l, -1);  xcd_barrier(bar);
        }
        if (TIME_DUP == 6) { ph_norm2(p, l, -1);   xcd_barrier(bar); }
        ph_route2(p, l);  xcd_barrier(bar);
        if (TIME_DUP == 5) { ph_router(p, l, -1);  xcd_barrier(bar); ph_route1(p, l, -1);  xcd_barrier(bar); ph_route2(p, l);  xcd_barrier(bar); }
        ph_moe1(p, l);    xcd_barrier(bar);
        if (TIME_DUP == 17) { ph_moe2<1>(p, l);    xcd_barrier(bar); }
        ph_moe2(p, l);    xcd_barrier(bar);
        if (TIME_DUP == 4) { ph_moe1(p, l);    xcd_barrier(bar); ph_moe2(p, l);    xcd_barrier(bar); }
        if (TIME_DUP == 15) { ph_moe1(p, l);    xcd_barrier(bar); }
        if (TIME_DUP == 16) { ph_moe2(p, l);    xcd_barrier(bar); }
#endif
    }
    ph_final(p, 0);
}


extern "C" void kernel_launch(void* const* d_in, const int* in_sizes, int n_in,
                              void* d_out, int out_size, void* d_ws, size_t ws_size,
                              hipStream_t stream) {
    static int grid = 0;
    if (!grid) {
        int dev = 0, cus = 0, per_cu = 0;
        hipGetDevice(&dev);
        hipDeviceGetAttribute(&cus, hipDeviceAttributeMultiprocessorCount, dev);
        hipFuncSetAttribute((const void*)mega, hipFuncAttributeMaxDynamicSharedMemorySize, LDS_BYTES);
        hipOccupancyMaxActiveBlocksPerMultiprocessor(&per_cu, mega, 512, LDS_BYTES);
        grid = (per_cu >= 1 && cus >= 192) ? cus : 0;
    }
    if (grid <= 0 || n_in < 36 || ws_size < WS_NEED) { fprintf(stderr, "kernel_launch: cannot launch (grid %d, ws %zu need %zu)\n", grid, ws_size, (size_t)WS_NEED); return; }
    hipMemsetAsync(d_ws, 0, ZERO_BYTES, stream);
    Params p{};
    for (int i = 0; i < 36; ++i) p.in[i] = (const float*)d_in[i];
    p.out = (float*)d_out;
    p.ws = (char*)d_ws;
    hipLaunchKernelGGL(mega, dim3(grid), dim3(512), LDS_BYTES, stream, p);
}
```

```cpp
#include <hip/hip_runtime.h>
#include <stdint.h>
#include <stdio.h>

typedef unsigned short bf16_t;
typedef short bf16x8 __attribute__((ext_vector_type(8)));
typedef float f32x4 __attribute__((ext_vector_type(4)));
typedef unsigned u32x4 __attribute__((ext_vector_type(4)));
typedef unsigned u32x2 __attribute__((ext_vector_type(2)));

#define T_TOK 65536
#define SEQ 8192
#define DM 1024
#define NLAYER 4
#define RW_EARLY 64
#define PW 3392
#define PWV 3336
#define PC_Q 0
#define PC_K 256
#define PC_V 512
#define PC_Z 768
#define PC_SU 1024
#define PC_SV 1280
#define PC_CB 1536
#define PC_CC 1792
#define PC_CH 2048
#define PC_RW 2304
#define PC_GA 3328
#define PC_GB 3332
#define WIN_ROWS 3584
#define RT_ROWS 256
#define MAXROWS 147456
#define MAXTILES 576

constexpr size_t OFF_BAR   = 0;
constexpr size_t OFF_CNT   = 16384;
constexpr size_t ZERO_BYTES = 32768;
constexpr size_t OFF_MOD   = 32768;
constexpr size_t OFF_WIN   = OFF_MOD + 786432;
constexpr size_t OFF_WOUT  = OFF_WIN + (size_t)4 * WIN_ROWS * 1024 * 2;
constexpr size_t OFF_SGUW  = OFF_WOUT + (size_t)4 * 1024 * 1024 * 2;
constexpr size_t OFF_LWU   = OFF_SGUW + 524288;
constexpr size_t OFF_LAU   = OFF_LWU + 131072;
constexpr size_t OFF_LGU   = OFF_LAU + 131072;
constexpr size_t OFF_ROUTW = OFF_LGU + 262144;
constexpr size_t OFF_GCD   = OFF_ROUTW + (size_t)4 * RT_ROWS * 1024 * 2;
constexpr size_t OFF_WGU   = OFF_GCD + 16384;
constexpr size_t OFF_WD    = OFF_WGU + (size_t)64 * 512 * 1024 * 2;
constexpr size_t OFF_H     = OFF_WD + (size_t)64 * 1024 * 256 * 2;
constexpr size_t OFF_P     = OFF_H + (size_t)T_TOK * 1024 * 2;
constexpr size_t OFF_MIX   = OFF_P + (size_t)T_TOK * PW * 2;
constexpr size_t OFF_RW    = OFF_MIX + (size_t)T_TOK * 1024 * 2;
constexpr size_t RW_ARR    = (size_t)T_TOK * 256 * 2;
constexpr size_t OFF_YR    = OFF_RW + 7 * RW_ARR;
constexpr size_t OFF_CE    = OFF_YR + RW_ARR;
constexpr size_t OFF_GAB   = OFF_CE + 2 * RW_ARR;
constexpr size_t OFF_GW    = OFF_GAB + (size_t)T_TOK * 8 * 4;
constexpr size_t WS_NEED   = OFF_GW + 4 * 8 * 1024 * 4;
constexpr size_t PO_LOGIT  = 0;
constexpr size_t PO_TOKINF = 20971520;
constexpr size_t PO_CBASE  = PO_TOKINF + 1048576;
constexpr size_t PO_ROWTOK = PO_CBASE + 65536;
constexpr size_t PO_ROWG   = PO_ROWTOK + 589824;
constexpr size_t PO_TILEE  = PO_ROWG + 589824;
constexpr size_t PO_HID    = 33554432;
constexpr size_t PO_Y      = PO_HID + (size_t)MAXROWS * 256 * 2 + 1048576;
static_assert(PO_TILEE + 4096 <= PO_HID, "moe tmp overlap");
static_assert(PO_Y + (size_t)2 * T_TOK * 1024 * 2 <= (size_t)T_TOK * PW * 2, "moe tmp too large");

#define LDS_BYTES 163840
#define LDS_XB_OFF (163840 - 256)
#define GDN_U1 0
#define TIME_DUP 0
#define DBG_NO_MOE 0
#define DBG_NO_RWKV 0
#define DBG_RWKV_Y0 0
#define DBG_RWKV_NOSCAN 0
#define DBG_RWKV_OUT 0
#define DBG_NO_GDN 0

struct Params {
    const float* in[36];
    float* out;
    char* ws;
};

#define XB_TMO      128
#define XB_XCNT(j)  (256  + 64 * (j))
#define XB_XSUB(j)  (1280 + 64 * (j))
#define XB_XGEN(j)  (2304 + 64 * (j))
#define XB_TOP      3328
#define XB_TOPGEN   3392
#define XCD_BAR_WORDS 3456
#define XB_SPIN_CAP (1u << 22)
#define LAS __attribute__((address_space(3)))

__device__ __forceinline__ unsigned xb_ld(unsigned* p)              { return __hip_atomic_load(p, __ATOMIC_RELAXED, __HIP_MEMORY_SCOPE_AGENT); }
__device__ __forceinline__ unsigned xb_add(unsigned* p, unsigned v) { return __hip_atomic_fetch_add(p, v, __ATOMIC_RELAXED, __HIP_MEMORY_SCOPE_AGENT); }
__device__ __forceinline__ unsigned xb_xcc_id() { return (unsigned)__builtin_amdgcn_s_getreg((3 << 11) | 20) & 0xFu; }
#define XB_SPIN(cond, bar) do { unsigned _sp = 0; while (cond) { __builtin_amdgcn_s_sleep(1); \
    if ((++_sp & 255u) == 0u) { if (xb_ld(&(bar)[XB_TMO])) break; if (_sp > XB_SPIN_CAP) { atomicAdd(&(bar)[XB_TMO], 1u); break; } } } } while (0)

struct XcdBarrier { unsigned* bar; unsigned x; volatile LAS unsigned* st; };

__device__ __forceinline__ XcdBarrier xcd_barrier_post(unsigned* bar, volatile LAS unsigned* st) {
    XcdBarrier b; b.bar = bar; b.x = xb_xcc_id(); b.st = st;
    if (threadIdx.x == 0) (void)xb_add(&bar[XB_XCNT(b.x)], 1u);
    return b;
}
__device__ __forceinline__ void xcd_barrier_complete(unsigned* bar, unsigned x, unsigned& nloc, unsigned& nx) {
    const unsigned G = gridDim.x * gridDim.y * gridDim.z;
    unsigned sum, cnt, mine, sp = 0u;
    for (;;) {
        sum = 0u; cnt = 0u; mine = 0u;
#pragma unroll
        for (unsigned j = 0; j < 16; ++j) { const unsigned c = xb_ld(&bar[XB_XCNT(j)]); sum += c; cnt += (c > 0u) ? 1u : 0u; mine = (j == x) ? c : mine; }
        if (sum == G) break;
        __builtin_amdgcn_s_sleep(1);
        if ((++sp & 255u) == 0u) { if (xb_ld(&bar[XB_TMO])) break; if (sp > XB_SPIN_CAP) { atomicAdd(&bar[XB_TMO], 1u); break; } }
    }
    nloc = mine > 0u ? mine : 1u; nx = cnt > 0u ? cnt : 1u;
}
__device__ __forceinline__ void xcd_barrier(const XcdBarrier& b) {
    asm volatile("s_waitcnt vmcnt(0)" ::: "memory");
    __syncthreads();
    if (threadIdx.x == 0) {
        unsigned blo_ = (unsigned)(unsigned long long)b.bar, bhi_ = (unsigned)((unsigned long long)b.bar >> 32), bx_ = b.x;
        asm volatile("" : "+v"(blo_), "+v"(bhi_), "+v"(bx_));
        unsigned* bar = (unsigned*)(__attribute__((address_space(1))) unsigned*)(((unsigned long long)(unsigned)__builtin_amdgcn_readfirstlane(bhi_) << 32) | (unsigned)__builtin_amdgcn_readfirstlane(blo_));
        const unsigned bx = (unsigned)__builtin_amdgcn_readfirstlane(bx_);
        __builtin_amdgcn_s_waitcnt(0);
        unsigned nloc = b.st[0], nx = b.st[1];
        if (nloc == 0u) { xcd_barrier_complete(bar, bx, nloc, nx); b.st[0] = nloc; b.st[1] = nx; }
        const unsigned old = xb_add(&bar[XB_XSUB(bx)], 1u);
        const unsigned gen = old / nloc;
        if (old + 1u == (gen + 1u) * nloc) {
            __builtin_amdgcn_fence(__ATOMIC_RELEASE, "agent");
            asm volatile("s_waitcnt vmcnt(0)" ::: "memory");
            const unsigned og = xb_add(&bar[XB_TOP], 1u);
            const unsigned tg = og / nx;
            if (og + 1u == (tg + 1u) * nx) xb_add(&bar[XB_TOPGEN], 1u);
            else XB_SPIN(xb_ld(&bar[XB_TOPGEN]) == tg, bar);
            __builtin_amdgcn_fence(__ATOMIC_ACQUIRE, "agent");
            xb_add(&bar[XB_XGEN(bx)], 1u);
            asm volatile("s_waitcnt vmcnt(0)" ::: "memory");
        } else {
            XB_SPIN(xb_ld(&bar[XB_XGEN(bx)]) == gen, bar);
            __builtin_amdgcn_fence(__ATOMIC_ACQUIRE, "agent");
            asm volatile("s_waitcnt vmcnt(0)" ::: "memory");
        }
    }
    __syncthreads();
}

__device__ __forceinline__ float bf2f(unsigned v) { return __uint_as_float(v << 16); }
__device__ __forceinline__ float bflo(unsigned v) { return __uint_as_float(v << 16); }
__device__ __forceinline__ float bfhi(unsigned v) { return __uint_as_float(v & 0xffff0000u); }
typedef float f32x2 __attribute__((ext_vector_type(2)));
typedef __bf16 bf16x2_t __attribute__((ext_vector_type(2)));
__device__ __forceinline__ unsigned pk2(float lo, float hi) { const f32x2 v = {lo, hi}; const bf16x2_t b = __builtin_convertvector(v, bf16x2_t); return __builtin_bit_cast(unsigned, b); }
__device__ __forceinline__ bf16_t f2bf(float f) { return (bf16_t)(pk2(f, 0.f) & 0xffffu); }
__device__ __forceinline__ float fexp_(float x) { return __builtin_amdgcn_exp2f(x * 1.4426950408889634f); }
__device__ __forceinline__ float flog_(float x) { return __builtin_amdgcn_logf(x) * 0.6931471805599453f; }
__device__ __forceinline__ float rcpf_(float x) { return __builtin_amdgcn_rcpf(x); }
__device__ __forceinline__ float sigmoidf_(float x) { return rcpf_(1.0f + fexp_(-x)); }
__device__ __forceinline__ float siluf_(float x) { return x * rcpf_(1.0f + fexp_(-x)); }
__device__ __forceinline__ float tanhf_(float y) { return 1.0f - 2.0f * rcpf_(1.0f + fexp_(2.0f * y)); }
__device__ __forceinline__ float geluf_(float x) { return 0.5f * x * (1.0f + tanhf_(0.7978845608028654f * (x + 0.044715f * x * x * x))); }
__device__ __forceinline__ float softplusf_(float x) { return fmaxf(x, 0.f) + flog_(1.0f + fexp_(-fabsf(x))); }
__device__ __forceinline__ void lds_barrier() { asm volatile("s_waitcnt lgkmcnt(0)" ::: "memory"); __builtin_amdgcn_s_barrier(); asm volatile("" ::: "memory"); }

template <int CTRL> __device__ __forceinline__ float dpp_f(float v) {
    return __int_as_float(__builtin_amdgcn_update_dpp(0, __float_as_int(v), CTRL, 0xf, 0xf, true));
}
__device__ __forceinline__ float rowsum16(float v) {
    v += dpp_f<0x128>(v); v += dpp_f<0x124>(v); v += dpp_f<0x122>(v); v += dpp_f<0x121>(v); return v;
}
__device__ __forceinline__ float wave_sum(float v) {
    v = rowsum16(v); v += __shfl_xor(v, 16); v += __shfl_xor(v, 32); return v;
}
__device__ __forceinline__ f32x4 mfma16(bf16x8 a, bf16x8 b, f32x4 c) { return __builtin_amdgcn_mfma_f32_16x16x32_bf16(a, b, c, 0, 0, 0); }
__device__ __forceinline__ bf16x8 ld_frag(const bf16_t* p) { return *(const bf16x8*)p; }
__device__ __forceinline__ void unpack8(const u32x4& v, float* f) {
    f[0] = bflo(v.x); f[1] = bfhi(v.x); f[2] = bflo(v.y); f[3] = bfhi(v.y); f[4] = bflo(v.z); f[5] = bfhi(v.z); f[6] = bflo(v.w); f[7] = bfhi(v.w);
}
__device__ __forceinline__ u32x4 pack8(const float* f) { u32x4 o; o.x = pk2(f[0], f[1]); o.y = pk2(f[2], f[3]); o.z = pk2(f[4], f[5]); o.w = pk2(f[6], f[7]); return o; }

template <class RowMap>
__device__ __forceinline__ void tr_tile(const int tid, float* tile, const float* __restrict__ src, int ld, int k0, int n0, int Ndim,
                                        bf16_t* __restrict__ dst, int dst_ld, RowMap rm) {
#pragma unroll
    for (int j = 0; j < 2; ++j) {
        const int kk = (tid >> 4) + 32 * j, n4 = (tid & 15) * 4;
        float4 v = make_float4(0.f, 0.f, 0.f, 0.f);
        if (n0 + n4 < Ndim) v = *(const float4*)(src + (size_t)(k0 + kk) * ld + n0 + n4);
        tile[kk * 65 + n4 + 0] = v.x; tile[kk * 65 + n4 + 1] = v.y; tile[kk * 65 + n4 + 2] = v.z; tile[kk * 65 + n4 + 3] = v.w;
    }
    lds_barrier();
    const int nn = tid >> 3, kc = (tid & 7) * 8;
    if (n0 + nn < Ndim) {
        float f[8];
#pragma unroll
        for (int i = 0; i < 8; ++i) f[i] = tile[(kc + i) * 65 + nn];
        *(u32x4*)(dst + (size_t)rm(n0 + nn) * dst_ld + k0 + kc) = pack8(f);
    }
    lds_barrier();
}
struct TrJob { const float* src; int ld, k0, n0, Ndim; bf16_t* dst; int dst_ld, mode  , up; };
__device__ __forceinline__ int trjob_row(const TrJob& j, int n) { return j.mode ? ((n >> 5) * 64 + j.up * 32 + (n & 31)) : n; }
__device__ __forceinline__ void tr_pair(const int tid, float* tileA, float* tileB, const TrJob& a, const TrJob& b, const bool haveB) {
    float4 va[2], vb[2];
#pragma unroll
    for (int j = 0; j < 2; ++j) {
        const int kk = (tid >> 4) + 32 * j, n4 = (tid & 15) * 4;
        va[j] = (a.n0 + n4 < a.Ndim) ? *(const float4*)(a.src + (size_t)(a.k0 + kk) * a.ld + a.n0 + n4) : make_float4(0.f, 0.f, 0.f, 0.f);
        vb[j] = (haveB && b.n0 + n4 < b.Ndim) ? *(const float4*)(b.src + (size_t)(b.k0 + kk) * b.ld + b.n0 + n4) : make_float4(0.f, 0.f, 0.f, 0.f);
    }
#pragma unroll
    for (int j = 0; j < 2; ++j) {
        const int kk = (tid >> 4) + 32 * j, n4 = (tid & 15) * 4;
        tileA[kk * 65 + n4 + 0] = va[j].x; tileA[kk * 65 + n4 + 1] = va[j].y; tileA[kk * 65 + n4 + 2] = va[j].z; tileA[kk * 65 + n4 + 3] = va[j].w;
        tileB[kk * 65 + n4 + 0] = vb[j].x; tileB[kk * 65 + n4 + 1] = vb[j].y; tileB[kk * 65 + n4 + 2] = vb[j].z; tileB[kk * 65 + n4 + 3] = vb[j].w;
    }
    lds_barrier();
    const int nn = tid >> 3, kc = (tid & 7) * 8;
    if (a.n0 + nn < a.Ndim) {
        float f[8];
#pragma unroll
        for (int i = 0; i < 8; ++i) f[i] = tileA[(kc + i) * 65 + nn];
        *(u32x4*)(a.dst + (size_t)trjob_row(a, a.n0 + nn) * a.dst_ld + a.k0 + kc) = pack8(f);
    }
    if (haveB && b.n0 + nn < b.Ndim) {
        float f[8];
#pragma unroll
        for (int i = 0; i < 8; ++i) f[i] = tileB[(kc + i) * 65 + nn];
        *(u32x4*)(b.dst + (size_t)trjob_row(b, b.n0 + nn) * b.dst_ld + b.k0 + kc) = pack8(f);
    }
    lds_barrier();
}
struct RmId { __device__ int operator()(int n) const { return n; } };
struct RmOff { int off; __device__ int operator()(int n) const { return n + off; } };
struct RmWin { __device__ int operator()(int n) const { return n < 1024 ? n : (n < 1032 ? 3328 + (n - 1024) : n - 8); } };
struct RmGate { int up; __device__ int operator()(int j) const { return (j >> 7) * 256 + up * 128 + (j & 127); } };

namespace g8 {
constexpr int BM = 256, BK = 64, HALF = 128, HTB = HALF * BK * 2, STAGE_BYTES = 8 * HTB, NXCD = 8, WGM = 8;
__device__ __forceinline__ int lds_byte(int r, int c) { const int st = (r >> 4) * 2 + (c >> 5), rr = r & 15, cc = c & 31, ob = rr * 64 + cc * 2; return st * 1024 + (ob ^ (((ob >> 9) & 1) << 5)); }
__device__ __forceinline__ void stage_rc(int b, int& R, int& C) { const int st = b / 1024, sb = b % 1024, swz = sb ^ (((sb >> 9) & 1) << 5); R = (st >> 1) * 16 + swz / 64; C = (st & 1) * 32 + (swz % 64) / 2; }
__device__ __forceinline__ int perm32(int rho) { const int n = rho >> 4, i = rho & 15; return 8 * (i >> 2) + 4 * n + (i & 3); }
struct Unit { int pm, pn; };
struct StaticOrder {
    int nM, nN, nwg, G, c;
    __device__ void init(int M, int N, int G_, int c_) { nM = M / BM; nN = N / BM; nwg = nM * nN; G = G_; c = c_; }
    __device__ bool next(int i, Unit& u) const {
        const long L = (long)i * G + c; if (L >= nwg) return false;
        int wgid = (int)L; { const int q = nwg / NXCD, r = nwg % NXCD, xcd = wgid % NXCD, off = wgid / NXCD; wgid = (xcd < r ? xcd * (q + 1) : r * (q + 1) + (xcd - r) * q) + off; }
        const int nig = WGM * nN, gid = wgid / nig, fm = gid * WGM, gsz = (nM - fm) < WGM ? (nM - fm) : WGM;
        u.pm = fm + ((wgid % nig) % gsz); u.pn = (wgid % nig) / gsz; return true;
    }
    __device__ const int* rows(const Unit&) const { return nullptr; }
};
struct OneUnit { int pm; __device__ bool next(int i, Unit& u) const { if (i > 0) return false; u.pm = pm; u.pn = 0; return true; } __device__ const int* rows(const Unit&) const { return nullptr; } };
template <int NT> struct MoeOrder {
    int ntiles, x, j, nj; const int* tile_e; const int* rowtok;
    int tab;
    __device__ void prime(int lane) { const int v = j + lane * nj, rt = (v / NT) * 8 + x; tab = (rt < ntiles) ? tile_e[rt] : 0; }
    __device__ bool next(int i, Unit& u) const {
        const int v = j + i * nj, rtl = v / NT, nt = v - rtl * NT, rt = rtl * 8 + x;
        if (rt >= ntiles) return false;
        u.pm = rt; u.pn = __builtin_amdgcn_readlane(tab, i) * NT + nt; return true;
    }
    __device__ const int* rows(const Unit& u) const { return rowtok + u.pm * 256; }
};
}
template <class Epi, class Sched, bool GATHER>
__device__ __forceinline__ void gemm8(const int tid  , LAS unsigned char* lds, const char* Abase, const char* Btbase, const int K, const Sched& S, const Epi& E, const unsigned hrow_off, const unsigned zero_off) {
    using namespace g8;
    const int wid = __builtin_amdgcn_readfirstlane(tid >> 6), lane = tid & 63, wr = wid >> 2, wc = wid & 3, fr = lane & 15, fq = lane >> 4;
    const int nt = K / BK;
    unsigned voffA[2], voffB[2];
#pragma unroll
    for (int i = 0; i < 2; ++i) { int R, C; stage_rc(tid * 16 + i * 8192, R, C); const int Rb = Epi::PERM ? (64 * (R >> 5) + perm32(R & 31)) : R;
        voffA[i] = (unsigned)(R * K + C) * 2u; voffB[i] = (unsigned)(Rb * K + C) * 2u; }
    const size_t kstep = (size_t)(BK * 2);
    const size_t hstep = (size_t)HALF * K * 2;
    const size_t bhstep = Epi::PERM ? (size_t)32 * K * 2 : hstep;
    const size_t tstep = 2 * hstep;
    const unsigned ldsw = (unsigned)wid * 1024u;
    const int aoff = lds_byte(wr * 64 + fr, fq * 8), boff = lds_byte(wc * 32 + fr, fq * 8);
#define G8_SA(b, h) (((b) * 2 + (h)) * HTB)
#define G8_SB(b, h) ((4 + (b) * 2 + (h)) * HTB)
#define G8_STAGE(bufoff, gbase, voff) do { _Pragma("unroll") for (int _i = 0; _i < 2; ++_i) \
        __builtin_amdgcn_global_load_lds((const __attribute__((address_space(1))) unsigned*)((const char*)(gbase) + (voff)[_i]), (LAS unsigned*)(lds + (bufoff) + ldsw + _i * 8192), 16, 0, 0); } while (0)
#define G8_STAGE_A(bufoff, NX, h, kb) do { if (GATHER) { if (NX) { G8_STAGE(bufoff, Abase + (kb), ngv[h]); } else { G8_STAGE(bufoff, Abase + (kb), cgv[h]); } } \
        else { G8_STAGE(bufoff, ((NX) ? nA : cA) + (size_t)(h) * hstep + (kb), voffA); } } while (0)
#define G8_LDA(dst, b, h) do { _Pragma("unroll") for (int m = 0; m < 4; ++m) _Pragma("unroll") for (int k = 0; k < 2; ++k) dst[m][k] = *(const LAS bf16x8*)(lds + G8_SA(b, h) + aoff + m * 2048 + k * 1024); } while (0)
#define G8_LDB(dst, b, h) do { _Pragma("unroll") for (int n = 0; n < 2; ++n) _Pragma("unroll") for (int k = 0; k < 2; ++k) dst[n][k] = *(const LAS bf16x8*)(lds + G8_SB(b, h) + boff + n * 2048 + k * 1024); } while (0)
#define G8_MMA(ai, bj, At, Bt) do { __builtin_amdgcn_s_setprio(1); _Pragma("unroll") for (int m = 0; m < 4; ++m) _Pragma("unroll") for (int n = 0; n < 2; ++n) _Pragma("unroll") for (int k = 0; k < 2; ++k) \
        acc[ai][bj][m][n] = __builtin_amdgcn_mfma_f32_16x16x32_bf16(Bt[n][k], At[m][k], acc[ai][bj][m][n], 0, 0, 0); __builtin_amdgcn_s_setprio(0); } while (0)
#define G8_WAIT_V(n) asm volatile("s_waitcnt vmcnt(" #n ")" ::: "memory")
#define G8_WAIT_L(n) asm volatile("s_waitcnt lgkmcnt(" #n ")" ::: "memory")
#define G8_BAR __builtin_amdgcn_s_barrier()
#define G8_SCHED __builtin_amdgcn_sched_barrier(0)
    Unit cur, nxt; int ui = 0;
    if (!S.next(0, cur)) return;
    f32x4 acc[2][2][4][2];
#pragma unroll
    for (int a = 0; a < 2; ++a)
#pragma unroll
        for (int b = 0; b < 2; ++b)
#pragma unroll
            for (int m = 0; m < 4; ++m)
#pragma unroll
                for (int n = 0; n < 2; ++n) acc[a][b][m][n] = (f32x4){0.f, 0.f, 0.f, 0.f};
    bf16x8 At[4][2], B0[2][2], B1[2][2];
    unsigned cgv[2][2], ngv[2][2];
    auto gather_off = [&](const Unit& u, unsigned (&gv)[2][2]) {
        const int* rl = S.rows(u);
#pragma unroll
        for (int h = 0; h < 2; ++h)
#pragma unroll
            for (int i = 0; i < 2; ++i) { int R, C; stage_rc(tid * 16 + i * 8192, R, C);
                const int v = rl[h * 128 + R]; gv[h][i] = (v < 0 ? zero_off : hrow_off + (unsigned)(v >> 1) * 2048u) + (unsigned)C * 2u; }
    };
    const char* cA = GATHER ? Abase : Abase + (size_t)cur.pm * tstep; const char* cB = Btbase + (size_t)cur.pn * tstep;
    const char* nA = cA;
    typename Epi::Pre pre; E.prefetch(cur, wr, fr, pre);
    if (GATHER) { gather_off(cur, cgv);
#pragma unroll
        for (int h = 0; h < 2; ++h) { ngv[h][0] = cgv[h][0]; ngv[h][1] = cgv[h][1]; } }
    G8_STAGE(G8_SB(0, 0), cB, voffB); G8_STAGE_A(G8_SA(0, 0), false, 0, (size_t)0); G8_STAGE(G8_SB(0, 1), cB + bhstep, voffB); G8_STAGE_A(G8_SA(0, 1), false, 1, (size_t)0);
    if (wr == 1) G8_BAR;
    G8_WAIT_V(4); G8_BAR;
    G8_STAGE(G8_SB(1, 0), cB + kstep, voffB); G8_STAGE_A(G8_SA(1, 0), false, 0, kstep); G8_STAGE(G8_SB(1, 1), cB + bhstep + kstep, voffB);
    G8_WAIT_V(6); G8_BAR;
    for (;;) {
        const bool has_next = S.next(ui + 1, nxt);
        const char* nB = has_next ? Btbase + (size_t)nxt.pn * tstep : cB;
        if (GATHER) { if (has_next) gather_off(nxt, ngv); }
        else nA = has_next ? Abase + (size_t)nxt.pm * tstep : cA;
#pragma unroll 1
        for (int t = 0; t < nt; t += 2) {
            const bool last = (t == nt - 2);
            const size_t k1 = (size_t)(t + 1) * kstep;
            const size_t k2 = last ? (size_t)0 : (size_t)(t + 2) * kstep, k3 = k2 + kstep;
            const char* b2 = (last ? nB : cB) + k2; const char* b3 = b2 + kstep;
            G8_LDB(B0, 0, 0); G8_SCHED; G8_LDA(At, 0, 0); G8_STAGE_A(G8_SA(1, 1), false, 1, k1);
            G8_WAIT_L(8); G8_BAR; G8_WAIT_L(0); G8_MMA(0, 0, At, B0); G8_BAR; G8_SCHED;
            G8_LDB(B1, 0, 1); G8_STAGE(G8_SB(0, 0), b2, voffB);
            G8_BAR; G8_WAIT_L(0); G8_MMA(0, 1, At, B1); G8_BAR;
            G8_LDA(At, 0, 1); if (last) { G8_STAGE_A(G8_SA(0, 0), true, 0, k2); } else { G8_STAGE_A(G8_SA(0, 0), false, 0, k2); }
            G8_BAR; G8_WAIT_L(0); G8_MMA(1, 0, At, B0); G8_BAR; G8_SCHED;
            G8_STAGE(G8_SB(0, 1), b2 + bhstep, voffB);
            G8_WAIT_V(6); G8_BAR; G8_MMA(1, 1, At, B1); G8_BAR;
            G8_LDB(B0, 1, 0); G8_SCHED; G8_LDA(At, 1, 0); if (last) { G8_STAGE_A(G8_SA(0, 1), true, 1, k2); } else { G8_STAGE_A(G8_SA(0, 1), false, 1, k2); }
            G8_WAIT_L(8); G8_BAR; G8_WAIT_L(0); G8_MMA(0, 0, At, B0); G8_BAR; G8_SCHED;
            G8_LDB(B1, 1, 1); G8_STAGE(G8_SB(1, 0), b3, voffB);
            G8_BAR; G8_WAIT_L(0); G8_MMA(0, 1, At, B1); G8_BAR;
            G8_LDA(At, 1, 1); if (last) { G8_STAGE_A(G8_SA(1, 0), true, 0, k3); } else { G8_STAGE_A(G8_SA(1, 0), false, 0, k3); }
            G8_BAR; G8_WAIT_L(0); G8_MMA(1, 0, At, B0); G8_BAR; G8_SCHED;
            G8_STAGE(G8_SB(1, 1), b3 + bhstep, voffB);
            G8_WAIT_V(6); G8_BAR; G8_MMA(1, 1, At, B1); G8_BAR;
        }
        E(acc, cur, wr, wc, fr, fq, pre);
        if (!has_next) break;
#pragma unroll
        for (int a = 0; a < 2; ++a)
#pragma unroll
            for (int b = 0; b < 2; ++b)
#pragma unroll
                for (int m = 0; m < 4; ++m)
#pragma unroll
                    for (int n = 0; n < 2; ++n) acc[a][b][m][n] = (f32x4){0.f, 0.f, 0.f, 0.f};
        cur = nxt; cB = nB; ++ui;
        E.prefetch(cur, wr, fr, pre);
        if (GATHER) {
#pragma unroll
            for (int h = 0; h < 2; ++h) { cgv[h][0] = ngv[h][0]; cgv[h][1] = ngv[h][1]; }
        } else cA = nA;
    }
    G8_WAIT_V(0);
    if (wr == 0) G8_BAR;
    G8_BAR;
}

template <int NOSTORE = 0  >
struct Ep8Inproj {
    static constexpr bool PERM = true;
    bf16_t* P;
    struct Pre {}; __device__ __forceinline__ void prefetch(const g8::Unit&, int, int, Pre&) const {}
    __device__ __forceinline__ void operator()(const f32x4 (&acc)[2][2][4][2], const g8::Unit& u, int wr, int wc, int fr, int fq, const Pre&) const {
#pragma unroll
        for (int ai = 0; ai < 2; ++ai)
#pragma unroll
            for (int m = 0; m < 4; ++m) {
                bf16_t* rowp = P + (size_t)(u.pm * 256 + ai * 128 + wr * 64 + m * 16 + fr) * PW;
#pragma unroll
                for (int bj = 0; bj < 2; ++bj) {
                    const int col = u.pn * 256 + wc * 64 + bj * 32 + fq * 8;
                    u32x4 o; o.x = pk2(acc[ai][bj][m][0][0], acc[ai][bj][m][0][1]); o.y = pk2(acc[ai][bj][m][0][2], acc[ai][bj][m][0][3]);
                    o.z = pk2(acc[ai][bj][m][1][0], acc[ai][bj][m][1][1]); o.w = pk2(acc[ai][bj][m][1][2], acc[ai][bj][m][1][3]);
                    if (!NOSTORE || o.x == 0x7fc12345u) *(u32x4*)(rowp + col) = o;
                }
            }
    }
};
struct Ep8Outproj {
    static constexpr bool PERM = true;
    const float* xin; const bf16_t* xb; bf16_t* xbo; const float* modl;
    struct Pre {}; __device__ __forceinline__ void prefetch(const g8::Unit&, int, int, Pre&) const {}
    __device__ __forceinline__ void operator()(const f32x4 (&acc)[2][2][4][2], const g8::Unit& u, int wr, int wc, int fr, int fq, const Pre&) const {
        const float* gt = modl + (size_t)((u.pm * 256) >> 13) * 6144 + 2 * 1024;
        if (xin) {
#pragma unroll
            for (int bj = 0; bj < 2; ++bj) {
                const int col = u.pn * 256 + wc * 64 + bj * 32 + fq * 8;
                const float4 g0 = *(const float4*)(gt + col), g1 = *(const float4*)(gt + col + 4);
                const float gg[8] = {g0.x, g0.y, g0.z, g0.w, g1.x, g1.y, g1.z, g1.w};
#pragma unroll
                for (int ai = 0; ai < 2; ++ai)
#pragma unroll
                    for (int m = 0; m < 4; ++m) {
                        const size_t off = (size_t)(u.pm * 256 + ai * 128 + wr * 64 + m * 16 + fr) * 1024 + col;
                        float x[8];
                        { const float4 a = *(const float4*)(xin + off), b4 = *(const float4*)(xin + off + 4); x[0] = a.x; x[1] = a.y; x[2] = a.z; x[3] = a.w; x[4] = b4.x; x[5] = b4.y; x[6] = b4.z; x[7] = b4.w; }
#pragma unroll
                        for (int n = 0; n < 2; ++n)
#pragma unroll
                            for (int r = 0; r < 4; ++r) x[n * 4 + r] += gg[n * 4 + r] * acc[ai][bj][m][n][r];
                        *(u32x4*)(xbo + off) = pack8(x);
                    }
            }
            return;
        }
        const size_t rbase = (size_t)(u.pm * 256 + wr * 64 + fr) * 1024 + u.pn * 256 + wc * 64 + fq * 8;
        u32x4 xr[2][2][4];
#pragma unroll
        for (int bj = 0; bj < 2; ++bj)
#pragma unroll
            for (int ai = 0; ai < 2; ++ai)
#pragma unroll
                for (int m = 0; m < 4; ++m) xr[bj][ai][m] = *(const u32x4*)(xb + rbase + (size_t)(ai * 128 + m * 16) * 1024 + bj * 32);
        __builtin_amdgcn_sched_barrier(0);
#pragma unroll
        for (int bj = 0; bj < 2; ++bj) {
            const int col = u.pn * 256 + wc * 64 + bj * 32 + fq * 8;
            const float4 g0 = *(const float4*)(gt + col), g1 = *(const float4*)(gt + col + 4);
            const float gg[8] = {g0.x, g0.y, g0.z, g0.w, g1.x, g1.y, g1.z, g1.w};
#pragma unroll
            for (int ai = 0; ai < 2; ++ai)
#pragma unroll
                for (int m = 0; m < 4; ++m) {
                    float x[8];
                    unpack8(xr[bj][ai][m], x);
#pragma unroll
                    for (int n = 0; n < 2; ++n)
#pragma unroll
                        for (int r = 0; r < 4; ++r) x[n * 4 + r] += gg[n * 4 + r] * acc[ai][bj][m][n][r];
                    *(u32x4*)(xbo + rbase + (size_t)(ai * 128 + m * 16) * 1024 + bj * 32) = pack8(x);
                }
        }
    }
};
struct Ep8Logit {
    static constexpr bool PERM = false;
    float* Lg;
    struct Pre {}; __device__ __forceinline__ void prefetch(const g8::Unit&, int, int, Pre&) const {}
    __device__ __forceinline__ void operator()(const f32x4 (&acc)[2][2][4][2], const g8::Unit& u, int wr, int wc, int fr, int fq, const Pre&) const {
#pragma unroll
        for (int ai = 0; ai < 2; ++ai)
#pragma unroll
            for (int m = 0; m < 4; ++m) {
                float* rowp = Lg + (size_t)(u.pm * 256 + ai * 128 + wr * 64 + m * 16 + fr) * 80;
#pragma unroll
                for (int n = 0; n < 2; ++n) {
                    const int col = wc * 32 + n * 16 + fq * 4;
                    if (col < 80) *(float4*)(rowp + col) = make_float4(acc[ai][0][m][n][0], acc[ai][0][m][n][1], acc[ai][0][m][n][2], acc[ai][0][m][n][3]);
                }
            }
    }
};
struct Ep8Moe1 {
    static constexpr bool PERM = true;
    bf16_t* Hd;
    struct Pre {}; __device__ __forceinline__ void prefetch(const g8::Unit&, int, int, Pre&) const {}
    __device__ __forceinline__ void operator()(const f32x4 (&acc)[2][2][4][2], const g8::Unit& u, int wr, int wc, int fr, int fq, const Pre&) const {
        const int jb = (u.pn & 1) * 128;
#pragma unroll
        for (int ai = 0; ai < 2; ++ai)
#pragma unroll
            for (int m = 0; m < 4; ++m) {
                bf16_t* rowp = Hd + (size_t)(u.pm * 256 + ai * 128 + wr * 64 + m * 16 + fr) * 256 + jb + wc * 32 + fq * 8;
                float h[8];
#pragma unroll
                for (int n = 0; n < 2; ++n)
#pragma unroll
                    for (int r = 0; r < 4; ++r) h[n * 4 + r] = siluf_(acc[ai][0][m][n][r]) * acc[ai][1][m][n][r];
                *(u32x4*)rowp = pack8(h);
            }
    }
};
template <int LINEAR = 0  >
struct Ep8Moe2 {
    static constexpr bool PERM = true;
    bf16_t* Y; const int* rowtok; const float* rowg;
    struct Pre { int v[8]; float g[8]; };
    __device__ __forceinline__ void prefetch(const g8::Unit& u, int wr, int fr, Pre& q) const {
#pragma unroll
        for (int ai = 0; ai < 2; ++ai)
#pragma unroll
            for (int m = 0; m < 4; ++m) {
                const int row = u.pm * 256 + ai * 128 + wr * 64 + m * 16 + fr;
                q.v[ai * 4 + m] = LINEAR ? (row % (2 * T_TOK)) : rowtok[row];
                q.g[ai * 4 + m] = LINEAR ? 1.0f : rowg[row];
            }
    }
    __device__ __forceinline__ void operator()(const f32x4 (&acc)[2][2][4][2], const g8::Unit& u, int wr, int wc, int fr, int fq, const Pre& q) const {
        const int n0 = (u.pn & 3) * 256;
#pragma unroll
        for (int ai = 0; ai < 2; ++ai)
#pragma unroll
            for (int m = 0; m < 4; ++m) {
                const int v = q.v[ai * 4 + m];
                if (v >= 0) {
                    const float g = q.g[ai * 4 + m];
                    bf16_t* yp = Y + ((size_t)(v & 1) * T_TOK + (size_t)(v >> 1)) * 1024 + n0 + wc * 64 + fq * 8;
#pragma unroll
                    for (int bj = 0; bj < 2; ++bj) {
                        u32x4 o; o.x = pk2(g * acc[ai][bj][m][0][0], g * acc[ai][bj][m][0][1]); o.y = pk2(g * acc[ai][bj][m][0][2], g * acc[ai][bj][m][0][3]);
                        o.z = pk2(g * acc[ai][bj][m][1][0], g * acc[ai][bj][m][1][1]); o.w = pk2(g * acc[ai][bj][m][1][2], g * acc[ai][bj][m][1][3]);
                        *(u32x4*)(yp + bj * 32) = o;
                    }
                }
            }
    }
};

#define MOD ((float*)(ws + OFF_MOD))
#define WIN ((bf16_t*)(ws + OFF_WIN))
#define WOUT ((bf16_t*)(ws + OFF_WOUT))
#define SGUW ((bf16_t*)(ws + OFF_SGUW))
#define LWU ((bf16_t*)(ws + OFF_LWU))
#define LAU ((bf16_t*)(ws + OFF_LAU))
#define LGU ((bf16_t*)(ws + OFF_LGU))
#define ROUTW ((bf16_t*)(ws + OFF_ROUTW))
#define GCD ((float*)(ws + OFF_GCD))
#define WGU ((bf16_t*)(ws + OFF_WGU))
#define WD ((bf16_t*)(ws + OFF_WD))
#define Hb ((bf16_t*)(ws + OFF_H))
#define GAB ((float*)(ws + OFF_GAB))
#define GW ((float*)(ws + OFF_GW))
__device__ __forceinline__ int gdn_slot(int u) { return (u & ~127) | (((u & 127) + 4 * (u >> 7)) & 127); }
#define Pb ((bf16_t*)(ws + OFF_P))
#define MIX ((bf16_t*)(ws + OFF_MIX))
#define RW_E ((bf16_t*)(ws + OFF_RW))
#define RW_CE ((float*)(ws + OFF_CE))
#define RW_KK ((bf16_t*)(ws + OFF_RW + 1 * RW_ARR))
#define RW_ZB ((bf16_t*)(ws + OFF_RW + 2 * RW_ARR))
#define RW_KM ((bf16_t*)(ws + OFF_RW + 3 * RW_ARR))
#define RW_R ((bf16_t*)(ws + OFF_RW + 4 * RW_ARR))
#define RW_V ((bf16_t*)(ws + OFF_RW + 5 * RW_ARR))
#define RW_G ((bf16_t*)(ws + OFF_RW + 6 * RW_ARR))
#define YR ((bf16_t*)(ws + OFF_YR))
#define LOGIT ((float*)(ws + OFF_P + PO_LOGIT))
#define TOKINF ((uint4*)(ws + OFF_P + PO_TOKINF))
#define CBASE ((unsigned*)(ws + OFF_P + PO_CBASE))
#define ROWTOK ((int*)(ws + OFF_P + PO_ROWTOK))
#define ROWG ((float*)(ws + OFF_P + PO_ROWG))
#define TILEE ((int*)(ws + OFF_P + PO_TILEE))
#define HID ((bf16_t*)(ws + OFF_P + PO_HID))
#define YB ((bf16_t*)(ws + OFF_P + PO_Y))
#define x_in INP(0)
#define xo (p.out)
#define XB ((bf16_t*)((char*)p.out + (size_t)T_TOK * 1024 * 2))
#define XB_LAST ((bf16_t*)(ws + OFF_RW))
#define XB_MID(l) ((l) == NLAYER - 1 ? XB_LAST : XB)
#define INP(k) (p.in[k])

__device__ __forceinline__ void ph_norm1(const Params& p, const int l_in) {
    extern __shared__ __attribute__((aligned(16))) char smem[];
    int tid_ = threadIdx.x; asm volatile("" : "+v"(tid_));
    int blk_ = blockIdx.x; asm volatile("" : "+s"(blk_));
    unsigned long long w64_ = (unsigned long long)p.ws; asm volatile("" : "+s"(w64_));
    char* ws_ = (char*)(__attribute__((address_space(1))) char*)w64_;
    int l_ = l_in; asm volatile("" : "+v"(l_)); const int l = __builtin_amdgcn_readfirstlane(l_);
    const int tid = tid_, lane = tid & 63, w = tid >> 6;
    int grid_ = gridDim.x; asm volatile("" : "+s"(grid_));
    const int blk = blk_, grid = grid_;
    const int fr = lane & 15, fq = lane >> 4;
    char* const ws = ws_;
    const float* const modl = MOD + (size_t)l * 8 * 6144;
    (void)lane; (void)w; (void)fr; (void)fq; (void)modl; (void)smem; (void)blk; (void)grid;
        const float* gn = INP(4) + l * 1024;
        const float* modp = (l > 0) ? (MOD + (size_t)(l - 1) * 8 * 6144) : nullptr;
        const int gw = blk * 8 + w, nw = grid * 8;
        unsigned gwp[8][8];
    #pragma unroll
        for (int o = 0; o < 8; ++o)
    #pragma unroll
            for (int j = 0; j < 4; ++j) { const float4 w4 = *(const float4*)(GW + (size_t)l * 8192 + o * 1024 + j * 256 + lane * 4); gwp[o][j * 2] = pk2(w4.x, w4.y); gwp[o][j * 2 + 1] = pk2(w4.z, w4.w); }
        for (int r0 = gw * 32; r0 < T_TOK; r0 += nw * 32) {
            const int b = r0 >> 13;
            float gs[16], sh[16], gf[16];
    #pragma unroll
            for (int j = 0; j < 4; ++j) {
                const int c = j * 256 + lane * 4;
                const float4 g4 = *(const float4*)(gn + c);
                const float4 sc4 = *(const float4*)(modl + b * 6144 + 1024 + c);
                const float4 sh4 = *(const float4*)(modl + b * 6144 + c);
                gs[j * 4 + 0] = g4.x * (1.f + sc4.x); gs[j * 4 + 1] = g4.y * (1.f + sc4.y); gs[j * 4 + 2] = g4.z * (1.f + sc4.z); gs[j * 4 + 3] = g4.w * (1.f + sc4.w);
                sh[j * 4 + 0] = sh4.x; sh[j * 4 + 1] = sh4.y; sh[j * 4 + 2] = sh4.z; sh[j * 4 + 3] = sh4.w;
                if (l > 0) { const float4 f4 = *(const float4*)(modp + b * 6144 + 5 * 1024 + c); gf[j * 4 + 0] = f4.x; gf[j * 4 + 1] = f4.y; gf[j * 4 + 2] = f4.z; gf[j * 4 + 3] = f4.w; }
                else { gf[j * 4 + 0] = 0.f; gf[j * 4 + 1] = 0.f; gf[j * 4 + 2] = 0.f; gf[j * 4 + 3] = 0.f; }
            }
            u32x2 cxb[4], cy0[4], cy1[4];
            float4 cxf[4];
            if (l > 0) {
    #pragma unroll
                for (int j = 0; j < 4; ++j) { const size_t o_ = (size_t)r0 * 1024 + j * 256 + lane * 4; cxb[j] = *(const u32x2*)(XB + o_); cy0[j] = *(const u32x2*)(YB + o_); cy1[j] = *(const u32x2*)(YB + (size_t)T_TOK * 1024 + o_); }
            } else {
    #pragma unroll
                for (int j = 0; j < 4; ++j) cxf[j] = *(const float4*)(x_in + (size_t)r0 * 1024 + j * 256 + lane * 4);
            }
            for (int r = r0; r < r0 + 32; ++r) {
                float xv[16]; float ss = 0.f;
                u32x2 nxb[4], ny0[4], ny1[4];
                float4 nxf[4];
                if (l > 0) {
                    const int rn = (r + 1 < r0 + 32) ? r + 1 : r;
    #pragma unroll
                    for (int j = 0; j < 4; ++j) { const size_t o_ = (size_t)rn * 1024 + j * 256 + lane * 4; nxb[j] = *(const u32x2*)(XB + o_); ny0[j] = *(const u32x2*)(YB + o_); ny1[j] = *(const u32x2*)(YB + (size_t)T_TOK * 1024 + o_); }
                } else {
                    const int rn = (r + 1 < r0 + 32) ? r + 1 : r;
    #pragma unroll
                    for (int j = 0; j < 4; ++j) nxf[j] = *(const float4*)(x_in + (size_t)rn * 1024 + j * 256 + lane * 4);
                }
    #pragma unroll
                for (int j = 0; j < 4; ++j) {
                    const int c = j * 256 + lane * 4;
                    float4 v;
                    if (l == 0) v = cxf[j];
                    else {
                        const u32x2 xb = cxb[j];
                        const u32x2 y0 = cy0[j];
                        const u32x2 y1 = cy1[j];
                        v.x = bflo(xb.x) + gf[j * 4 + 0] * (bflo(y0.x) + bflo(y1.x)); v.y = bfhi(xb.x) + gf[j * 4 + 1] * (bfhi(y0.x) + bfhi(y1.x));
                        v.z = bflo(xb.y) + gf[j * 4 + 2] * (bflo(y0.y) + bflo(y1.y)); v.w = bfhi(xb.y) + gf[j * 4 + 3] * (bfhi(y0.y) + bfhi(y1.y));
                        u32x2 xn; xn.x = pk2(v.x, v.y); xn.y = pk2(v.z, v.w);
                        *(u32x2*)(XB + (size_t)r * 1024 + c) = xn;
                    }
                    xv[j * 4 + 0] = v.x; xv[j * 4 + 1] = v.y; xv[j * 4 + 2] = v.z; xv[j * 4 + 3] = v.w;
                    ss += v.x * v.x + v.y * v.y + v.z * v.z + v.w * v.w;
                }
                ss = wave_sum(ss);
                const float rs = rsqrtf(ss * (1.0f / 1024.0f) + 1e-6f);
    #pragma unroll
                for (int i = 0; i < 16; ++i) xv[i] = xv[i] * rs * gs[i] + sh[i];
                unsigned hp[8];
    #pragma unroll
                for (int j = 0; j < 4; ++j) {
                    const int c = j * 256 + lane * 4;
                    u32x2 o;
                    o.x = pk2(xv[j * 4 + 0], xv[j * 4 + 1]);
                    o.y = pk2(xv[j * 4 + 2], xv[j * 4 + 3]);
                    *(u32x2*)(Hb + (size_t)r * 1024 + c) = o;
                    hp[j * 2] = o.x; hp[j * 2 + 1] = o.y;
                }
                float gd[8];
    #pragma unroll
                for (int o = 0; o < 8; ++o) {
                    float s = 0.f;
    #pragma unroll
                    for (int i = 0; i < 8; ++i) s = __builtin_amdgcn_fdot2_f32_bf16(__builtin_bit_cast(bf16x2_t, hp[i]), __builtin_bit_cast(bf16x2_t, gwp[o][i]), s, false);
                    gd[o] = s;
                }
    #pragma unroll
                for (int i = 0; i < 4; ++i) { const float keep = (lane & 1) ? gd[4 + i] : gd[i], send = (lane & 1) ? gd[i] : gd[4 + i]; gd[i] = keep + dpp_f<0xB1>(send); }
    #pragma unroll
                for (int i = 0; i < 2; ++i) { const float keep = (lane & 2) ? gd[2 + i] : gd[i], send = (lane & 2) ? gd[i] : gd[2 + i]; gd[i] = keep + dpp_f<0x4E>(send); }
                { const float keep = (lane & 4) ? gd[1] : gd[0], send = (lane & 4) ? gd[0] : gd[1]; gd[0] = keep + dpp_f<0x124>(send); }
                gd[0] += dpp_f<0x128>(gd[0]); gd[0] += __shfl_xor(gd[0], 16); gd[0] += __shfl_xor(gd[0], 32);
                if (lane < 8) GAB[(size_t)r * 8 + (((lane & 1) << 2) | (lane & 2) | ((lane >> 2) & 1))] = gd[0];
                if (l > 0) {
    #pragma unroll
                    for (int j = 0; j < 4; ++j) { cxb[j] = nxb[j]; cy0[j] = ny0[j]; cy1[j] = ny1[j]; }
                } else {
    #pragma unroll
                    for (int j = 0; j < 4; ++j) cxf[j] = nxf[j];
                }
            }
        }
}

template <int NOSTORE = 0>
__device__ __forceinline__ void ph_inproj(const Params& p, const int l_in) {
    extern __shared__ __attribute__((aligned(16))) char smem[];
    int tid_ = threadIdx.x; asm volatile("" : "+v"(tid_));
    int blk_ = blockIdx.x; asm volatile("" : "+s"(blk_));
    unsigned long long w64_ = (unsigned long long)p.ws; asm volatile("" : "+s"(w64_));
    char* ws_ = (char*)(__attribute__((address_space(1))) char*)w64_;
    int l_ = l_in; asm volatile("" : "+v"(l_)); const int l = __builtin_amdgcn_readfirstlane(l_);
    const int tid = tid_, lane = tid & 63, w = tid >> 6;
    int grid_ = gridDim.x; asm volatile("" : "+s"(grid_));
    const int blk = blk_, grid = grid_;
    const int fr = lane & 15, fq = lane >> 4;
    char* const ws = ws_;
    const float* const modl = MOD + (size_t)l * 8 * 6144;
    (void)lane; (void)w; (void)fr; (void)fq; (void)modl; (void)smem; (void)blk; (void)grid;
        g8::StaticOrder S; S.init(T_TOK, 3328, grid, blk);
        Ep8Inproj<NOSTORE> ep{Pb};
        gemm8<Ep8Inproj<NOSTORE>, g8::StaticOrder, false>(tid, (LAS unsigned char*)smem, (const char*)Hb, (const char*)(WIN + (size_t)l * WIN_ROWS * 1024), 1024, S, ep, 0u, 0u);
}

template <int SKIPST = 0  >
__device__ __forceinline__ void ph_rwprep(const Params& p, const int l_in, const int part = 2, const int first_in = -1, const int stride_in = 0) {
    extern __shared__ __attribute__((aligned(16))) char smem[];
    int tid_ = threadIdx.x; asm volatile("" : "+v"(tid_));
    int blk_ = blockIdx.x; asm volatile("" : "+s"(blk_));
    unsigned long long w64_ = (unsigned long long)p.ws; asm volatile("" : "+s"(w64_));
    char* ws_ = (char*)(__attribute__((address_space(1))) char*)w64_;
    int l_ = l_in; asm volatile("" : "+v"(l_)); const int l = __builtin_amdgcn_readfirstlane(l_);
    const int tid = tid_, lane = tid & 63, w = tid >> 6;
    int grid_ = gridDim.x; asm volatile("" : "+s"(grid_));
    const int blk = blk_, grid = grid_;
    const int fr = lane & 15, fq = lane >> 4;
    char* const ws = ws_;
    const float* const modl = MOD + (size_t)l * 8 * 6144;
    (void)lane; (void)w; (void)fr; (void)fq; (void)modl; (void)smem; (void)blk; (void)grid;
        bf16_t* X = (bf16_t*)smem;
        float* Kf = (float*)(smem + 33792);
        float* RS = (float*)(smem + 33792 + 65536);
        float* MU = (float*)(smem + 33792 + 65536 + 1024);
        for (int i = tid; i < 1024; i += 512) MU[i] = INP(17)[l * 1024 + i];
        lds_barrier();
        const float* w0 = INP(18) + l * 256; const float* a0 = INP(20) + l * 256;
        const float* kkp = INP(23) + l * 256; const float* kap = INP(24) + l * 256;
        const int nidx = part == 2 ? 1024 : (part == 0 ? 8 * RW_EARLY : 8 * (128 - RW_EARLY));
        int idx0_ = first_in < 0 ? blk : first_in; asm volatile("" : "+s"(idx0_));
        const int idxs = first_in < 0 ? grid : stride_in;
        for (int idx = idx0_; idx < nidx; idx += idxs) {
            const int tile = part == 2 ? idx : (part == 0 ? (idx / RW_EARLY) * 128 + idx % RW_EARLY : (idx / (128 - RW_EARLY)) * 128 + RW_EARLY + idx % (128 - RW_EARLY));
            const int t0 = tile * 64;
            {
                const int tok = tid >> 3, sub = tid & 7;
                const size_t t = (size_t)t0 + tok;
                const bool hasprev = ((t & (SEQ - 1)) != 0);
                const bf16_t* pc = Pb + t * PW + PC_RW;
                u32x4 cua[16], pua[16];
    #pragma unroll
                for (int it = 0; it < 16; ++it) cua[it] = *(const u32x4*)(pc + it * 64 + sub * 8);
    #pragma unroll
                for (int it = 0; it < 16; ++it) pua[it] = hasprev ? *(const u32x4*)(pc - PW + it * 64 + sub * 8) : (u32x4){0u, 0u, 0u, 0u};
    #pragma unroll
                for (int it = 0; it < 16; ++it) {
                    const int c = it * 64 + sub * 8;
                    const u32x4 cu = cua[it], pu = pua[it];
                    float cf[8], pf[8], ps[8];
                    unpack8(cu, cf); unpack8(pu, pf);
                    const float4 m0 = *(const float4*)(MU + c), m1 = *(const float4*)(MU + c + 4);
                    const float mm[8] = {m0.x, m0.y, m0.z, m0.w, m1.x, m1.y, m1.z, m1.w};
    #pragma unroll
                    for (int i = 0; i < 8; ++i) ps[i] = cf[i] + (pf[i] - cf[i]) * mm[i];
                    if (it < 4) { *(u32x4*)(RW_R + t * 256 + c) = pack8(ps); }
                    else if (it < 8) {
    #pragma unroll
                        for (int i = 0; i < 8; ++i) Kf[tok * 256 + (c - 256) + i] = ps[i];
                    }
                    else if (it < 12) { *(u32x4*)(RW_V + t * 256 + (c - 512)) = pack8(ps); }
                    else if (it == 12) {
    #pragma unroll
                        for (int i = 0; i < 8; ++i) ps[i] = tanhf_(ps[i]);
                        *(u32x4*)(X + tok * 264 + (c - 768)) = pack8(ps);
                    }
                    else if (it == 13) { *(u32x4*)(X + tok * 264 + 64 + (c - 832)) = pack8(ps); }
                    else {
    #pragma unroll
                        for (int i = 0; i < 8; ++i) ps[i] = sigmoidf_(ps[i]);
                        *(u32x4*)(X + tok * 264 + 128 + (c - 896)) = pack8(ps);
                    }
                }
            }
            lds_barrier();
            {
                const int tok = tid >> 3, sub = tid & 7, hd = sub >> 1, hf = sub & 1;
                float s = 0.f;
                for (int i = 0; i < 32; ++i) { const int ch = hd * 64 + hf * 32 + i; const float v = Kf[tok * 256 + ch] * kkp[ch]; s += v * v; }
                s += __shfl_xor(s, 1);
                if (hf == 0) RS[tok * 4 + hd] = rsqrtf(s + 1e-12f);
            }
            lds_barrier();
            {
#pragma unroll 1
                for (int mh = 0; mh < 2; ++mh) {
                f32x4 aw[2][2], aa[2][2], ag[2][2];
    #pragma unroll
                for (int m = 0; m < 2; ++m)
    #pragma unroll
                    for (int n = 0; n < 2; ++n) { aw[m][n] = (f32x4){0.f, 0.f, 0.f, 0.f}; aa[m][n] = aw[m][n]; ag[m][n] = aw[m][n]; }
    #pragma unroll
                for (int ks = 0; ks < 2; ++ks) {
                    bf16x8 bx[2], bxa[2];
    #pragma unroll
                    for (int m = 0; m < 2; ++m) { bx[m] = ld_frag(X + ((mh * 2 + m) * 16 + fr) * 264 + ks * 32 + fq * 8); bxa[m] = ld_frag(X + ((mh * 2 + m) * 16 + fr) * 264 + 64 + ks * 32 + fq * 8); }
    #pragma unroll
                    for (int n = 0; n < 2; ++n) {
                        const int chr = w * 32 + g8::perm32(n * 16 + fr);
                        const bf16x8 fw = ld_frag(LWU + ((size_t)l * 256 + chr) * 64 + ks * 32 + fq * 8);
                        const bf16x8 fa = ld_frag(LAU + ((size_t)l * 256 + chr) * 64 + ks * 32 + fq * 8);
    #pragma unroll
                        for (int m = 0; m < 2; ++m) { aw[m][n] = mfma16(fw, bx[m], aw[m][n]); aa[m][n] = mfma16(fa, bxa[m], aa[m][n]); }
                    }
                }
    #pragma unroll
                for (int ks = 0; ks < 4; ++ks) {
                    bf16x8 bx[2];
    #pragma unroll
                    for (int m = 0; m < 2; ++m) bx[m] = ld_frag(X + ((mh * 2 + m) * 16 + fr) * 264 + 128 + ks * 32 + fq * 8);
    #pragma unroll
                    for (int n = 0; n < 2; ++n) {
                        const int chr = w * 32 + g8::perm32(n * 16 + fr);
                        const bf16x8 fg = ld_frag(LGU + ((size_t)l * 256 + chr) * 128 + ks * 32 + fq * 8);
    #pragma unroll
                        for (int m = 0; m < 2; ++m) ag[m][n] = mfma16(fg, bx[m], ag[m][n]);
                    }
                }
                {
                    const int ch0 = w * 32 + fq * 8;
                    float w0a[8], a0a[8], kka[8], kaa[8];
    #pragma unroll
                    for (int n = 0; n < 2; ++n) {
                        const float4 w04 = *(const float4*)(w0 + ch0 + 4 * n), a04 = *(const float4*)(a0 + ch0 + 4 * n), kk4 = *(const float4*)(kkp + ch0 + 4 * n), ka4 = *(const float4*)(kap + ch0 + 4 * n);
                        w0a[4 * n] = w04.x; w0a[4 * n + 1] = w04.y; w0a[4 * n + 2] = w04.z; w0a[4 * n + 3] = w04.w;
                        a0a[4 * n] = a04.x; a0a[4 * n + 1] = a04.y; a0a[4 * n + 2] = a04.z; a0a[4 * n + 3] = a04.w;
                        kka[4 * n] = kk4.x; kka[4 * n + 1] = kk4.y; kka[4 * n + 2] = kk4.z; kka[4 * n + 3] = kk4.w;
                        kaa[4 * n] = ka4.x; kaa[4 * n + 1] = ka4.y; kaa[4 * n + 2] = ka4.z; kaa[4 * n + 3] = ka4.w;
                    }
                    float e2[2][8];
    #pragma unroll
                    for (int m = 0; m < 2; ++m) {
                        const int tok = (mh * 2 + m) * 16 + fr;
                        const size_t t = (size_t)t0 + tok;
                        const float rs = RS[tok * 4 + (ch0 >> 6)];
                        float e[8], kkv[8], zb[8], km[8], gg[8];
    #pragma unroll
                        for (int n = 0; n < 2; ++n)
    #pragma unroll
                            for (int r = 0; r < 4; ++r) {
                                const int q = 4 * n + r;
                                const float zw = w0a[q] + aw[m][n][r];
                                const float wlog = -softplusf_(-zw) - 0.5f;
                                e[q] = -fexp_(wlog);
                                const float a = sigmoidf_(a0a[q] + aa[m][n][r]);
                                const float kv = Kf[tok * 256 + ch0 + q];
                                kkv[q] = kv * kka[q] * rs;
                                km[q] = kv * (1.0f + (a - 1.0f) * kaa[q]);
                                zb[q] = kkv[q] * a;
                                gg[q] = ag[m][n][r];
                            }
    #pragma unroll
                        for (int q = 0; q < 8; ++q) e2[m][q] = e[q];
                        if (SKIPST) { if (e[0] + kkv[1] + zb[2] + km[3] + gg[0] == 123.456f) RS[0] = 1.f; continue; }
                        *(u32x4*)(RW_KK + t * 256 + ch0) = pack8(kkv);
                        *(u32x4*)(RW_ZB + t * 256 + ch0) = pack8(zb);
                        *(u32x4*)(RW_KM + t * 256 + ch0) = pack8(km);
                        *(u32x4*)(RW_G + t * 256 + ch0) = pack8(gg);
                    }
                    if (!SKIPST) {
    #pragma unroll
                        for (int q = 0; q < 8; ++q) {
                            float x0 = e2[0][q], x1 = e2[1][q];
                            const float tot0 = rowsum16(x0);
                            x0 += dpp_f<0x111>(x0); x0 += dpp_f<0x112>(x0); x0 += dpp_f<0x114>(x0); x0 += dpp_f<0x118>(x0);
                            x1 += dpp_f<0x111>(x1); x1 += dpp_f<0x112>(x1); x1 += dpp_f<0x114>(x1); x1 += dpp_f<0x118>(x1);
                            e2[0][q] = x0; e2[1][q] = x1 + tot0;
                        }
    #pragma unroll
                        for (int m = 0; m < 2; ++m) {
                            float* cp = RW_CE + ((size_t)t0 + (mh * 2 + m) * 16 + fr) * 256 + ch0;
                            *(float4*)cp = make_float4(fexp_(e2[m][0]), fexp_(e2[m][1]), fexp_(e2[m][2]), fexp_(e2[m][3])); *(float4*)(cp + 4) = make_float4(fexp_(e2[m][4]), fexp_(e2[m][5]), fexp_(e2[m][6]), fexp_(e2[m][7]));
                        }
                    }
                }
                }
            }
            lds_barrier();
        }
}

__device__ __forceinline__ void ph_conv(const Params& p, const int l_in, const int b_first, const int b_count) {
    extern __shared__ __attribute__((aligned(16))) char smem[];
    int tid_ = threadIdx.x; asm volatile("" : "+v"(tid_));
    int blk_ = blockIdx.x; asm volatile("" : "+s"(blk_));
    unsigned long long w64_ = (unsigned long long)p.ws; asm volatile("" : "+s"(w64_));
    char* ws_ = (char*)(__attribute__((address_space(1))) char*)w64_;
    int l_ = l_in; asm volatile("" : "+v"(l_)); const int l = __builtin_amdgcn_readfirstlane(l_);
    const int tid = tid_, lane = tid & 63, w = tid >> 6;
    int grid_ = gridDim.x; asm volatile("" : "+s"(grid_));
    const int blk = blk_, grid = grid_;
    const int fr = lane & 15, fq = lane >> 4;
    char* const ws = ws_;
    const float* const modl = MOD + (size_t)l * 8 * 6144;
    (void)lane; (void)w; (void)fr; (void)fq; (void)modl; (void)smem; (void)blk; (void)grid;
        const float* cw = INP(16) + l * 3 * 256;
        for (int item = b_first * 512 + tid; item < T_TOK * 32; item += b_count * 512) {
            const size_t t = (size_t)(item >> 5); const int c8 = (item & 31) * 8;
            const int pos = (int)(t & (SEQ - 1));
            const bf16_t* pr = Pb + t * PW;
            float acc[8];
    #pragma unroll
            for (int i = 0; i < 8; ++i) acc[i] = 0.f;
            u32x4 ra[3], rb[3];
    #pragma unroll
            for (int k = 0; k < 3; ++k) {
                const int back = (pos >= 2 - k) ? 2 - k : 0;
                ra[k] = *(const u32x4*)(pr - (size_t)back * PW + PC_CC + c8);
                rb[k] = *(const u32x4*)(pr - (size_t)back * PW + PC_CH + c8);
            }
            const u32x4 rg = *(const u32x4*)(pr + PC_CB + c8);
    #pragma unroll
            for (int k = 0; k < 3; ++k) {
                const float msk = (pos >= 2 - k) ? 1.f : 0.f;
                float a[8], b[8];
                unpack8(ra[k], a); unpack8(rb[k], b);
                const float4 w0 = *(const float4*)(cw + k * 256 + c8), w1 = *(const float4*)(cw + k * 256 + c8 + 4);
                const float ww[8] = {w0.x * msk, w0.y * msk, w0.z * msk, w0.w * msk, w1.x * msk, w1.y * msk, w1.z * msk, w1.w * msk};
    #pragma unroll
                for (int i = 0; i < 8; ++i) acc[i] += ww[i] * a[i] * b[i];
            }
            float g[8]; unpack8(rg, g);
    #pragma unroll
            for (int i = 0; i < 8; ++i) acc[i] *= g[i];
            *(u32x4*)(MIX + t * 1024 + 512 + c8) = pack8(acc);
        }
}

__device__ __forceinline__ void ph_sgu(const Params& p, const int l_in, const int b_first, const int b_count) {
    extern __shared__ __attribute__((aligned(16))) char smem[];
    int tid_ = threadIdx.x; asm volatile("" : "+v"(tid_));
    int blk_ = blockIdx.x; asm volatile("" : "+s"(blk_));
    unsigned long long w64_ = (unsigned long long)p.ws; asm volatile("" : "+s"(w64_));
    char* ws_ = (char*)(__attribute__((address_space(1))) char*)w64_;
    int l_ = l_in; asm volatile("" : "+v"(l_)); const int l = __builtin_amdgcn_readfirstlane(l_);
    const int tid = tid_, lane = tid & 63, w = tid >> 6;
    int grid_ = gridDim.x; asm volatile("" : "+s"(grid_));
    const int blk = blk_, grid = grid_;
    const int fr = lane & 15, fq = lane >> 4;
    char* const ws = ws_;
    const float* const modl = MOD + (size_t)l * 8 * 6144;
    (void)lane; (void)w; (void)fr; (void)fq; (void)modl; (void)smem; (void)blk; (void)grid;
        bf16_t* VT = (bf16_t*)smem;
        const float* lng = INP(12) + l * 256; const float* lnb = INP(13) + l * 256;
        const float* sb = INP(15) + (size_t)l * 4 * 128;
        for (int ci = b_first; ci < 512; ci += b_count) {
            const size_t t0 = (size_t)ci * 128;
            {
                const float4 g4 = *(const float4*)(lng + lane * 4), b4 = *(const float4*)(lnb + lane * 4);
                u32x2 raws[16];
    #pragma unroll
                for (int i = 0; i < 16; ++i) raws[i] = *(const u32x2*)(Pb + (t0 + w * 16 + i) * PW + PC_SV + lane * 4);
    #pragma unroll
                for (int i = 0; i < 16; ++i) {
                    const int s = w * 16 + i;
                    const u32x2 raw = raws[i];
                    float g[4] = {geluf_(bflo(raw.x)), geluf_(bfhi(raw.x)), geluf_(bflo(raw.y)), geluf_(bfhi(raw.y))};
                    const float mean = wave_sum(g[0] + g[1] + g[2] + g[3]) * (1.0f / 256.0f);
                    float d[4] = {g[0] - mean, g[1] - mean, g[2] - mean, g[3] - mean};
                    const float var = wave_sum(d[0] * d[0] + d[1] * d[1] + d[2] * d[2] + d[3] * d[3]) * (1.0f / 256.0f);
                    const float rs = rsqrtf(var + 1e-5f);
                    VT[(lane * 4 + 0) * 136 + s] = f2bf(d[0] * rs * g4.x + b4.x);
                    VT[(lane * 4 + 1) * 136 + s] = f2bf(d[1] * rs * g4.y + b4.y);
                    VT[(lane * 4 + 2) * 136 + s] = f2bf(d[2] * rs * g4.z + b4.z);
                    VT[(lane * 4 + 3) * 136 + s] = f2bf(d[3] * rs * g4.w + b4.w);
                }
            }
            lds_barrier();
            {
                const int hd = w >> 1;
                const bf16_t* Wh = SGUW + ((size_t)(l * 4 + hd)) * 128 * 128;
                u32x2 rawu[8][2];
    #pragma unroll
                for (int m = 0; m < 8; ++m)
    #pragma unroll
                    for (int n = 0; n < 2; ++n) rawu[m][n] = *(const u32x2*)(Pb + (t0 + m * 16 + fr) * PW + PC_SU + w * 32 + n * 16 + fq * 4);
                f32x4 acc[8][2];
    #pragma unroll
                for (int m = 0; m < 8; ++m) { acc[m][0] = (f32x4){0.f, 0.f, 0.f, 0.f}; acc[m][1] = acc[m][0]; }
    #pragma unroll
                for (int ks = 0; ks < 4; ++ks) {
                    const bf16x8 a0 = ld_frag(VT + (w * 32 + fr) * 136 + ks * 32 + fq * 8);
                    const bf16x8 a1 = ld_frag(VT + (w * 32 + 16 + fr) * 136 + ks * 32 + fq * 8);
    #pragma unroll
                    for (int m = 0; m < 8; ++m) {
                        if (ks <= (m >> 1)) {
                            const bf16x8 bw = ld_frag(Wh + (size_t)(m * 16 + fr) * 128 + ks * 32 + fq * 8);
                            acc[m][0] = mfma16(a0, bw, acc[m][0]); acc[m][1] = mfma16(a1, bw, acc[m][1]);
                        }
                    }
                }
    #pragma unroll
                for (int m = 0; m < 8; ++m) {
                    const int tok = m * 16 + fr;
                    const float bias = sb[hd * 128 + tok];
    #pragma unroll
                    for (int n = 0; n < 2; ++n) {
                        const int ch0 = w * 32 + n * 16 + fq * 4;
                        const u32x2 raw = rawu[m][n];
                        u32x2 o;
                        o.x = pk2(geluf_(bflo(raw.x)) * (acc[m][n][0] + bias), geluf_(bfhi(raw.x)) * (acc[m][n][1] + bias));
                        o.y = pk2(geluf_(bflo(raw.y)) * (acc[m][n][2] + bias), geluf_(bfhi(raw.y)) * (acc[m][n][3] + bias));
                        *(u32x2*)(MIX + (t0 + tok) * 1024 + 256 + ch0) = o;
                    }
                }
            }
            lds_barrier();
        }
}

template <int SKIP = 0  >
__device__ __forceinline__ void ph_gdn1(const Params& p, const int l_in, const int u_first, const int u_stride, const int u_end) {
    extern __shared__ __attribute__((aligned(16))) char smem[];
    int tid_ = threadIdx.x; asm volatile("" : "+v"(tid_));
    int blk_ = blockIdx.x; asm volatile("" : "+s"(blk_));
    unsigned long long w64_ = (unsigned long long)p.ws; asm volatile("" : "+s"(w64_));
    char* ws_ = (char*)(__attribute__((address_space(1))) char*)w64_;
    int l_ = l_in; asm volatile("" : "+v"(l_)); const int l = __builtin_amdgcn_readfirstlane(l_);
    const int tid = tid_, lane = tid & 63, w = tid >> 6;
    int grid_ = gridDim.x; asm volatile("" : "+s"(grid_));
    const int blk = blk_, grid = grid_;
    const int fr = lane & 15, fq = lane >> 4;
    char* const ws = ws_;
    const float* const modl = MOD + (size_t)l * 8 * 6144;
    (void)lane; (void)w; (void)fr; (void)fq; (void)modl; (void)smem; (void)blk; (void)grid;
        bf16_t* Qb = (bf16_t*)(smem);
        bf16_t* Kb = (bf16_t*)(smem + 9216);
        bf16_t* AT = (bf16_t*)(smem + 18432);
        bf16_t* UT = (bf16_t*)(smem + 27648);
        bf16_t* WT = (bf16_t*)(smem + 36864);
        bf16_t* KTT = (bf16_t*)(smem + 46080);
        float* XS = (float*)(smem + 55296);
        bf16_t* AmB = (bf16_t*)(smem + 88064);
        float* Ad = (float*)(smem + 97280);
        float* Tb = (float*)(smem + 101376);
        float* gcs = (float*)(smem + 105472);
        float* beta = gcs + 64; float* eg = gcs + 128; float* graw = gcs + 192;
        float* CW = (float*)(smem + 106496);
        for (int i = tid; i < 4 * 768; i += 512) CW[i] = INP(8)[(size_t)l * 4 * 768 + i];
        const float alog_all[4] = {INP(9)[l * 4 + 0], INP(9)[l * 4 + 1], INP(9)[l * 4 + 2], INP(9)[l * 4 + 3]};
        const float dtb_all[4] = {INP(10)[l * 4 + 0], INP(10)[l * 4 + 1], INP(10)[l * 4 + 2], INP(10)[l * 4 + 3]};
        lds_barrier();
        for (int u = u_first; u < u_end; u += u_stride) {
            int tidu_ = tid; asm volatile("" : "+v"(tidu_));
            const int tid = tidu_, lane = tid & 63, w = tid >> 6, fr = lane & 15, fq = lane >> 4;
            const int b = u >> 9, hd = (u >> 7) & 3, nch = u & 127;
            const size_t t0 = (size_t)b * SEQ + (size_t)nch * 64;
            {
                const int i = tid >> 3, sub = tid & 7;
                const int pos = nch * 64 + i;
                const bf16_t* pr = Pb + (t0 + i) * PW;
                float q[8], k[8], v[8];
    #pragma unroll
                for (int e = 0; e < 8; ++e) { q[e] = 0.f; k[e] = 0.f; v[e] = 0.f; }
                u32x4 rq_[4], rk_[4], rv_[4];
    #pragma unroll
                for (int j = 0; j < 4; ++j) {
                    const int back = (pos >= 3 - j) ? 3 - j : 0;
                    const bf16_t* pp = pr - (size_t)back * PW + hd * 64 + sub * 8;
                    rq_[j] = *(const u32x4*)(pp + PC_Q); rk_[j] = *(const u32x4*)(pp + PC_K); rv_[j] = *(const u32x4*)(pp + PC_V);
                }
                const float ga_raw = GAB[(t0 + i) * 8 + hd], gb_raw = GAB[(t0 + i) * 8 + 4 + hd];
    #pragma unroll
                for (int j = 0; j < 4; ++j) {
                    const float msk = (pos >= 3 - j && !(SKIP & 2)) ? 1.f : 0.f;
                    float a[8], bb[8], c[8];
                    unpack8(rq_[j], a); unpack8(rk_[j], bb); unpack8(rv_[j], c);
                    const float* wq = CW + j * 768 + hd * 64 + sub * 8;
                    const float4 q0 = *(const float4*)(wq), q1 = *(const float4*)(wq + 4);
                    const float4 k0 = *(const float4*)(wq + 256), k1 = *(const float4*)(wq + 260);
                    const float4 v0 = *(const float4*)(wq + 512), v1 = *(const float4*)(wq + 516);
                    const float wqa[8] = {q0.x, q0.y, q0.z, q0.w, q1.x, q1.y, q1.z, q1.w};
                    const float wka[8] = {k0.x, k0.y, k0.z, k0.w, k1.x, k1.y, k1.z, k1.w};
                    const float wva[8] = {v0.x, v0.y, v0.z, v0.w, v1.x, v1.y, v1.z, v1.w};
    #pragma unroll
                    for (int e = 0; e < 8; ++e) { q[e] += msk * wqa[e] * a[e]; k[e] += msk * wka[e] * bb[e]; v[e] += msk * wva[e] * c[e]; }
                }
                float sq = 0.f, sk = 0.f;
    #pragma unroll
                for (int e = 0; e < 8; ++e) { q[e] = siluf_(q[e]); k[e] = siluf_(k[e]); v[e] = siluf_(v[e]); sq += q[e] * q[e]; sk += k[e] * k[e]; }
                sq += dpp_f<0xB1>(sq); sq += dpp_f<0x4E>(sq); sq += dpp_f<0x141>(sq);
                sk += dpp_f<0xB1>(sk); sk += dpp_f<0x4E>(sk); sk += dpp_f<0x141>(sk);
                const float rq = rsqrtf(sq + 1e-6f) * 0.125f, rk = rsqrtf(sk + 1e-6f);
    #pragma unroll
                for (int e = 0; e < 8; ++e) { q[e] *= rq; k[e] *= rk; }
                *(u32x4*)(Qb + i * 72 + sub * 8) = pack8(q);
                *(u32x4*)(Kb + i * 72 + sub * 8) = pack8(k);
                *(float4*)(XS + i * 128 + 64 + sub * 8) = make_float4(k[0], k[1], k[2], k[3]); *(float4*)(XS + i * 128 + 64 + sub * 8 + 4) = make_float4(k[4], k[5], k[6], k[7]);
                *(float4*)(XS + i * 128 + sub * 8) = make_float4(v[0], v[1], v[2], v[3]); *(float4*)(XS + i * 128 + sub * 8 + 4) = make_float4(v[4], v[5], v[6], v[7]);
                if (sub == 0) {
                    const float a = ga_raw, bb = gb_raw;
                    const float alg = hd == 0 ? alog_all[0] : hd == 1 ? alog_all[1] : hd == 2 ? alog_all[2] : alog_all[3];
                    const float dtb = hd == 0 ? dtb_all[0] : hd == 1 ? dtb_all[1] : hd == 2 ? dtb_all[2] : dtb_all[3];
                    graw[i] = -fexp_(alg) * softplusf_(a + dtb);
                    beta[i] = sigmoidf_(bb);
                }
            }
            lds_barrier();
            if (w == 0) {
                float g = graw[lane];
                g += dpp_f<0x111>(g); g += dpp_f<0x112>(g); g += dpp_f<0x114>(g); g += dpp_f<0x118>(g);
                const int gi_ = __float_as_int(g);
                const float t0_ = __int_as_float(__builtin_amdgcn_readlane(gi_, 15)), t1_ = __int_as_float(__builtin_amdgcn_readlane(gi_, 31)), t2_ = __int_as_float(__builtin_amdgcn_readlane(gi_, 47));
                g += (lane >= 48) ? (t0_ + t1_ + t2_) : (lane >= 32) ? (t0_ + t1_) : (lane >= 16) ? t0_ : 0.f;
                gcs[lane] = g; eg[lane] = fexp_(g);
            }
            lds_barrier();
            {
    #pragma unroll
                for (int q2 = 0; q2 < 2; ++q2) {
                    const int ti = w * 2 + q2, mt = ti >> 2, nt = ti & 3;
                    f32x4 ckk = (f32x4){0.f, 0.f, 0.f, 0.f}, cqk = ckk;
                    if (nt <= mt) {
    #pragma unroll
                        for (int ks = 0; ks < 2; ++ks) {
                            const bf16x8 fk = ld_frag(Kb + (mt * 16 + fr) * 72 + ks * 32 + fq * 8);
                            const bf16x8 fqv = ld_frag(Qb + (mt * 16 + fr) * 72 + ks * 32 + fq * 8);
                            const bf16x8 fb = ld_frag(Kb + (nt * 16 + fr) * 72 + ks * 32 + fq * 8);
                            ckk = mfma16(fk, fb, ckk); cqk = mfma16(fqv, fb, cqk);
                        }
                    }
                    const int jj = nt * 16 + fr;
                    const float gj = gcs[jj];
    #pragma unroll
                    for (int r = 0; r < 4; ++r) {
                        const int ii = mt * 16 + fq * 4 + r;
                        const float dec = (ii >= jj) ? fexp_(gcs[ii] - gj) : 0.f;
                        const float aval = (ii > jj) ? beta[ii] * ckk[r] * dec : 0.f;
                        AmB[ii * 72 + jj] = f2bf(-aval);
                        if (mt == nt) Ad[mt * 256 + (ii & 15) * 16 + (jj & 15)] = aval;
                        AT[ii * 72 + jj] = f2bf((ii >= jj) ? cqk[r] * dec : 0.f);
                    }
                }
            }
            lds_barrier();
            if (w == 0) {
                const int b = lane >> 4, c = lane & 15;
                const float* ad = Ad + b * 256;
                float x[16];
    #pragma unroll
                for (int i = 0; i < 16; ++i) {
                    float a = (i == c) ? 1.f : 0.f;
    #pragma unroll
                    for (int j = 0; j < i; ++j) a -= ad[i * 16 + j] * x[j];
                    x[i] = a;
                }
    #pragma unroll
                for (int i = 0; i < 16; ++i) Tb[b * 256 + i * 16 + c] = x[i];
            } else {
                const float glast = gcs[63];
                for (int idx = tid - 64; idx < 4096; idx += 448) {
                    const int d = idx & 63, j = idx >> 6;
                    KTT[d * 72 + j] = f2bf(bf2f(Kb[j * 72 + d]) * fexp_(glast - gcs[j]));
                }
                if (tid == 64) __hip_atomic_store(&GCD[u], fexp_(glast), __ATOMIC_RELAXED, __HIP_MEMORY_SCOPE_AGENT);
            }
            lds_barrier();
            if (!(SKIP & 1)) {
                const int cidx = w * 16 + fr;
                bf16_t* xt = (cidx < 64) ? (UT + cidx * 72) : (WT + (cidx - 64) * 72);
                const bf16x8 zf = {0, 0, 0, 0, 0, 0, 0, 0};
    #pragma unroll
                for (int b = 0; b < 4; ++b) {
                    f32x4 G;
    #pragma unroll
                    for (int r = 0; r < 4; ++r) { const int i = b * 16 + fq * 4 + r; float v = beta[i] * XS[i * 128 + cidx]; if (cidx >= 64) v *= eg[i]; G[r] = v; }
    #pragma unroll
                    for (int ks = 0; ks < (b + 1) / 2; ++ks) {
                        const int k0 = ks * 32 + fq * 8;
                        const bool ok = k0 < b * 16;
                        const bf16x8 af = ok ? ld_frag(AmB + (b * 16 + fr) * 72 + k0) : zf;
                        const bf16x8 bfv = ok ? ld_frag(xt + k0) : zf;
                        G = mfma16(af, bfv, G);
                    }
                    f32x4 X = (f32x4){0.f, 0.f, 0.f, 0.f};
    #pragma unroll
                    for (int ks = 0; ks < 4; ++ks) X = __builtin_amdgcn_mfma_f32_16x16x4f32(Tb[b * 256 + fr * 16 + fq * 4 + ks], G[ks], X, 0, 0, 0);
                    u32x2 o; o.x = pk2(X[0], X[1]); o.y = pk2(X[2], X[3]);
                    *(u32x2*)(xt + b * 16 + fq * 4) = o;
                }
            }
            lds_barrier();
            if (!(SKIP & 4)) {
                bf16_t* ub = Hb + (size_t)gdn_slot(u) * 16384;
                const int prod = w >> 1, half = w & 1;
                const bf16_t* Xs = (prod == 0 || prod == 2) ? KTT : AT;
                const bf16_t* Ys = (prod == 0 || prod == 1) ? WT : UT;
                f32x4 acc[2][4];
    #pragma unroll
                for (int m = 0; m < 2; ++m)
    #pragma unroll
                    for (int n = 0; n < 4; ++n) acc[m][n] = (f32x4){0.f, 0.f, 0.f, 0.f};
    #pragma unroll
                for (int ks = 0; ks < 2; ++ks) {
                    bf16x8 fx[2], fy[4];
    #pragma unroll
                    for (int m = 0; m < 2; ++m) fx[m] = ld_frag(Xs + ((half * 2 + m) * 16 + fr) * 72 + ks * 32 + fq * 8);
    #pragma unroll
                    for (int n = 0; n < 4; ++n) fy[n] = ld_frag(Ys + (n * 16 + fr) * 72 + ks * 32 + fq * 8);
                    if (prod != 2) {
    #pragma unroll
                        for (int m = 0; m < 2; ++m)
    #pragma unroll
                            for (int n = 0; n < 4; ++n) acc[m][n] = mfma16(fy[n], fx[m], acc[m][n]);
                    } else {
    #pragma unroll
                        for (int m = 0; m < 2; ++m)
    #pragma unroll
                            for (int n = 0; n < 4; ++n) acc[m][n] = mfma16(fx[m], fy[n], acc[m][n]);
                    }
                }
    #pragma unroll
                for (int m = 0; m < 2; ++m) {
                    const int mt = half * 2 + m;
    #pragma unroll
                    for (int n = 0; n < 4; ++n) {
                        u32x2 o;
                        if (prod == 0) {
                            o.x = pk2(-acc[m][n][0], -acc[m][n][1]); o.y = pk2(-acc[m][n][2], -acc[m][n][3]);
                            *(u32x2*)(ub + (mt * 2 + (n >> 1)) * 512 + lane * 8 + (n & 1) * 4) = o;
                        } else if (prod == 1) {
                            const int ii = mt * 16 + fr; const float e = eg[ii];
                            const u32x2 qv = *(const u32x2*)(Qb + ii * 72 + n * 16 + fq * 4);
                            o.x = pk2(bflo(qv.x) * e - acc[m][n][0], bfhi(qv.x) * e - acc[m][n][1]); o.y = pk2(bflo(qv.y) * e - acc[m][n][2], bfhi(qv.y) * e - acc[m][n][3]);
                            *(u32x2*)(ub + 4096 + (mt * 2 + (n >> 1)) * 512 + lane * 8 + (n & 1) * 4) = o;
                        } else if (prod == 2) {
                            o.x = pk2(acc[m][n][0], acc[m][n][1]); o.y = pk2(acc[m][n][2], acc[m][n][3]);
                            *(u32x2*)(ub + 8192 + (n * 2 + (mt >> 1)) * 512 + lane * 8 + (mt & 1) * 4) = o;
                        } else {
                            o.x = pk2(acc[m][n][0], acc[m][n][1]); o.y = pk2(acc[m][n][2], acc[m][n][3]);
                            *(u32x2*)(ub + 12288 + (n * 2 + (mt >> 1)) * 512 + lane * 8 + (mt & 1) * 4) = o;
                        }
                    }
                }
            }
            lds_barrier();
        }
}

template <int MODE  >
__device__ __forceinline__ void ph_scan(const Params& p, const int l_in) {
    extern __shared__ __attribute__((aligned(16))) char smem[];
    int tid_ = threadIdx.x; asm volatile("" : "+v"(tid_));
    int blk_ = blockIdx.x; asm volatile("" : "+s"(blk_));
    unsigned long long w64_ = (unsigned long long)p.ws; asm volatile("" : "+s"(w64_));
    char* ws_ = (char*)(__attribute__((address_space(1))) char*)w64_;
    int l_ = l_in; asm volatile("" : "+v"(l_)); const int l = __builtin_amdgcn_readfirstlane(l_);
    const int tid = tid_, lane = tid & 63, w = tid >> 6;
    int grid_ = gridDim.x; asm volatile("" : "+s"(grid_));
    const int blk = blk_, grid = grid_;
    const int fr = lane & 15, fq = lane >> 4;
    char* const ws = ws_;
    const float* const modl = MOD + (size_t)l * 8 * 6144;
    (void)lane; (void)w; (void)fr; (void)fq; (void)modl; (void)smem; (void)blk; (void)grid;
        unsigned* const late_cnt = (unsigned*)(ws + OFF_CNT) + 1024 + l * 64;
        if (blk >= 128 && MODE == 0 && grid == 256) {
            ph_rwprep(p, l, 1, blk - 128, 128);
            asm volatile("s_waitcnt vmcnt(0)" ::: "memory");
            __syncthreads();
            if (tid == 0) {
                __builtin_amdgcn_fence(__ATOMIC_RELEASE, "agent");
                asm volatile("s_waitcnt vmcnt(0)" ::: "memory");
                __hip_atomic_fetch_add(late_cnt, 1u, __ATOMIC_RELAXED, __HIP_MEMORY_SCOPE_AGENT);
            }
        }
        if (blk >= 128 && !DBG_NO_GDN && MODE != 1 && MODE < 8) {
            if (MODE != 3 && MODE != 5) { ph_conv(p, l, blk - 128, grid - 128); ph_sgu(p, l, blk - 128, grid - 128); }
            if (MODE != 4) ph_gdn1(p, l, GDN_U1 + blk - 128, grid - 128, 4096);
            unsigned* sb = (unsigned*)(ws + OFF_CNT) + l * 64;
            asm volatile("s_waitcnt vmcnt(0)" ::: "memory");
            __syncthreads();
            if (tid == 0) {
                __builtin_amdgcn_fence(__ATOMIC_RELEASE, "agent");
                asm volatile("s_waitcnt vmcnt(0)" ::: "memory");
                __hip_atomic_fetch_add(sb, 1u, __ATOMIC_RELAXED, __HIP_MEMORY_SCOPE_AGENT);
                if (blk < 160) {
                    unsigned sp = 0;
                    while (__hip_atomic_load(sb, __ATOMIC_RELAXED, __HIP_MEMORY_SCOPE_AGENT) < (unsigned)(grid - 128)) { __builtin_amdgcn_s_sleep(2); if (++sp > (1u << 24)) break; }
                    __builtin_amdgcn_fence(__ATOMIC_ACQUIRE, "agent");
                    asm volatile("s_waitcnt vmcnt(0)" ::: "memory");
                }
            }
            __syncthreads();
        }
        for (int role = blk; role < 160; role += grid) {
            if (role < 128) {
                if (DBG_NO_RWKV || DBG_RWKV_NOSCAN || MODE >= 2) continue;
                const int bh = role >> 2, rg = role & 3, b = bh >> 2, hd = bh & 3;
                const size_t tb = (size_t)b * SEQ;
                constexpr int SST = 340;
                float* ybuf = (float*)smem;
                float* tilebuf = ybuf + 2 * 8192;
                static_assert(2 * 33 * SST * 4 + 2 * 8192 * 4 <= LDS_XB_OFF, "RWKV scan LDS image overlaps the grid barrier's LDS words");
                f32x2 sA = {0.f, 0.f}, sB = {0.f, 0.f}; float dcur = 0.f;
                const int kq = lane & 15, rsub = lane >> 4;
                int li = tid - 256;
                struct LT { float4 c0, c1; u32x4 kraw, zraw, mraw, rraw; unsigned vv; };
                auto fetch_tile = [&](int tt_, LT& x) {
                    const int tt = tt_ < 256 ? tt_ : 255;
                    const int s = li >> 3, part = li & 7;
                    const size_t tbase = (tb + (size_t)tt * 32) * 256;
                    const unsigned vo16 = (unsigned)((s * 256 + hd * 64 + part * 8) * 2), vo32 = vo16 * 2u, vov = (unsigned)((s * 256 + hd * 64 + rg * 16 + part * 2) * 2);
                    x.c0 = *(const float4*)((const char*)(RW_CE + tbase) + vo32); x.c1 = *(const float4*)((const char*)(RW_CE + tbase + 4) + vo32);
                    x.kraw = *(const u32x4*)((const char*)(RW_KK + tbase + 256) + vo16);
                    x.zraw = *(const u32x4*)((const char*)(RW_ZB + tbase) + vo16); x.mraw = *(const u32x4*)((const char*)(RW_KM + tbase) + vo16); x.rraw = *(const u32x4*)((const char*)(RW_R + tbase) + vo16);
                    x.vv = *(const unsigned*)((const char*)(RW_V + tbase) + vov);
                };
                auto commit_tile = [&](int tt, int buf, const LT& x) {
                    const int s = li >> 3, part = li & 7;
                    const int pos = tt * 32 + s;
                    float* dst = tilebuf + (size_t)buf * (33 * SST) + s * SST;
                    const float4 c0 = x.c0, c1 = x.c1;
                    u32x4 kraw = x.kraw;
                    if (!(pos + 1 < SEQ)) kraw = (u32x4){0u, 0u, 0u, 0u};
                    const u32x4 zraw = x.zraw, mraw = x.mraw, rraw = x.rraw;
                    const unsigned vv = x.vv;
                    const float ce[8] = {c0.x, c0.y, c0.z, c0.w, c1.x, c1.y, c1.z, c1.w};
                    float P[8], kn[8], f[8], o[8];
    #pragma unroll
                    for (int i = 0; i < 8; ++i) P[i] = ce[i];
                    unpack8(kraw, kn);
    #pragma unroll
                    for (int i = 0; i < 8; ++i) o[i] = P[i] * kn[i];
                    *(float4*)(dst + part * 8) = make_float4(o[0], o[1], o[2], o[3]); *(float4*)(dst + part * 8 + 4) = make_float4(o[4], o[5], o[6], o[7]);
                    unpack8(rraw, f);
    #pragma unroll
                    for (int i = 0; i < 8; ++i) o[i] = f[i] * P[i];
                    *(float4*)(dst + 192 + part * 8) = make_float4(o[0], o[1], o[2], o[3]); *(float4*)(dst + 192 + part * 8 + 4) = make_float4(o[4], o[5], o[6], o[7]);
                    if (s == 31) { float* pl = tilebuf + (size_t)buf * (33 * SST) + 32 * SST + part * 8;
                        *(float4*)pl = make_float4(P[0], P[1], P[2], P[3]); *(float4*)(pl + 4) = make_float4(P[4], P[5], P[6], P[7]); }
    #pragma unroll
                    for (int i = 0; i < 8; ++i) P[i] = rcpf_(ce[i]);
                    float al = 0.f, be = 0.f;
                    unpack8(zraw, f);
    #pragma unroll
                    for (int i = 0; i < 8; ++i) { al += f[i] * kn[i]; o[i] = f[i] * P[i]; }
                    *(float4*)(dst + 64 + part * 8) = make_float4(o[0], o[1], o[2], o[3]); *(float4*)(dst + 64 + part * 8 + 4) = make_float4(o[4], o[5], o[6], o[7]);
                    unpack8(mraw, f);
    #pragma unroll
                    for (int i = 0; i < 8; ++i) { be += f[i] * kn[i]; o[i] = f[i] * P[i]; }
                    *(float4*)(dst + 128 + part * 8) = make_float4(o[0], o[1], o[2], o[3]); *(float4*)(dst + 128 + part * 8 + 4) = make_float4(o[4], o[5], o[6], o[7]);
                    al += __shfl_xor(al, 1); al += __shfl_xor(al, 2); al += __shfl_xor(al, 4);
                    be += __shfl_xor(be, 1); be += __shfl_xor(be, 2); be += __shfl_xor(be, 4);
                    {
                        const float v0 = bflo(vv), v1 = bfhi(vv);
                        *(float4*)(dst + 256 + part * 8) = make_float4(v0, al, v0 * be * (1.0f / 32.0f), 0.f);
                        *(float4*)(dst + 256 + part * 8 + 4) = make_float4(v1, al, v1 * be * (1.0f / 32.0f), 0.f);
                    }
                };
                auto flush_y = [&](int tt, int buf) {
                    const int s = li >> 3, part = li & 7;
                    const float* yb = ybuf + buf * 8192 + s * 256 + part * 32;
                    float y2[2];
    #pragma unroll
                    for (int r = 0; r < 2; ++r) {
                        const float4 a = *(const float4*)(yb + r * 16), b4 = *(const float4*)(yb + r * 16 + 4), c4 = *(const float4*)(yb + r * 16 + 8), d4 = *(const float4*)(yb + r * 16 + 12);
                        y2[r] = ((a.x + a.y) + (a.z + a.w)) + ((b4.x + b4.y) + (b4.z + b4.w)) + ((c4.x + c4.y) + (c4.z + c4.w)) + ((d4.x + d4.y) + (d4.z + d4.w));
                    }
                    *(unsigned*)((char*)(YR + ((size_t)(bh * 4 + rg) * SEQ + (size_t)tt * 32) * 16) + (unsigned)((s * 16 + part * 2) * 2)) = pk2(y2[0], y2[1]);
                };
                LT R0;
                if (w >= 4) { fetch_tile(0, R0); commit_tile(0, 0, R0); fetch_tile(1, R0); }
                lds_barrier();
                if (w < 4) __builtin_amdgcn_s_setprio(3);
                for (int tt = 0; tt < 256; ++tt) {
                    const int buf = tt & 1;
                    if (w >= 4) {
                        asm volatile("" : "+v"(li));
                        if (MODE == 0 && grid == 256 && tt == 2 * RW_EARLY - 4) {
                            unsigned sp = 0;
                            while (__hip_atomic_load(late_cnt, __ATOMIC_RELAXED, __HIP_MEMORY_SCOPE_AGENT) < 128u) { __builtin_amdgcn_s_sleep(2); if (++sp > (1u << 24)) break; }
                            __builtin_amdgcn_fence(__ATOMIC_ACQUIRE, "agent");
                        }
                        if (tt + 1 < 256) commit_tile(tt + 1, buf ^ 1, R0);
                        fetch_tile(tt + 2, R0);
                        if (tt > 0) flush_y(tt - 1, buf ^ 1);
                    } else {
                        const int lr = w * 4 + rsub;
                        int o_vec = (2 * 8192 + buf * (33 * SST) + kq * 4) * 4, o_rec = (2 * 8192 + buf * (33 * SST) + 256 + lr * 4) * 4, o_y = (buf * 8192 + lr * 16 + kq) * 4;
                        asm volatile("" : "+v"(o_vec), "+v"(o_rec), "+v"(o_y));
                        const float* tv = (const float*)(smem + o_vec); const float* trc = (const float*)(smem + o_rec); float* yb = (float*)(smem + o_y);
                        float4 cu = *(const float4*)(tv), czb = *(const float4*)(tv + 64), ckm = *(const float4*)(tv + 128), cr = *(const float4*)(tv + 192);
                        typedef float f32x3_t __attribute__((ext_vector_type(3)));
                        f32x3_t crec = *(const f32x3_t*)(trc);
    #pragma unroll 8
                        for (int s = 0; s < 32; ++s) {
                            const int sn = ((s + 1) & 31) * SST;
                            const float4 nu = *(const float4*)(tv + sn), nzb = *(const float4*)(tv + sn + 64), nkm = *(const float4*)(tv + sn + 128), nr = *(const float4*)(tv + sn + 192);
                            const f32x3_t nrec = *(const f32x3_t*)(trc + sn);
                            __builtin_amdgcn_sched_barrier(0);
                            const f32x2 uA = {cu.x, cu.y}, uB = {cu.z, cu.w}, zA = {czb.x, czb.y}, zB = {czb.z, czb.w}, kA = {ckm.x, ckm.y}, kB = {ckm.z, ckm.w};
                            const f32x2 rA = {cr.x, cr.y}, rB = {cr.z, cr.w};
                            const f32x2 gg = {crec.z, crec.z};
                            const f32x2 ep = sA * uA + (sB * uB + gg);
                            const float e = rowsum16(ep.x + ep.y);
                            const f32x2 nd = {-dcur, -dcur}, vv = {crec.x, crec.x};
                            const f32x2 tA = kA * vv + sA, tB = kB * vv + sB;
                            sA = zA * nd + tA;
                            sB = zB * nd + tB;
                            const f32x2 yp = sA * rA + sB * rB;
                            yb[s * 256] = yp.x + yp.y;
                            dcur = e - dcur * crec.y;
                            cu = nu; czb = nzb; ckm = nkm; cr = nr; crec = nrec;
                            __builtin_amdgcn_sched_barrier(0);
                        }
                        {
                            const float4 pl = *(const float4*)(tv + 32 * SST);
                            const f32x2 pA = {pl.x, pl.y}, pB = {pl.z, pl.w};
                            sA = sA * pA; sB = sB * pB;
                        }
                    }
                    lds_barrier();
                }
                __builtin_amdgcn_s_setprio(0);
                if (w >= 4) flush_y(255, 1);
                lds_barrier();
            } else {
                if (DBG_NO_GDN || MODE == 1 || MODE == 4 || MODE == 5 || MODE == 6) continue;
                const int bh = role - 128, b = bh >> 2, hd = bh & 3;
                {
                    const int c0 = w * 16;
                    const unsigned vM = (unsigned)(fr * 2048 + c0 * 2 + fq * 8);
                    f32x4 S[4];
    #pragma unroll
                    for (int t = 0; t < 4; ++t) S[t] = (f32x4){0.f, 0.f, 0.f, 0.f};
                    const int lw = tid - 256;
                    struct LU { u32x4 d[8]; float cd; };
                    auto fetch = [&](int n, LU& x) {
                        const int u = b * 512 + hd * 128 + (n < 128 ? n : 127);
                        const char* ub = (const char*)Hb + (size_t)gdn_slot(u) * 32768;
    #pragma unroll
                        for (int i = 0; i < 8; ++i) x.d[i] = *(const u32x4*)((ub + i * 4096) + (unsigned)(lw * 16));
                        x.cd = GCD[u];
                    };
                    auto iter = [&](int it, LU& x) {
                        if (w >= 4) {
                            if (it < 128) {
                                char* Ls = smem + (it & 1) * 32768;
    #pragma unroll
                                for (int i = 0; i < 8; ++i) *(u32x4*)(Ls + i * 4096 + lw * 16) = x.d[i];
                                if (lw == 0) *(float*)(smem + 65536 + (it & 1) * 16) = x.cd;
                                fetch(it + 2, x);
                            }
                        } else if (it >= 1 && it <= 128) {
                            const int n = it - 1;
                            const char* Ls = smem + (n & 1) * 32768;
                            const float cd = *(const float*)(smem + 65536 + (n & 1) * 16);
                            u32x4 nq[2], oq[2];
    #pragma unroll
                            for (int pr = 0; pr < 2; ++pr) { nq[pr] = *(const u32x4*)(Ls + 16384 + (w * 2 + pr) * 1024 + lane * 16); oq[pr] = *(const u32x4*)(Ls + 24576 + (w * 2 + pr) * 1024 + lane * 16); }
                            bf16x8 bS[2];
    #pragma unroll
                            for (int ks = 0; ks < 2; ++ks) {
                                u32x4 t4; t4.x = pk2(S[2 * ks][0], S[2 * ks][1]); t4.y = pk2(S[2 * ks][2], S[2 * ks][3]); t4.z = pk2(S[2 * ks + 1][0], S[2 * ks + 1][1]); t4.w = pk2(S[2 * ks + 1][2], S[2 * ks + 1][3]);
                                bS[ks] = __builtin_bit_cast(bf16x8, t4);
                            }
                            const size_t t0 = (size_t)b * SEQ + (size_t)n * 64;
    #pragma unroll
                            for (int mt = 0; mt < 4; ++mt) {
                                const unsigned nlo = (mt & 1) ? nq[mt >> 1].z : nq[mt >> 1].x, nhi = (mt & 1) ? nq[mt >> 1].w : nq[mt >> 1].y;
                                f32x4 sn = (f32x4){cd * S[mt][0] + bflo(nlo), cd * S[mt][1] + bfhi(nlo), cd * S[mt][2] + bflo(nhi), cd * S[mt][3] + bfhi(nhi)};
                                const bf16x8 w0 = *(const bf16x8*)(Ls + (mt * 2 + 0) * 1024 + lane * 16), w1 = *(const bf16x8*)(Ls + (mt * 2 + 1) * 1024 + lane * 16);
                                sn = mfma16(w0, bS[0], sn); sn = mfma16(w1, bS[1], sn);
                                S[mt] = sn;
                            }
    #pragma unroll
                            for (int mt = 0; mt < 4; ++mt) {
                                const unsigned olo = (mt & 1) ? oq[mt >> 1].z : oq[mt >> 1].x, ohi = (mt & 1) ? oq[mt >> 1].w : oq[mt >> 1].y;
                                f32x4 oa = (f32x4){bflo(olo), bfhi(olo), bflo(ohi), bfhi(ohi)};
                                const bf16x8 p0 = *(const bf16x8*)(Ls + 8192 + (mt * 2 + 0) * 1024 + lane * 16), p1 = *(const bf16x8*)(Ls + 8192 + (mt * 2 + 1) * 1024 + lane * 16);
                                oa = mfma16(bS[0], p0, oa); oa = mfma16(bS[1], p1, oa);
                                u32x2 ov; ov.x = pk2(oa[0], oa[1]); ov.y = pk2(oa[2], oa[3]);
                                *(u32x2*)(((char*)MIX + (t0 + mt * 16) * 2048 + hd * 128) + vM) = ov;
                            }
                        }
                        lds_barrier();
                    };
                    LU R0, R1;
                    if (w >= 4) { fetch(0, R0); fetch(1, R1); }
    #pragma unroll 1
                    for (int it = 0; it < 130; it += 2) {
                        iter(it, R0);
                        iter(it + 1, R1);
                    }
                }
                lds_barrier();
            }
        }
        {
            int cw, ncw;
            if (grid > 160) { cw = blk - 160; ncw = grid - 160; } else { cw = blk; ncw = grid; }
            float* tile = (float*)smem;
            if (cw >= 0 && MODE != 1 && MODE != 5 && MODE != 7 && MODE < 8) {
                auto make_job = [&](int idx) {
                    const int which = idx >> 12, rem = idx & 4095, e = rem >> 6, r2 = rem & 63;
                    TrJob j;
                    if (which < 2) { const int kt = r2 >> 2, nt = r2 & 3;
                        j.src = INP(32) + ((size_t)l * 64 + e) * 1024 * 256; if (which == 1) j.src = INP(33) + ((size_t)l * 64 + e) * 1024 * 256;
                        j.ld = 256; j.k0 = kt * 64; j.n0 = nt * 64; j.Ndim = 256; j.dst = WGU + (size_t)e * 512 * 1024; j.dst_ld = 1024; j.mode = 1; j.up = which; }
                    else { const int kt = r2 >> 4, nt = r2 & 15;
                        j.src = INP(34) + ((size_t)l * 64 + e) * 256 * 1024; j.ld = 1024; j.k0 = kt * 64; j.n0 = nt * 64; j.Ndim = 1024; j.dst = WD + (size_t)e * 1024 * 256; j.dst_ld = 256; j.mode = 0; j.up = 0; }
                    return j;
                };
                for (int idx = cw; idx < 12288; idx += 2 * ncw) {
                    const bool haveB = idx + ncw < 12288;
                    const TrJob ja = make_job(idx), jb = make_job(haveB ? idx + ncw : idx);
                    tr_pair(tid, tile, tile + 64 * 65 + 16, ja, jb, haveB);
                }
            }
        }
}

__device__ __forceinline__ void ph_post(const Params& p, const int l_in) {
    extern __shared__ __attribute__((aligned(16))) char smem[];
    int tid_ = threadIdx.x; asm volatile("" : "+v"(tid_));
    int blk_ = blockIdx.x; asm volatile("" : "+s"(blk_));
    unsigned long long w64_ = (unsigned long long)p.ws; asm volatile("" : "+s"(w64_));
    char* ws_ = (char*)(__attribute__((address_space(1))) char*)w64_;
    int l_ = l_in; asm volatile("" : "+v"(l_)); const int l = __builtin_amdgcn_readfirstlane(l_);
    const int tid = tid_, lane = tid & 63, w = tid >> 6;
    int grid_ = gridDim.x; asm volatile("" : "+s"(grid_));
    const int blk = blk_, grid = grid_;
    const int fr = lane & 15, fq = lane >> 4;
    char* const ws = ws_;
    const float* const modl = MOD + (size_t)l * 8 * 6144;
    (void)lane; (void)w; (void)fr; (void)fq; (void)modl; (void)smem; (void)blk; (void)grid;
        const float* ng = INP(11) + l * 64;
        const float* gng = INP(26) + l * 256; const float* gnb = INP(27) + l * 256; const float* rk = INP(25) + l * 256;
        const int ch = lane * 4;
        const float4 ng4 = *(const float4*)(ng + (ch & 63));
        const float4 gg4 = *(const float4*)(gng + ch), gb4 = *(const float4*)(gnb + ch), rk4 = *(const float4*)(rk + ch);
        struct PostIn { u32x2 ov, zv, yv, rv, kv, vv, gv; };
        auto load_in = [&](size_t t) {
            PostIn q;
            q.ov = *(const u32x2*)(MIX + t * 1024 + ch);
            q.zv = *(const u32x2*)(Pb + t * PW + PC_Z + ch);
            q.yv = *(const u32x2*)(YR + ((size_t)(((t >> 13) * 4 + (lane >> 4)) * 4 + ((lane & 15) >> 2)) * SEQ + (t & (SEQ - 1))) * 16 + (lane & 3) * 4);
            q.rv = *(const u32x2*)(RW_R + t * 256 + ch);
            q.kv = *(const u32x2*)(RW_KM + t * 256 + ch);
            q.vv = *(const u32x2*)(RW_V + t * 256 + ch);
            q.gv = *(const u32x2*)(RW_G + t * 256 + ch);
            return q;
        };
        const size_t tstride = (size_t)grid * 8;
        size_t t = (size_t)blk * 8 + w;
        PostIn cur = load_in(t < T_TOK ? t : 0);
        for (; t < T_TOK; t += tstride) {
            const PostIn nxt = load_in(t + tstride < T_TOK ? t + tstride : t);
            {
                const u32x2 ov = cur.ov, zv = cur.zv;
                const float o[4] = {bflo(ov.x), bfhi(ov.x), bflo(ov.y), bfhi(ov.y)};
                const float z[4] = {bflo(zv.x), bfhi(zv.x), bflo(zv.y), bfhi(zv.y)};
                const float ms = rowsum16(o[0] * o[0] + o[1] * o[1] + o[2] * o[2] + o[3] * o[3]) * (1.0f / 64.0f);
                const float rs = rsqrtf(ms + 1e-6f);
                u32x2 r;
                r.x = pk2(o[0] * rs * ng4.x * siluf_(z[0]), o[1] * rs * ng4.y * siluf_(z[1]));
                r.y = pk2(o[2] * rs * ng4.z * siluf_(z[2]), o[3] * rs * ng4.w * siluf_(z[3]));
                *(u32x2*)(MIX + t * 1024 + ch) = r;
            }
            {
                const u32x2 yv = cur.yv, rv = cur.rv, kv = cur.kv, vv = cur.vv, gv = cur.gv;
                const float y[4] = {bflo(yv.x), bfhi(yv.x), bflo(yv.y), bfhi(yv.y)};
                const float mean = rowsum16(y[0] + y[1] + y[2] + y[3]) * (1.0f / 64.0f);
                const float d[4] = {y[0] - mean, y[1] - mean, y[2] - mean, y[3] - mean};
                const float var = rowsum16(d[0] * d[0] + d[1] * d[1] + d[2] * d[2] + d[3] * d[3]) * (1.0f / 64.0f);
                const float rs = rsqrtf(var + 64e-5f);
                const float bon = rowsum16(bflo(rv.x) * bflo(kv.x) * rk4.x + bfhi(rv.x) * bfhi(kv.x) * rk4.y + bflo(rv.y) * bflo(kv.y) * rk4.z + bfhi(rv.y) * bfhi(kv.y) * rk4.w);
                u32x2 r;
                r.x = pk2((d[0] * rs * gg4.x + gb4.x + bon * bflo(vv.x)) * bflo(gv.x), (d[1] * rs * gg4.y + gb4.y + bon * bfhi(vv.x)) * bfhi(gv.x));
                r.y = pk2((d[2] * rs * gg4.z + gb4.z + bon * bflo(vv.y)) * bflo(gv.y), (d[3] * rs * gg4.w + gb4.w + bon * bfhi(vv.y)) * bfhi(gv.y));
                *(u32x2*)(MIX + t * 1024 + 768 + ch) = r;
            }
            cur = nxt;
        }
}

template <int PROBE = 0>
__device__ __forceinline__ void ph_outproj(const Params& p, const int l_in) {
    extern __shared__ __attribute__((aligned(16))) char smem[];
    int tid_ = threadIdx.x; asm volatile("" : "+v"(tid_));
    int blk_ = blockIdx.x; asm volatile("" : "+s"(blk_));
    unsigned long long w64_ = (unsigned long long)p.ws; asm volatile("" : "+s"(w64_));
    char* ws_ = (char*)(__attribute__((address_space(1))) char*)w64_;
    int l_ = l_in; asm volatile("" : "+v"(l_)); const int l = __builtin_amdgcn_readfirstlane(l_);
    const int tid = tid_, lane = tid & 63, w = tid >> 6;
    int grid_ = gridDim.x; asm volatile("" : "+s"(grid_));
    const int blk = blk_, grid = grid_;
    const int fr = lane & 15, fq = lane >> 4;
    char* const ws = ws_;
    const float* const modl = MOD + (size_t)l * 8 * 6144;
    (void)lane; (void)w; (void)fr; (void)fq; (void)modl; (void)smem; (void)blk; (void)grid;
        g8::StaticOrder S; S.init(T_TOK, 1024, grid, blk);
        Ep8Outproj ep{(l == 0) ? x_in : (const float*)nullptr, XB, PROBE ? XB_LAST : XB_MID(l), modl};
        gemm8<Ep8Outproj, g8::StaticOrder, false>(tid, (LAS unsigned char*)smem, (const char*)MIX, (const char*)(WOUT + (size_t)l * 1024 * 1024), 1024, S, ep, 0u, 0u);
}

__device__ __forceinline__ void ph_norm2(const Params& p, const int l_in, const int own_tile  ) {
    extern __shared__ __attribute__((aligned(16))) char smem[];
    int tid_ = threadIdx.x; asm volatile("" : "+v"(tid_));
    int blk_ = blockIdx.x; asm volatile("" : "+s"(blk_));
    unsigned long long w64_ = (unsigned long long)p.ws; asm volatile("" : "+s"(w64_));
    char* ws_ = (char*)(__attribute__((address_space(1))) char*)w64_;
    int l_ = l_in; asm volatile("" : "+v"(l_)); const int l = __builtin_amdgcn_readfirstlane(l_);
    const int tid = tid_, lane = tid & 63, w = tid >> 6;
    int grid_ = gridDim.x; asm volatile("" : "+s"(grid_));
    const int blk = blk_, grid = grid_;
    const int fr = lane & 15, fq = lane >> 4;
    char* const ws = ws_;
    const float* const modl = MOD + (size_t)l * 8 * 6144;
    (void)lane; (void)w; (void)fr; (void)fq; (void)modl; (void)smem; (void)blk; (void)grid;
        const float* gn = INP(5) + l * 1024;
        const int gw = blk * 8 + w, nw = grid * 8;
        for (int r0 = (own_tile >= 0 ? own_tile * 256 + w * 32 : gw * 32); r0 < (own_tile >= 0 ? own_tile * 256 + w * 32 + 32 : T_TOK); r0 += nw * 32) {
            const int b = r0 >> 13;
            float gs[16], sh[16];
    #pragma unroll
            for (int j = 0; j < 4; ++j) {
                const int c = j * 256 + lane * 4;
                const float4 g4 = *(const float4*)(gn + c);
                const float4 sc4 = *(const float4*)(modl + b * 6144 + 4 * 1024 + c);
                const float4 sh4 = *(const float4*)(modl + b * 6144 + 3 * 1024 + c);
                gs[j * 4 + 0] = g4.x * (1.f + sc4.x); gs[j * 4 + 1] = g4.y * (1.f + sc4.y); gs[j * 4 + 2] = g4.z * (1.f + sc4.z); gs[j * 4 + 3] = g4.w * (1.f + sc4.w);
                sh[j * 4 + 0] = sh4.x; sh[j * 4 + 1] = sh4.y; sh[j * 4 + 2] = sh4.z; sh[j * 4 + 3] = sh4.w;
            }
            const bf16_t* xsrc = XB_MID(l);
            u32x2 cur[4][4], nxt[4][4];
    #pragma unroll
            for (int q = 0; q < 4; ++q)
    #pragma unroll
                for (int j = 0; j < 4; ++j) cur[q][j] = *(const u32x2*)(xsrc + (size_t)(r0 + q) * 1024 + j * 256 + lane * 4);
            for (int rg = r0; rg < r0 + 32; rg += 4) {
                const int rn = (rg + 4 < r0 + 32) ? rg + 4 : rg;
    #pragma unroll
                for (int q = 0; q < 4; ++q)
    #pragma unroll
                    for (int j = 0; j < 4; ++j) nxt[q][j] = *(const u32x2*)(xsrc + (size_t)(rn + q) * 1024 + j * 256 + lane * 4);
    #pragma unroll
                for (int q = 0; q < 4; ++q) {
                    const int r = rg + q;
                    float xv[16]; float ss = 0.f;
    #pragma unroll
                    for (int j = 0; j < 4; ++j) {
                        const u32x2 xb = cur[q][j];
                        const float4 v = make_float4(bflo(xb.x), bfhi(xb.x), bflo(xb.y), bfhi(xb.y));
                        xv[j * 4 + 0] = v.x; xv[j * 4 + 1] = v.y; xv[j * 4 + 2] = v.z; xv[j * 4 + 3] = v.w;
                        ss += v.x * v.x + v.y * v.y + v.z * v.z + v.w * v.w;
                    }
                    ss = wave_sum(ss);
                    const float rs = rsqrtf(ss * (1.0f / 1024.0f) + 1e-6f);
    #pragma unroll
                    for (int j = 0; j < 4; ++j) {
                        const int c = j * 256 + lane * 4;
                        u32x2 o;
                        o.x = pk2(xv[j * 4 + 0] * rs * gs[j * 4 + 0] + sh[j * 4 + 0], xv[j * 4 + 1] * rs * gs[j * 4 + 1] + sh[j * 4 + 1]);
                        o.y = pk2(xv[j * 4 + 2] * rs * gs[j * 4 + 2] + sh[j * 4 + 2], xv[j * 4 + 3] * rs * gs[j * 4 + 3] + sh[j * 4 + 3]);
                        *(u32x2*)(Hb + (size_t)r * 1024 + c) = o;
                    }
                }
    #pragma unroll
                for (int q = 0; q < 4; ++q)
    #pragma unroll
                    for (int j = 0; j < 4; ++j) cur[q][j] = nxt[q][j];
            }
        }
        for (int i = blk * 512 + tid; i < MAXROWS; i += grid * 512) ROWTOK[i] = -1;
}

__device__ __forceinline__ void ph_router(const Params& p, const int l_in, const int own_tile) {
    extern __shared__ __attribute__((aligned(16))) char smem[];
    int tid_ = threadIdx.x; asm volatile("" : "+v"(tid_));
    int blk_ = blockIdx.x; asm volatile("" : "+s"(blk_));
    unsigned long long w64_ = (unsigned long long)p.ws; asm volatile("" : "+s"(w64_));
    char* ws_ = (char*)(__attribute__((address_space(1))) char*)w64_;
    int l_ = l_in; asm volatile("" : "+v"(l_)); const int l = __builtin_amdgcn_readfirstlane(l_);
    const int tid = tid_, lane = tid & 63, w = tid >> 6;
    int grid_ = gridDim.x; asm volatile("" : "+s"(grid_));
    const int blk = blk_, grid = grid_;
    const int fr = lane & 15, fq = lane >> 4;
    char* const ws = ws_;
    const float* const modl = MOD + (size_t)l * 8 * 6144;
    (void)lane; (void)w; (void)fr; (void)fq; (void)modl; (void)smem; (void)blk; (void)grid;
        Ep8Logit ep{LOGIT};
        if (own_tile >= 0) { g8::OneUnit S{own_tile}; gemm8<Ep8Logit, g8::OneUnit, false>(tid, (LAS unsigned char*)smem, (const char*)Hb, (const char*)(ROUTW + (size_t)l * RT_ROWS * 1024), 1024, S, ep, 0u, 0u); }
        else { g8::StaticOrder S; S.init(T_TOK, RT_ROWS, grid, blk); gemm8<Ep8Logit, g8::StaticOrder, false>(tid, (LAS unsigned char*)smem, (const char*)Hb, (const char*)(ROUTW + (size_t)l * RT_ROWS * 1024), 1024, S, ep, 0u, 0u); }
}

__device__ __forceinline__ void ph_route1(const Params& p, const int l_in, const int own_tile) {
    extern __shared__ __attribute__((aligned(16))) char smem[];
    int tid_ = threadIdx.x; asm volatile("" : "+v"(tid_));
    int blk_ = blockIdx.x; asm volatile("" : "+s"(blk_));
    unsigned long long w64_ = (unsigned long long)p.ws; asm volatile("" : "+s"(w64_));
    char* ws_ = (char*)(__attribute__((address_space(1))) char*)w64_;
    int l_ = l_in; asm volatile("" : "+v"(l_)); const int l = __builtin_amdgcn_readfirstlane(l_);
    const int tid = tid_, lane = tid & 63, w = tid >> 6;
    int grid_ = gridDim.x; asm volatile("" : "+s"(grid_));
    const int blk = blk_, grid = grid_;
    const int fr = lane & 15, fq = lane >> 4;
    char* const ws = ws_;
    const float* const modl = MOD + (size_t)l * 8 * 6144;
    (void)lane; (void)w; (void)fr; (void)fq; (void)modl; (void)smem; (void)blk; (void)grid;
        const float* bg = INP(29) + l * 8; const float* br = INP(31) + l * 64;
        for (int c = (own_tile >= 0 ? own_tile : blk); c < (own_tile >= 0 ? own_tile + 1 : 256); c += grid) {
            int e0 = 0, e1 = 0; float g0 = 0.f, g1 = 0.f;
            const int t = c * 256 + tid;
            if (tid < 256) {
                const float* lg = LOGIT + (size_t)t * 80;
                float gl[8]; float mx = -3.0e38f; int gs = 0;
    #pragma unroll
                for (int i = 0; i < 8; ++i) { gl[i] = lg[i] + bg[i]; if (gl[i] > mx) { mx = gl[i]; gs = i; } }
                float den = 0.f;
    #pragma unroll
                for (int i = 0; i < 8; ++i) den += fexp_(gl[i] - mx);
                const float pg = 1.0f / den;
                float v1 = -3.0e38f, v2 = -3.0e38f; int i1 = 0, i2 = 0;
                for (int i = 0; i < 8; ++i) {
                    const float v = lg[8 + gs * 8 + i] + br[gs * 8 + i];
                    if (v > v1) { v2 = v1; i2 = i1; v1 = v; i1 = i; } else if (v > v2) { v2 = v; i2 = i; }
                }
                const float q1 = 1.0f / (1.0f + fexp_(v2 - v1));
                g0 = q1 * pg; g1 = (1.0f - q1) * pg;
                e0 = gs * 8 + i1; e1 = gs * 8 + i2;
            }
            unsigned r0 = 0, r1 = 0;
            unsigned* WC = (unsigned*)(smem + 2048);
            if (tid < 256) {
                const unsigned long long lower = (1ull << lane) - 1ull;
                for (int e = 0; e < 64; ++e) {
                    const unsigned long long m0 = __ballot(e0 == e), m1 = __ballot(e1 == e);
                    const unsigned below = (unsigned)__popcll(m0 & lower) + (unsigned)__popcll(m1 & lower);
                    if (e0 == e) r0 = below;
                    if (e1 == e) r1 = below;
                    if (lane == 0) WC[w * 64 + e] = (unsigned)__popcll(m0) + (unsigned)__popcll(m1);
                }
            }
            __syncthreads();
            if (tid < 256) {
                for (int ww = 0; ww < w; ++ww) { r0 += WC[ww * 64 + e0]; r1 += WC[ww * 64 + e1]; }
                TOKINF[t] = make_uint4((unsigned)e0 | ((unsigned)e1 << 8), __float_as_uint(g0), __float_as_uint(g1), r0 | (r1 << 16));
            }
            if (tid < 64) CBASE[c * 64 + tid] = WC[tid] + WC[64 + tid] + WC[128 + tid] + WC[192 + tid];
            __syncthreads();
        }
}

__device__ __forceinline__ void ph_route2(const Params& p, const int l_in) {
    extern __shared__ __attribute__((aligned(16))) char smem[];
    int tid_ = threadIdx.x; asm volatile("" : "+v"(tid_));
    int blk_ = blockIdx.x; asm volatile("" : "+s"(blk_));
    unsigned long long w64_ = (unsigned long long)p.ws; asm volatile("" : "+s"(w64_));
    char* ws_ = (char*)(__attribute__((address_space(1))) char*)w64_;
    int l_ = l_in; asm volatile("" : "+v"(l_)); const int l = __builtin_amdgcn_readfirstlane(l_);
    const int tid = tid_, lane = tid & 63, w = tid >> 6;
    int grid_ = gridDim.x; asm volatile("" : "+s"(grid_));
    const int blk = blk_, grid = grid_;
    const int fr = lane & 15, fq = lane >> 4;
    char* const ws = ws_;
    const float* const modl = MOD + (size_t)l * 8 * 6144;
    (void)lane; (void)w; (void)fr; (void)fq; (void)modl; (void)smem; (void)blk; (void)grid;
        unsigned* pst = (unsigned*)smem;
        unsigned* tot = pst + 80;
        unsigned* PRE = pst + 256;
        {
            unsigned* PS = pst + 256 + 256 * 64;
            const int e = tid & 63, part = tid >> 6;
            unsigned cv[32]; unsigned s = 0;
    #pragma unroll
            for (int i = 0; i < 32; ++i) { cv[i] = CBASE[(part * 32 + i) * 64 + e]; }
    #pragma unroll
            for (int i = 0; i < 32; ++i) s += cv[i];
            PS[part * 64 + e] = s;
            __syncthreads();
            if (tid < 64) { unsigned a = 0; for (int q = 0; q < 8; ++q) a += PS[q * 64 + tid]; tot[tid] = a; }
            for (int c = blk; c < 256; c += grid) {
                const int cp = c >> 5, ci = c & 31;
                if (part == cp) {
                    unsigned a = 0;
                    for (int q = 0; q < cp; ++q) a += PS[q * 64 + e];
    #pragma unroll
                    for (int i = 0; i < 32; ++i) a += (i < ci) ? cv[i] : 0u;
                    PRE[c * 64 + e] = a;
                }
            }
        }
        __syncthreads();
        if (tid == 0) {
            unsigned run = 0;
            for (int e = 0; e < 64; ++e) { pst[e] = run; run += (tot[e] + 255u) & ~255u; }
            pst[64] = run;
        }
        __syncthreads();
        if (blk == 0) {
            if (tid < 64) { for (unsigned tl = pst[tid] >> 8; tl < (pst[tid + 1] >> 8); ++tl) TILEE[tl] = tid; }
            if (tid == 0) TILEE[1023] = (int)(pst[64] >> 8);
        }
        for (int c = blk; c < 256; c += grid) {
            if (tid < 256) {
                const int t = c * 256 + tid;
                const uint4 ti = TOKINF[t];
                const int e0 = ti.x & 255, e1 = (ti.x >> 8) & 255;
                const unsigned r0 = pst[e0] + PRE[c * 64 + e0] + (ti.w & 0xffffu);
                const unsigned r1 = pst[e1] + PRE[c * 64 + e1] + (ti.w >> 16);
                ROWTOK[r0] = t * 2; ROWG[r0] = __uint_as_float(ti.y);
                ROWTOK[r1] = t * 2 + 1; ROWG[r1] = __uint_as_float(ti.z);
            }
        }
        __syncthreads();
}

__device__ __forceinline__ void ph_moe1(const Params& p, const int l_in) {
    extern __shared__ __attribute__((aligned(16))) char smem[];
    int tid_ = threadIdx.x; asm volatile("" : "+v"(tid_));
    int blk_ = blockIdx.x; asm volatile("" : "+s"(blk_));
    unsigned long long w64_ = (unsigned long long)p.ws; asm volatile("" : "+s"(w64_));
    char* ws_ = (char*)(__attribute__((address_space(1))) char*)w64_;
    int l_ = l_in; asm volatile("" : "+v"(l_)); const int l = __builtin_amdgcn_readfirstlane(l_);
    const int tid = tid_, lane = tid & 63, w = tid >> 6;
    int grid_ = gridDim.x; asm volatile("" : "+s"(grid_));
    const int blk = blk_, grid = grid_;
    const int fr = lane & 15, fq = lane >> 4;
    char* const ws = ws_;
    const float* const modl = MOD + (size_t)l * 8 * 6144;
    (void)lane; (void)w; (void)fr; (void)fq; (void)modl; (void)smem; (void)blk; (void)grid;
        g8::MoeOrder<2> S; S.ntiles = TILEE[1023]; S.x = blk & 7; S.j = blk >> 3; S.nj = (grid - S.x + 7) >> 3; S.tile_e = TILEE; S.rowtok = ROWTOK; S.prime(lane);
        Ep8Moe1 ep{HID};
        gemm8<Ep8Moe1, g8::MoeOrder<2>, true>(tid, (LAS unsigned char*)smem, (const char*)ws, (const char*)WGU, 1024, S, ep, (unsigned)OFF_H, (unsigned)(OFF_WIN + (size_t)PWV * 1024 * 2));
}

template <int LINEAR = 0>
__device__ __forceinline__ void ph_moe2(const Params& p, const int l_in) {
    extern __shared__ __attribute__((aligned(16))) char smem[];
    int tid_ = threadIdx.x; asm volatile("" : "+v"(tid_));
    int blk_ = blockIdx.x; asm volatile("" : "+s"(blk_));
    unsigned long long w64_ = (unsigned long long)p.ws; asm volatile("" : "+s"(w64_));
    char* ws_ = (char*)(__attribute__((address_space(1))) char*)w64_;
    int l_ = l_in; asm volatile("" : "+v"(l_)); const int l = __builtin_amdgcn_readfirstlane(l_);
    const int tid = tid_, lane = tid & 63, w = tid >> 6;
    int grid_ = gridDim.x; asm volatile("" : "+s"(grid_));
    const int blk = blk_, grid = grid_;
    const int fr = lane & 15, fq = lane >> 4;
    char* const ws = ws_;
    const float* const modl = MOD + (size_t)l * 8 * 6144;
    (void)lane; (void)w; (void)fr; (void)fq; (void)modl; (void)smem; (void)blk; (void)grid;
        g8::MoeOrder<4> S; S.ntiles = TILEE[1023]; S.x = blk & 7; S.j = blk >> 3; S.nj = (grid - S.x + 7) >> 3; S.tile_e = TILEE; S.rowtok = ROWTOK; S.prime(lane);
        Ep8Moe2<LINEAR> ep{YB, ROWTOK, ROWG};
        gemm8<Ep8Moe2<LINEAR>, g8::MoeOrder<4>, false>(tid, (LAS unsigned char*)smem, (const char*)HID, (const char*)WD, 256, S, ep, 0u, 0u);
}

__device__ __forceinline__ void ph_prologue(const Params& p, const int l_in) {
    extern __shared__ __attribute__((aligned(16))) char smem[];
    int tid_ = threadIdx.x; asm volatile("" : "+v"(tid_));
    int blk_ = blockIdx.x; asm volatile("" : "+s"(blk_));
    unsigned long long w64_ = (unsigned long long)p.ws;
    char* ws_ = (char*)(__attribute__((address_space(1))) char*)w64_;
    int l_ = l_in; asm volatile("" : "+v"(l_)); const int l = __builtin_amdgcn_readfirstlane(l_);
    const int tid = tid_, lane = tid & 63, w = tid >> 6;
    int grid_ = gridDim.x; asm volatile("" : "+s"(grid_));
    const int blk = blk_, grid = grid_;
    const int fr = lane & 15, fq = lane >> 4;
    char* const ws = ws_;
    const float* const modl = MOD + (size_t)l * 8 * 6144;
    (void)lane; (void)w; (void)fr; (void)fq; (void)modl; (void)smem; (void)blk; (void)grid;
        {
            float* cact = (float*)smem;
            float* red = (float*)(smem + 32768);
            for (int i = tid; i < 8192; i += 512) { const float c = INP(1)[i]; cact[i] = siluf_(c); }
            __syncthreads();
            const int ol = tid & 63, ks = tid >> 6;
            for (int g = blk; g < 384; g += grid) {
                const int gid = g * 64 + ol; const int l = gid / 6144, n = gid % 6144;
                const float* wp = INP(2) + (size_t)l * 1024 * 6144 + (size_t)(ks * 128) * 6144 + n;
                float acc[8];
    #pragma unroll
                for (int b = 0; b < 8; ++b) acc[b] = 0.f;
    #pragma unroll 8
                for (int k = 0; k < 128; ++k) {
                    const float wv = wp[(size_t)k * 6144];
    #pragma unroll
                    for (int b = 0; b < 8; ++b) acc[b] += cact[b * 1024 + ks * 128 + k] * wv;
                }
    #pragma unroll
                for (int b = 0; b < 8; ++b) red[(ks * 8 + b) * 64 + ol] = acc[b];
                __syncthreads();
                {
                    const int b = tid >> 6;
                    float s = 0.f;
    #pragma unroll
                    for (int q = 0; q < 8; ++q) s += red[(q * 8 + b) * 64 + ol];
                    MOD[(size_t)(l * 8 + b) * 6144 + n] = s + INP(3)[l * 6144 + n];
                }
                __syncthreads();
            }
        }
        float* tile = (float*)smem;
        for (int jb = blk; jb < 4608; jb += grid) {
            int j = jb;
            if (j < 3392) { const int l = j / 848, r = j % 848, kt = r / 53, nt = r % 53;
                tr_tile(tid, tile, INP(6) + (size_t)l * 1024 * 3336, 3336, kt * 64, nt * 64, 3336, WIN + (size_t)l * WIN_ROWS * 1024, 1024, RmWin()); continue; }
            j -= 3392;
            if (j < 1024) { const int l = j >> 8, r = j & 255, kt = r >> 4, nt = r & 15;
                tr_tile(tid, tile, INP(7) + (size_t)l * 1024 * 1024, 1024, kt * 64, nt * 64, 1024, WOUT + (size_t)l * 1024 * 1024, 1024, RmId()); continue; }
            j -= 1024;
            if (j < 16) { const int l = j >> 2, nt = j & 3;
                tr_tile(tid, tile, INP(19) + (size_t)l * 64 * 256, 256, 0, nt * 64, 256, LWU + (size_t)l * 256 * 64, 64, RmId()); continue; }
            j -= 16;
            if (j < 16) { const int l = j >> 2, nt = j & 3;
                tr_tile(tid, tile, INP(21) + (size_t)l * 64 * 256, 256, 0, nt * 64, 256, LAU + (size_t)l * 256 * 64, 64, RmId()); continue; }
            j -= 16;
            if (j < 32) { const int l = j >> 3, r = j & 7, kt = r >> 2, nt = r & 3;
                tr_tile(tid, tile, INP(22) + (size_t)l * 128 * 256, 256, kt * 64, nt * 64, 256, LGU + (size_t)l * 256 * 128, 128, RmId()); continue; }
            j -= 32;
            if (j < 64) { const int l = j >> 4, kt = j & 15;
                tr_tile(tid, tile, INP(30) + (size_t)l * 1024 * 64, 64, kt * 64, 0, 64, ROUTW + (size_t)l * RT_ROWS * 1024, 1024, RmOff{8}); continue; }
            j -= 64;
            { const int l = j >> 4, kt = j & 15;
                tr_tile(tid, tile, INP(28) + (size_t)l * 1024 * 8, 8, kt * 64, 0, 8, ROUTW + (size_t)l * RT_ROWS * 1024, 1024, RmId()); }
        }
        const int gt = blk * 512 + tid, ngt = grid * 512;
        for (int i = gt; i < 4 * (WIN_ROWS - PWV) * 128; i += ngt) { const int l = i / ((WIN_ROWS - PWV) * 128), r = i % ((WIN_ROWS - PWV) * 128); *(u32x4*)(WIN + ((size_t)l * WIN_ROWS + PWV) * 1024 + (size_t)r * 8) = (u32x4){0u, 0u, 0u, 0u}; }
        for (int i = gt; i < 4 * (RT_ROWS - 72) * 128; i += ngt) { const int l = i / ((RT_ROWS - 72) * 128), r = i % ((RT_ROWS - 72) * 128); *(u32x4*)(ROUTW + ((size_t)l * RT_ROWS + 72) * 1024 + (size_t)r * 8) = (u32x4){0u, 0u, 0u, 0u}; }
        for (int i = gt; i < 4 * 4 * 128 * 128; i += ngt) { const int s = i & 127, t = (i >> 7) & 127; SGUW[i] = (s <= t) ? f2bf(INP(14)[i]) : (bf16_t)0; }
        for (int i = gt; i < 4 * 8 * 1024; i += ngt) { const int l = i >> 13, j = (i >> 10) & 7, k = i & 1023; GW[i] = INP(6)[((size_t)l * 1024 + k) * 3336 + 1024 + j]; }
}

__device__ __forceinline__ void ph_final(const Params& p, const int l_in) {
    extern __shared__ __attribute__((aligned(16))) char smem[];
    int tid_ = threadIdx.x; asm volatile("" : "+v"(tid_));
    int blk_ = blockIdx.x; asm volatile("" : "+s"(blk_));
    unsigned long long w64_ = (unsigned long long)p.ws; asm volatile("" : "+s"(w64_));
    char* ws_ = (char*)(__attribute__((address_space(1))) char*)w64_;
    int l_ = l_in; asm volatile("" : "+v"(l_)); const int l = __builtin_amdgcn_readfirstlane(l_);
    const int tid = tid_, lane = tid & 63, w = tid >> 6;
    int grid_ = gridDim.x; asm volatile("" : "+s"(grid_));
    const int blk = blk_, grid = grid_;
    const int fr = lane & 15, fq = lane >> 4;
    char* const ws = ws_;
    const float* const modl = MOD + (size_t)l * 8 * 6144;
    (void)lane; (void)w; (void)fr; (void)fq; (void)modl; (void)smem; (void)blk; (void)grid;
        const float* gn = INP(35);
        const float* modp = MOD + (size_t)(NLAYER - 1) * 8 * 6144;
        const int gw = blk * 8 + w, nw = grid * 8;
        for (int r0 = gw * 32; r0 < T_TOK; r0 += nw * 32) {
            const int b = r0 >> 13;
            float gs[16], gf[16];
    #pragma unroll
            for (int j = 0; j < 4; ++j) {
                const int c = j * 256 + lane * 4;
                const float4 g4 = *(const float4*)(gn + c);
                const float4 f4 = *(const float4*)(modp + b * 6144 + 5 * 1024 + c);
                gs[j * 4 + 0] = g4.x; gs[j * 4 + 1] = g4.y; gs[j * 4 + 2] = g4.z; gs[j * 4 + 3] = g4.w;
                gf[j * 4 + 0] = f4.x; gf[j * 4 + 1] = f4.y; gf[j * 4 + 2] = f4.z; gf[j * 4 + 3] = f4.w;
            }
            u32x2 cxb[4], cy0[4], cy1[4];
    #pragma unroll
            for (int j = 0; j < 4; ++j) { const size_t o_ = (size_t)r0 * 1024 + j * 256 + lane * 4; cxb[j] = *(const u32x2*)(XB_LAST + o_); cy0[j] = *(const u32x2*)(YB + o_); cy1[j] = *(const u32x2*)(YB + (size_t)T_TOK * 1024 + o_); }
            for (int r = r0; r < r0 + 32; ++r) {
                float xv[16]; float ss = 0.f;
                u32x2 nxb[4], ny0[4], ny1[4];
                {
                    const int rn = (r + 1 < r0 + 32) ? r + 1 : r;
    #pragma unroll
                    for (int j = 0; j < 4; ++j) { const size_t o_ = (size_t)rn * 1024 + j * 256 + lane * 4; nxb[j] = *(const u32x2*)(XB_LAST + o_); ny0[j] = *(const u32x2*)(YB + o_); ny1[j] = *(const u32x2*)(YB + (size_t)T_TOK * 1024 + o_); }
                }
    #pragma unroll
                for (int j = 0; j < 4; ++j) {
                    const int c = j * 256 + lane * 4;
                    const u32x2 xb = cxb[j];
                    float4 v = make_float4(bflo(xb.x), bfhi(xb.x), bflo(xb.y), bfhi(xb.y));
#if !DBG_NO_MOE
                    const u32x2 y0 = cy0[j];
                    const u32x2 y1 = cy1[j];
                    v.x += gf[j * 4 + 0] * (bflo(y0.x) + bflo(y1.x)); v.y += gf[j * 4 + 1] * (bfhi(y0.x) + bfhi(y1.x));
                    v.z += gf[j * 4 + 2] * (bflo(y0.y) + bflo(y1.y)); v.w += gf[j * 4 + 3] * (bfhi(y0.y) + bfhi(y1.y));
#endif
                    xv[j * 4 + 0] = v.x; xv[j * 4 + 1] = v.y; xv[j * 4 + 2] = v.z; xv[j * 4 + 3] = v.w;
                    ss += v.x * v.x + v.y * v.y + v.z * v.z + v.w * v.w;
                }
                ss = wave_sum(ss);
                const float rs = rsqrtf(ss * (1.0f / 1024.0f) + 1e-6f);
    #pragma unroll
                for (int j = 0; j < 4; ++j) {
                    const int c = j * 256 + lane * 4;
                    float* dstp = xo + (size_t)r * 1024 + c;
                    *(float4*)dstp = make_float4(xv[j * 4 + 0] * rs * gs[j * 4 + 0], xv[j * 4 + 1] * rs * gs[j * 4 + 1], xv[j * 4 + 2] * rs * gs[j * 4 + 2], xv[j * 4 + 3] * rs * gs[j * 4 + 3]);
                }
    #pragma unroll
                for (int j = 0; j < 4; ++j) { cxb[j] = nxb[j]; cy0[j] = ny0[j]; cy1[j] = ny1[j]; }
            }
        }
}

#ifdef TEST_PHASE
#define TK(name) __global__ void __launch_bounds__(512, 2) tk_##name(Params p, int l) { ph_##name(p, l); }
TK(prologue) TK(norm1) TK(inproj) TK(post) TK(outproj) TK(route2) TK(moe1) TK(final)
#endif

__global__ void __launch_bounds__(512, 2) mega(Params p) {
    extern __shared__ __attribute__((aligned(16))) char smem_all[];
    if (threadIdx.x == 0) *(uint4*)(smem_all + LDS_XB_OFF) = make_uint4(0u, 0u, 0u, 0u);
    __syncthreads();
    XcdBarrier bar = xcd_barrier_post((unsigned*)(p.ws + OFF_BAR), (volatile LAS unsigned*)(smem_all + LDS_XB_OFF));
    ph_prologue(p, 0);
    xcd_barrier(bar);
    if (TIME_DUP == 11) { ph_prologue(p, 0); xcd_barrier(bar); ph_prologue(p, 0); xcd_barrier(bar); ph_prologue(p, 0); xcd_barrier(bar); ph_prologue(p, 0); xcd_barrier(bar); }
    for (int l = 0; l < NLAYER; ++l) {
        ph_norm1(p, l);   xcd_barrier(bar);
        ph_inproj(p, l);  xcd_barrier(bar);
        if (TIME_DUP == 1) { ph_inproj(p, l);  xcd_barrier(bar); }
        if (TIME_DUP == 32) { ph_inproj<1>(p, l);  xcd_barrier(bar); }
        if (TIME_DUP == 30) { xcd_barrier(bar); xcd_barrier(bar); xcd_barrier(bar); xcd_barrier(bar); }
#if !DBG_NO_RWKV
        ph_rwprep(p, l, gridDim.x == 256 ? 0 : 2);
#endif
        if (TIME_DUP == 7) ph_gdn1(p, l, blockIdx.x, gridDim.x, 4096);
        if (GDN_U1 > 0 && !DBG_NO_GDN) ph_gdn1(p, l, blockIdx.x, gridDim.x, GDN_U1);
        xcd_barrier(bar);
        if (TIME_DUP == 8) { ph_rwprep(p, l); xcd_barrier(bar); }
        if (TIME_DUP == 19) { ph_rwprep<1>(p, l); xcd_barrier(bar); }
        ph_scan<0>(p, l);    xcd_barrier(bar);
        if (TIME_DUP == 3) { ph_scan<0>(p, l);    xcd_barrier(bar); }
        if (TIME_DUP == 9) { ph_scan<1>(p, l);    xcd_barrier(bar); }
        if (TIME_DUP == 10) { ph_scan<2>(p, l);    xcd_barrier(bar); }
        if (TIME_DUP == 20) { ph_scan<3>(p, l);    xcd_barrier(bar); }
        if (TIME_DUP == 21) { ph_scan<4>(p, l);    xcd_barrier(bar); }
        if (TIME_DUP == 22) { ph_scan<5>(p, l);    xcd_barrier(bar); }
        if (TIME_DUP == 23) { ph_scan<6>(p, l);    xcd_barrier(bar); }
        if (TIME_DUP == 24) { ph_scan<7>(p, l);    xcd_barrier(bar); }
        if (TIME_DUP == 25) { ph_scan<8>(p, l);    xcd_barrier(bar); }
        if (TIME_DUP == 26) { ph_scan<9>(p, l);    xcd_barrier(bar); }
        if (TIME_DUP == 27) { ph_scan<10>(p, l);    xcd_barrier(bar); }
        ph_post(p, l);    xcd_barrier(bar);
        ph_outproj(p, l); xcd_barrier(bar);
        if (TIME_DUP == 31) { ph_outproj<1>(p, l); xcd_barrier(bar); }
#if !DBG_NO_MOE
        if (gridDim.x == 256) {
            const int own = ((int)blockIdx.x & 7) * 32 + ((int)blockIdx.x >> 3);
            ph_norm2(p, l, own);
            asm volatile("s_waitcnt vmcnt(0)" ::: "memory"); __syncthreads();
            ph_router(p, l, own);
            asm volatile("s_waitcnt vmcnt(0)" ::: "memory"); __syncthreads();
            ph_route1(p, l, own);  xcd_barrier(bar);
        } else {
            ph_norm2(p, l, -1);   xcd_barrier(bar);
            ph_router(p, l, -1);  xcd_barrier(bar);
            ph_route1(p, l, -1);  xcd_barrier(bar);
        }
        if (TIME_DUP == 6) { ph_norm2(p, l, -1);   xcd_barrier(bar); }
        ph_route2(p, l);  xcd_barrier(bar);
        if (TIME_DUP == 5) { ph_router(p, l, -1);  xcd_barrier(bar); ph_route1(p, l, -1);  xcd_barrier(bar); ph_route2(p, l);  xcd_barrier(bar); }
        ph_moe1(p, l);    xcd_barrier(bar);
        if (TIME_DUP == 17) { ph_moe2<1>(p, l);    xcd_barrier(bar); }
        ph_moe2(p, l);    xcd_barrier(bar);
        if (TIME_DUP == 4) { ph_moe1(p, l);    xcd_barrier(bar); ph_moe2(p, l);    xcd_barrier(bar); }
        if (TIME_DUP == 15) { ph_moe1(p, l);    xcd_barrier(bar); }
        if (TIME_DUP == 16) { ph_moe2(p, l);    xcd_barrier(bar); }
#endif
    }
    ph_final(p, 0);
}


extern "C" void kernel_launch(void* const* d_in, const int* in_sizes, int n_in,
                              void* d_out, int out_size, void* d_ws, size_t ws_size,
                              hipStream_t stream) {
    static int grid = 0;
    if (!grid) {
        int dev = 0, cus = 0, per_cu = 0;
        hipGetDevice(&dev);
        hipDeviceGetAttribute(&cus, hipDeviceAttributeMultiprocessorCount, dev);
        hipFuncSetAttribute((const void*)mega, hipFuncAttributeMaxDynamicSharedMemorySize, LDS_BYTES);
        hipOccupancyMaxActiveBlocksPerMultiprocessor(&per_cu, mega, 512, LDS_BYTES);
        grid = (per_cu >= 1 && cus >= 192) ? cus : 0;
    }
    if (grid <= 0 || n_in < 36 || ws_size < WS_NEED) { fprintf(stderr, "kernel_launch: cannot launch (grid %d, ws %zu need %zu)\n", grid, ws_size, (size_t)WS_NEED); return; }
    hipMemsetAsync(d_ws, 0, ZERO_BYTES, stream);
    Params p{};
    for (int i = 0; i < 36; ++i) p.in[i] = (const float*)d_in[i];
    p.out = (float*)d_out;
    p.ws = (char*)d_ws;
    hipLaunchKernelGGL(mega, dim3(grid), dim3(512), LDS_BYTES, stream, p);
}
```

```cpp
#include <hip/hip_runtime.h>
#include <stdint.h>
#include <stdio.h>

typedef unsigned short bf16_t;
typedef short bf16x8 __attribute__((ext_vector_type(8)));
typedef float f32x4 __attribute__((ext_vector_type(4)));
typedef unsigned u32x4 __attribute__((ext_vector_type(4)));
typedef unsigned u32x2 __attribute__((ext_vector_type(2)));

#define T_TOK 65536
#define SEQ 8192
#define DM 1024
#define NLAYER 4
#define RW_EARLY 64
#define PW 3392
#define PWV 3336
#define PC_Q 0
#define PC_K 256
#define PC_V 512
#define PC_Z 768
#define PC_SU 1024
#define PC_SV 1280
#define PC_CB 1536
#define PC_CC 1792
#define PC_CH 2048
#define PC_RW 2304
#define PC_GA 3328
#define PC_GB 3332
#define WIN_ROWS 3584
#define RT_ROWS 256
#define MAXROWS 147456
#define MAXTILES 576

constexpr size_t OFF_BAR   = 0;
constexpr size_t OFF_CNT   = 16384;
constexpr size_t ZERO_BYTES = 32768;
constexpr size_t OFF_MOD   = 32768;
constexpr size_t OFF_WIN   = OFF_MOD + 786432;
constexpr size_t OFF_WOUT  = OFF_WIN + (size_t)4 * WIN_ROWS * 1024 * 2;
constexpr size_t OFF_SGUW  = OFF_WOUT + (size_t)4 * 1024 * 1024 * 2;
constexpr size_t OFF_LWU   = OFF_SGUW + 524288;
constexpr size_t OFF_LAU   = OFF_LWU + 131072;
constexpr size_t OFF_LGU   = OFF_LAU + 131072;
constexpr size_t OFF_ROUTW = OFF_LGU + 262144;
constexpr size_t OFF_GCD   = OFF_ROUTW + (size_t)4 * RT_ROWS * 1024 * 2;
constexpr size_t OFF_WGU   = OFF_GCD + 16384;
constexpr size_t OFF_WD    = OFF_WGU + (size_t)64 * 512 * 1024 * 2;
constexpr size_t OFF_H     = OFF_WD + (size_t)64 * 1024 * 256 * 2;
constexpr size_t OFF_P     = OFF_H + (size_t)T_TOK * 1024 * 2;
constexpr size_t OFF_MIX   = OFF_P + (size_t)T_TOK * PW * 2;
constexpr size_t OFF_RW    = OFF_MIX + (size_t)T_TOK * 1024 * 2;
constexpr size_t RW_ARR    = (size_t)T_TOK * 256 * 2;
constexpr size_t OFF_YR    = OFF_RW + 7 * RW_ARR;
constexpr size_t OFF_CE    = OFF_YR + RW_ARR;
constexpr size_t OFF_GAB   = OFF_CE + 2 * RW_ARR;
constexpr size_t OFF_GW    = OFF_GAB + (size_t)T_TOK * 8 * 4;
constexpr size_t WS_NEED   = OFF_GW + 4 * 8 * 1024 * 4;
constexpr size_t PO_LOGIT  = 0;
constexpr size_t PO_TOKINF = 20971520;
constexpr size_t PO_CBASE  = PO_TOKINF + 1048576;
constexpr size_t PO_ROWTOK = PO_CBASE + 65536;
constexpr size_t PO_ROWG   = PO_ROWTOK + 589824;
constexpr size_t PO_TILEE  = PO_ROWG + 589824;
constexpr size_t PO_HID    = 33554432;
constexpr size_t PO_Y      = PO_HID + (size_t)MAXROWS * 256 * 2 + 1048576;
static_assert(PO_TILEE + 4096 <= PO_HID, "moe tmp overlap");
static_assert(PO_Y + (size_t)2 * T_TOK * 1024 * 2 <= (size_t)T_TOK * PW * 2, "moe tmp too large");

#define LDS_BYTES 163840
#define LDS_XB_OFF (163840 - 256)
#define GDN_U1 0
#define TIME_DUP 0
#define DBG_NO_MOE 0
#define DBG_NO_RWKV 0
#define DBG_RWKV_Y0 0
#define DBG_RWKV_NOSCAN 0
#define DBG_RWKV_OUT 0
#define DBG_NO_GDN 0

struct Params {
    const float* in[36];
    float* out;
    char* ws;
};

#define XB_TMO      128
#define XB_XCNT(j)  (256  + 64 * (j))
#define XB_XSUB(j)  (1280 + 64 * (j))
#define XB_XGEN(j)  (2304 + 64 * (j))
#define XB_TOP      3328
#define XB_TOPGEN   3392
#define XCD_BAR_WORDS 3456
#define XB_SPIN_CAP (1u << 22)
#define LAS __attribute__((address_space(3)))

__device__ __forceinline__ unsigned xb_ld(unsigned* p)              { return __hip_atomic_load(p, __ATOMIC_RELAXED, __HIP_MEMORY_SCOPE_AGENT); }
__device__ __forceinline__ unsigned xb_add(unsigned* p, unsigned v) { return __hip_atomic_fetch_add(p, v, __ATOMIC_RELAXED, __HIP_MEMORY_SCOPE_AGENT); }
__device__ __forceinline__ unsigned xb_xcc_id() { return (unsigned)__builtin_amdgcn_s_getreg((3 << 11) | 20) & 0xFu; }
#define XB_SPIN(cond, bar) do { unsigned _sp = 0; while (cond) { __builtin_amdgcn_s_sleep(1); \
    if ((++_sp & 255u) == 0u) { if (xb_ld(&(bar)[XB_TMO])) break; if (_sp > XB_SPIN_CAP) { atomicAdd(&(bar)[XB_TMO], 1u); break; } } } } while (0)

struct XcdBarrier { unsigned* bar; unsigned x; volatile LAS unsigned* st; };

__device__ __forceinline__ XcdBarrier xcd_barrier_post(unsigned* bar, volatile LAS unsigned* st) {
    XcdBarrier b; b.bar = bar; b.x = xb_xcc_id(); b.st = st;
    if (threadIdx.x == 0) (void)xb_add(&bar[XB_XCNT(b.x)], 1u);
    return b;
}
__device__ __forceinline__ void xcd_barrier_complete(unsigned* bar, unsigned x, unsigned& nloc, unsigned& nx) {
    const unsigned G = gridDim.x * gridDim.y * gridDim.z;
    unsigned sum, cnt, mine, sp = 0u;
    for (;;) {
        sum = 0u; cnt = 0u; mine = 0u;
#pragma unroll
        for (unsigned j = 0; j < 16; ++j) { const unsigned c = xb_ld(&bar[XB_XCNT(j)]); sum += c; cnt += (c > 0u) ? 1u : 0u; mine = (j == x) ? c : mine; }
        if (sum == G) break;
        __builtin_amdgcn_s_sleep(1);
        if ((++sp & 255u) == 0u) { if (xb_ld(&bar[XB_TMO])) break; if (sp > XB_SPIN_CAP) { atomicAdd(&bar[XB_TMO], 1u); break; } }
    }
    nloc = mine > 0u ? mine : 1u; nx = cnt > 0u ? cnt : 1u;
}
__device__ __forceinline__ void xcd_barrier(const XcdBarrier& b) {
    asm volatile("s_waitcnt vmcnt(0)" ::: "memory");
    __syncthreads();
    if (threadIdx.x == 0) {
        unsigned blo_ = (unsigned)(unsigned long long)b.bar, bhi_ = (unsigned)((unsigned long long)b.bar >> 32), bx_ = b.x;
        asm volatile("" : "+v"(blo_), "+v"(bhi_), "+v"(bx_));
        unsigned* bar = (unsigned*)(__attribute__((address_space(1))) unsigned*)(((unsigned long long)(unsigned)__builtin_amdgcn_readfirstlane(bhi_) << 32) | (unsigned)__builtin_amdgcn_readfirstlane(blo_));
        const unsigned bx = (unsigned)__builtin_amdgcn_readfirstlane(bx_);
        __builtin_amdgcn_s_waitcnt(0);
        unsigned nloc = b.st[0], nx = b.st[1];
        if (nloc == 0u) { xcd_barrier_complete(bar, bx, nloc, nx); b.st[0] = nloc; b.st[1] = nx; }
        const unsigned old = xb_add(&bar[XB_XSUB(bx)], 1u);
        const unsigned gen = old / nloc;
        if (old + 1u == (gen + 1u) * nloc) {
            __builtin_amdgcn_fence(__ATOMIC_RELEASE, "agent");
            asm volatile("s_waitcnt vmcnt(0)" ::: "memory");
            const unsigned og = xb_add(&bar[XB_TOP], 1u);
            const unsigned tg = og / nx;
            if (og + 1u == (tg + 1u) * nx) xb_add(&bar[XB_TOPGEN], 1u);
            else XB_SPIN(xb_ld(&bar[XB_TOPGEN]) == tg, bar);
            __builtin_amdgcn_fence(__ATOMIC_ACQUIRE, "agent");
            xb_add(&bar[XB_XGEN(bx)], 1u);
            asm volatile("s_waitcnt vmcnt(0)" ::: "memory");
        } else {
            XB_SPIN(xb_ld(&bar[XB_XGEN(bx)]) == gen, bar);
            __builtin_amdgcn_fence(__ATOMIC_ACQUIRE, "agent");
            asm volatile("s_waitcnt vmcnt(0)" ::: "memory");
        }
    }
    __syncthreads();
}

__device__ __forceinline__ float bf2f(unsigned v) { return __uint_as_float(v << 16); }
__device__ __forceinline__ float bflo(unsigned v) { return __uint_as_float(v << 16); }
__device__ __forceinline__ float bfhi(unsigned v) { return __uint_as_float(v & 0xffff0000u); }
typedef float f32x2 __attribute__((ext_vector_type(2)));
typedef __bf16 bf16x2_t __attribute__((ext_vector_type(2)));
__device__ __forceinline__ unsigned pk2(float lo, float hi) { const f32x2 v = {lo, hi}; const bf16x2_t b = __builtin_convertvector(v, bf16x2_t); return __builtin_bit_cast(unsigned, b); }
__device__ __forceinline__ bf16_t f2bf(float f) { return (bf16_t)(pk2(f, 0.f) & 0xffffu); }
__device__ __forceinline__ float fexp_(float x) { return __builtin_amdgcn_exp2f(x * 1.4426950408889634f); }
__device__ __forceinline__ float flog_(float x) { return __builtin_amdgcn_logf(x) * 0.6931471805599453f; }
__device__ __forceinline__ float rcpf_(float x) { return __builtin_amdgcn_rcpf(x); }
__device__ __forceinline__ float sigmoidf_(float x) { return rcpf_(1.0f + fexp_(-x)); }
__device__ __forceinline__ float siluf_(float x) { return x * rcpf_(1.0f + fexp_(-x)); }
__device__ __forceinline__ float tanhf_(float y) { return 1.0f - 2.0f * rcpf_(1.0f + fexp_(2.0f * y)); }
__device__ __forceinline__ float geluf_(float x) { return 0.5f * x * (1.0f + tanhf_(0.7978845608028654f * (x + 0.044715f * x * x * x))); }
__device__ __forceinline__ float softplusf_(float x) { return fmaxf(x, 0.f) + flog_(1.0f + fexp_(-fabsf(x))); }
__device__ __forceinline__ void lds_barrier() { asm volatile("s_waitcnt lgkmcnt(0)" ::: "memory"); __builtin_amdgcn_s_barrier(); asm volatile("" ::: "memory"); }

template <int CTRL> __device__ __forceinline__ float dpp_f(float v) {
    return __int_as_float(__builtin_amdgcn_update_dpp(0, __float_as_int(v), CTRL, 0xf, 0xf, true));
}
__device__ __forceinline__ float rowsum16(float v) {
    v += dpp_f<0x128>(v); v += dpp_f<0x124>(v); v += dpp_f<0x122>(v); v += dpp_f<0x121>(v); return v;
}
__device__ __forceinline__ float wave_sum(float v) {
    v = rowsum16(v); v += __shfl_xor(v, 16); v += __shfl_xor(v, 32); return v;
}
__device__ __forceinline__ f32x4 mfma16(bf16x8 a, bf16x8 b, f32x4 c) { return __builtin_amdgcn_mfma_f32_16x16x32_bf16(a, b, c, 0, 0, 0); }
__device__ __forceinline__ bf16x8 ld_frag(const bf16_t* p) { return *(const bf16x8*)p; }
__device__ __forceinline__ void unpack8(const u32x4& v, float* f) {
    f[0] = bflo(v.x); f[1] = bfhi(v.x); f[2] = bflo(v.y); f[3] = bfhi(v.y); f[4] = bflo(v.z); f[5] = bfhi(v.z); f[6] = bflo(v.w); f[7] = bfhi(v.w);
}
__device__ __forceinline__ u32x4 pack8(const float* f) { u32x4 o; o.x = pk2(f[0], f[1]); o.y = pk2(f[2], f[3]); o.z = pk2(f[4], f[5]); o.w = pk2(f[6], f[7]); return o; }

template <class RowMap>
__device__ __forceinline__ void tr_tile(const int tid, float* tile, const float* __restrict__ src, int ld, int k0, int n0, int Ndim,
                                        bf16_t* __restrict__ dst, int dst_ld, RowMap rm) {
#pragma unroll
    for (int j = 0; j < 2; ++j) {
        const int kk = (tid >> 4) + 32 * j, n4 = (tid & 15) * 4;
        float4 v = make_float4(0.f, 0.f, 0.f, 0.f);
        if (n0 + n4 < Ndim) v = *(const float4*)(src + (size_t)(k0 + kk) * ld + n0 + n4);
        tile[kk * 65 + n4 + 0] = v.x; tile[kk * 65 + n4 + 1] = v.y; tile[kk * 65 + n4 + 2] = v.z; tile[kk * 65 + n4 + 3] = v.w;
    }
    lds_barrier();
    const int nn = tid >> 3, kc = (tid & 7) * 8;
    if (n0 + nn < Ndim) {
        float f[8];
#pragma unroll
        for (int i = 0; i < 8; ++i) f[i] = tile[(kc + i) * 65 + nn];
        *(u32x4*)(dst + (size_t)rm(n0 + nn) * dst_ld + k0 + kc) = pack8(f);
    }
    lds_barrier();
}
struct TrJob { const float* src; int ld, k0, n0, Ndim; bf16_t* dst; int dst_ld, mode  , up; };
__device__ __forceinline__ int trjob_row(const TrJob& j, int n) { return j.mode ? ((n >> 5) * 64 + j.up * 32 + (n & 31)) : n; }
__device__ __forceinline__ void tr_pair(const int tid, float* tileA, float* tileB, const TrJob& a, const TrJob& b, const bool haveB) {
    float4 va[2], vb[2];
#pragma unroll
    for (int j = 0; j < 2; ++j) {
        const int kk = (tid >> 4) + 32 * j, n4 = (tid & 15) * 4;
        va[j] = (a.n0 + n4 < a.Ndim) ? *(const float4*)(a.src + (size_t)(a.k0 + kk) * a.ld + a.n0 + n4) : make_float4(0.f, 0.f, 0.f, 0.f);
        vb[j] = (haveB && b.n0 + n4 < b.Ndim) ? *(const float4*)(b.src + (size_t)(b.k0 + kk) * b.ld + b.n0 + n4) : make_float4(0.f, 0.f, 0.f, 0.f);
    }
#pragma unroll
    for (int j = 0; j < 2; ++j) {
        const int kk = (tid >> 4) + 32 * j, n4 = (tid & 15) * 4;
        tileA[kk * 65 + n4 + 0] = va[j].x; tileA[kk * 65 + n4 + 1] = va[j].y; tileA[kk * 65 + n4 + 2] = va[j].z; tileA[kk * 65 + n4 + 3] = va[j].w;
        tileB[kk * 65 + n4 + 0] = vb[j].x; tileB[kk * 65 + n4 + 1] = vb[j].y; tileB[kk * 65 + n4 + 2] = vb[j].z; tileB[kk * 65 + n4 + 3] = vb[j].w;
    }
    lds_barrier();
    const int nn = tid >> 3, kc = (tid & 7) * 8;
    if (a.n0 + nn < a.Ndim) {
        float f[8];
#pragma unroll
        for (int i = 0; i < 8; ++i) f[i] = tileA[(kc + i) * 65 + nn];
        *(u32x4*)(a.dst + (size_t)trjob_row(a, a.n0 + nn) * a.dst_ld + a.k0 + kc) = pack8(f);
    }
    if (haveB && b.n0 + nn < b.Ndim) {
        float f[8];
#pragma unroll
        for (int i = 0; i < 8; ++i) f[i] = tileB[(kc + i) * 65 + nn];
        *(u32x4*)(b.dst + (size_t)trjob_row(b, b.n0 + nn) * b.dst_ld + b.k0 + kc) = pack8(f);
    }
    lds_barrier();
}
struct RmId { __device__ int operator()(int n) const { return n; } };
struct RmOff { int off; __device__ int operator()(int n) const { return n + off; } };
struct RmWin { __device__ int operator()(int n) const { return n < 1024 ? n : (n < 1032 ? 3328 + (n - 1024) : n - 8); } };
struct RmGate { int up; __device__ int operator()(int j) const { return (j >> 7) * 256 + up * 128 + (j & 127); } };

namespace g8 {
constexpr int BM = 256, BK = 64, HALF = 128, HTB = HALF * BK * 2, STAGE_BYTES = 8 * HTB, NXCD = 8, WGM = 4;
__device__ __forceinline__ int lds_byte(int r, int c) { const int st = (r >> 4) * 2 + (c >> 5), rr = r & 15, cc = c & 31, ob = rr * 64 + cc * 2; return st * 1024 + (ob ^ (((ob >> 9) & 1) << 5)); }
__device__ __forceinline__ void stage_rc(int b, int& R, int& C) { const int st = b / 1024, sb = b % 1024, swz = sb ^ (((sb >> 9) & 1) << 5); R = (st >> 1) * 16 + swz / 64; C = (st & 1) * 32 + (swz % 64) / 2; }
__device__ __forceinline__ int perm32(int rho) { const int n = rho >> 4, i = rho & 15; return 8 * (i >> 2) + 4 * n + (i & 3); }
struct Unit { int pm, pn; };
struct StaticOrder {
    int nM, nN, nwg, G, c;
    __device__ void init(int M, int N, int G_, int c_) { nM = M / BM; nN = N / BM; nwg = nM * nN; G = G_; c = c_; }
    __device__ bool next(int i, Unit& u) const {
        const long L = (long)i * G + c; if (L >= nwg) return false;
        int wgid = (int)L; { const int q = nwg / NXCD, r = nwg % NXCD, xcd = wgid % NXCD, off = wgid / NXCD; wgid = (xcd < r ? xcd * (q + 1) : r * (q + 1) + (xcd - r) * q) + off; }
        const int nig = WGM * nN, gid = wgid / nig, fm = gid * WGM, gsz = (nM - fm) < WGM ? (nM - fm) : WGM;
        u.pm = fm + ((wgid % nig) % gsz); u.pn = (wgid % nig) / gsz; return true;
    }
    __device__ const int* rows(const Unit&) const { return nullptr; }
};
struct OneUnit { int pm; __device__ bool next(int i, Unit& u) const { if (i > 0) return false; u.pm = pm; u.pn = 0; return true; } __device__ const int* rows(const Unit&) const { return nullptr; } };
template <int NT> struct MoeOrder {
    int ntiles, x, j, nj; const int* tile_e; const int* rowtok;
    int tab;
    __device__ void prime(int lane) { const int v = j + lane * nj, rt = (v / NT) * 8 + x; tab = (rt < ntiles) ? tile_e[rt] : 0; }
    __device__ bool next(int i, Unit& u) const {
        const int v = j + i * nj, rtl = v / NT, nt = v - rtl * NT, rt = rtl * 8 + x;
        if (rt >= ntiles) return false;
        u.pm = rt; u.pn = __builtin_amdgcn_readlane(tab, i) * NT + nt; return true;
    }
    __device__ const int* rows(const Unit& u) const { return rowtok + u.pm * 256; }
};
}
template <class Epi, class Sched, bool GATHER>
__device__ __forceinline__ void gemm8(const int tid  , LAS unsigned char* lds, const char* Abase, const char* Btbase, const int K, const Sched& S, const Epi& E, const unsigned hrow_off, const unsigned zero_off) {
    using namespace g8;
    const int wid = __builtin_amdgcn_readfirstlane(tid >> 6), lane = tid & 63, wr = wid >> 2, wc = wid & 3, fr = lane & 15, fq = lane >> 4;
    const int nt = K / BK;
    unsigned voffA[2], voffB[2];
#pragma unroll
    for (int i = 0; i < 2; ++i) { int R, C; stage_rc(tid * 16 + i * 8192, R, C); const int Rb = Epi::PERM ? (64 * (R >> 5) + perm32(R & 31)) : R;
        voffA[i] = (unsigned)(R * K + C) * 2u; voffB[i] = (unsigned)(Rb * K + C) * 2u; }
    const size_t kstep = (size_t)(BK * 2);
    const size_t hstep = (size_t)HALF * K * 2;
    const size_t bhstep = Epi::PERM ? (size_t)32 * K * 2 : hstep;
    const size_t tstep = 2 * hstep;
    const unsigned ldsw = (unsigned)wid * 1024u;
    const int aoff = lds_byte(wr * 64 + fr, fq * 8), boff = lds_byte(wc * 32 + fr, fq * 8);
#define G8_SA(b, h) (((b) * 2 + (h)) * HTB)
#define G8_SB(b, h) ((4 + (b) * 2 + (h)) * HTB)
#define G8_STAGE(bufoff, gbase, voff) do { _Pragma("unroll") for (int _i = 0; _i < 2; ++_i) \
        __builtin_amdgcn_global_load_lds((const __attribute__((address_space(1))) unsigned*)((const char*)(gbase) + (voff)[_i]), (LAS unsigned*)(lds + (bufoff) + ldsw + _i * 8192), 16, 0, 0); } while (0)
#define G8_STAGE_A(bufoff, NX, h, kb) do { if (GATHER) { if (NX) { G8_STAGE(bufoff, Abase + (kb), ngv[h]); } else { G8_STAGE(bufoff, Abase + (kb), cgv[h]); } } \
        else { G8_STAGE(bufoff, ((NX) ? nA : cA) + (size_t)(h) * hstep + (kb), voffA); } } while (0)
#define G8_LDA(dst, b, h) do { _Pragma("unroll") for (int m = 0; m < 4; ++m) _Pragma("unroll") for (int k = 0; k < 2; ++k) dst[m][k] = *(const LAS bf16x8*)(lds + G8_SA(b, h) + aoff + m * 2048 + k * 1024); } while (0)
#define G8_LDB(dst, b, h) do { _Pragma("unroll") for (int n = 0; n < 2; ++n) _Pragma("unroll") for (int k = 0; k < 2; ++k) dst[n][k] = *(const LAS bf16x8*)(lds + G8_SB(b, h) + boff + n * 2048 + k * 1024); } while (0)
#define G8_MMA(ai, bj, At, Bt) do { if (!(Epi::SKIP_BJ1 && (bj) == 1)) { __builtin_amdgcn_s_setprio(1); _Pragma("unroll") for (int m = 0; m < 4; ++m) _Pragma("unroll") for (int n = 0; n < 2; ++n) _Pragma("unroll") for (int k = 0; k < 2; ++k) \
        acc[ai][bj][m][n] = __builtin_amdgcn_mfma_f32_16x16x32_bf16(Bt[n][k], At[m][k], acc[ai][bj][m][n], 0, 0, 0); __builtin_amdgcn_s_setprio(0); } } while (0)
#define G8_WAIT_V(n) asm volatile("s_waitcnt vmcnt(" #n ")" ::: "memory")
#define G8_WAIT_L(n) asm volatile("s_waitcnt lgkmcnt(" #n ")" ::: "memory")
#define G8_BAR __builtin_amdgcn_s_barrier()
#define G8_SCHED __builtin_amdgcn_sched_barrier(0)
    Unit cur, nxt; int ui = 0;
    if (!S.next(0, cur)) return;
    f32x4 acc[2][2][4][2];
#pragma unroll
    for (int a = 0; a < 2; ++a)
#pragma unroll
        for (int b = 0; b < 2; ++b)
#pragma unroll
            for (int m = 0; m < 4; ++m)
#pragma unroll
                for (int n = 0; n < 2; ++n) acc[a][b][m][n] = (f32x4){0.f, 0.f, 0.f, 0.f};
    bf16x8 At[4][2], B0[2][2], B1[2][2];
    unsigned cgv[2][2], ngv[2][2];
    auto gather_off = [&](const Unit& u, unsigned (&gv)[2][2]) {
        const int* rl = S.rows(u);
#pragma unroll
        for (int h = 0; h < 2; ++h)
#pragma unroll
            for (int i = 0; i < 2; ++i) { int R, C; stage_rc(tid * 16 + i * 8192, R, C);
                const int v = rl[h * 128 + R]; gv[h][i] = (v < 0 ? zero_off : hrow_off + (unsigned)(v >> 1) * 2048u) + (unsigned)C * 2u; }
    };
    const char* cA = GATHER ? Abase : Abase + (size_t)cur.pm * tstep; const char* cB = Btbase + (size_t)cur.pn * tstep;
    const char* nA = cA;
    typename Epi::Pre pre; E.prefetch(cur, wr, fr, pre);
    if (GATHER) { gather_off(cur, cgv);
#pragma unroll
        for (int h = 0; h < 2; ++h) { ngv[h][0] = cgv[h][0]; ngv[h][1] = cgv[h][1]; } }
    G8_STAGE(G8_SB(0, 0), cB, voffB); G8_STAGE_A(G8_SA(0, 0), false, 0, (size_t)0); G8_STAGE(G8_SB(0, 1), cB + bhstep, voffB); G8_STAGE_A(G8_SA(0, 1), false, 1, (size_t)0);
    if (wr == 1) G8_BAR;
    G8_WAIT_V(4); G8_BAR;
    G8_STAGE(G8_SB(1, 0), cB + kstep, voffB); G8_STAGE_A(G8_SA(1, 0), false, 0, kstep); G8_STAGE(G8_SB(1, 1), cB + bhstep + kstep, voffB);
    G8_WAIT_V(6); G8_BAR;
    for (;;) {
        const bool has_next = S.next(ui + 1, nxt);
        const char* nB = has_next ? Btbase + (size_t)nxt.pn * tstep : cB;
        if (GATHER) { if (has_next) gather_off(nxt, ngv); }
        else nA = has_next ? Abase + (size_t)nxt.pm * tstep : cA;
#pragma unroll 1
        for (int t = 0; t < nt; t += 2) {
            const bool last = (t == nt - 2);
            const size_t k1 = (size_t)(t + 1) * kstep;
            const size_t k2 = last ? (size_t)0 : (size_t)(t + 2) * kstep, k3 = k2 + kstep;
            const char* b2 = (last ? nB : cB) + k2; const char* b3 = b2 + kstep;
            G8_LDB(B0, 0, 0); G8_SCHED; G8_LDA(At, 0, 0); G8_STAGE_A(G8_SA(1, 1), false, 1, k1);
            G8_WAIT_L(8); G8_BAR; G8_WAIT_L(0); G8_MMA(0, 0, At, B0); G8_BAR; G8_SCHED;
            G8_LDB(B1, 0, 1); G8_STAGE(G8_SB(0, 0), b2, voffB);
            G8_BAR; G8_WAIT_L(0); G8_MMA(0, 1, At, B1); G8_BAR;
            G8_LDA(At, 0, 1); if (last) { G8_STAGE_A(G8_SA(0, 0), true, 0, k2); } else { G8_STAGE_A(G8_SA(0, 0), false, 0, k2); }
            G8_BAR; G8_WAIT_L(0); G8_MMA(1, 0, At, B0); G8_BAR; G8_SCHED;
            G8_STAGE(G8_SB(0, 1), b2 + bhstep, voffB);
            G8_WAIT_V(6); G8_BAR; G8_MMA(1, 1, At, B1); G8_BAR;
            G8_LDB(B0, 1, 0); G8_SCHED; G8_LDA(At, 1, 0); if (last) { G8_STAGE_A(G8_SA(0, 1), true, 1, k2); } else { G8_STAGE_A(G8_SA(0, 1), false, 1, k2); }
            G8_WAIT_L(8); G8_BAR; G8_WAIT_L(0); G8_MMA(0, 0, At, B0); G8_BAR; G8_SCHED;
            G8_LDB(B1, 1, 1); G8_STAGE(G8_SB(1, 0), b3, voffB);
            G8_BAR; G8_WAIT_L(0); G8_MMA(0, 1, At, B1); G8_BAR;
            G8_LDA(At, 1, 1); if (last) { G8_STAGE_A(G8_SA(1, 0), true, 0, k3); } else { G8_STAGE_A(G8_SA(1, 0), false, 0, k3); }
            G8_BAR; G8_WAIT_L(0); G8_MMA(1, 0, At, B0); G8_BAR; G8_SCHED;
            G8_STAGE(G8_SB(1, 1), b3 + bhstep, voffB);
            G8_WAIT_V(6); G8_BAR; G8_MMA(1, 1, At, B1); G8_BAR;
        }
        E(acc, cur, wr, wc, fr, fq, pre);
        if (!has_next) break;
#pragma unroll
        for (int a = 0; a < 2; ++a)
#pragma unroll
            for (int b = 0; b < 2; ++b)
#pragma unroll
                for (int m = 0; m < 4; ++m)
#pragma unroll
                    for (int n = 0; n < 2; ++n) acc[a][b][m][n] = (f32x4){0.f, 0.f, 0.f, 0.f};
        cur = nxt; cB = nB; ++ui;
        E.prefetch(cur, wr, fr, pre);
        if (GATHER) {
#pragma unroll
            for (int h = 0; h < 2; ++h) { cgv[h][0] = ngv[h][0]; cgv[h][1] = ngv[h][1]; }
        } else cA = nA;
    }
    G8_WAIT_V(0);
    if (wr == 0) G8_BAR;
    G8_BAR;
}

template <int NOSTORE = 0  >
struct Ep8Inproj {
    static constexpr bool PERM = true; static constexpr bool SKIP_BJ1 = false;
    bf16_t* P;
    struct Pre {}; __device__ __forceinline__ void prefetch(const g8::Unit&, int, int, Pre&) const {}
    __device__ __forceinline__ void operator()(const f32x4 (&acc)[2][2][4][2], const g8::Unit& u, int wr, int wc, int fr, int fq, const Pre&) const {
#pragma unroll
        for (int ai = 0; ai < 2; ++ai)
#pragma unroll
            for (int m = 0; m < 4; ++m) {
                bf16_t* rowp = P + (size_t)(u.pm * 256 + ai * 128 + wr * 64 + m * 16 + fr) * PW;
#pragma unroll
                for (int bj = 0; bj < 2; ++bj) {
                    const int col = u.pn * 256 + wc * 64 + bj * 32 + fq * 8;
                    u32x4 o; o.x = pk2(acc[ai][bj][m][0][0], acc[ai][bj][m][0][1]); o.y = pk2(acc[ai][bj][m][0][2], acc[ai][bj][m][0][3]);
                    o.z = pk2(acc[ai][bj][m][1][0], acc[ai][bj][m][1][1]); o.w = pk2(acc[ai][bj][m][1][2], acc[ai][bj][m][1][3]);
                    if (!NOSTORE || o.x == 0x7fc12345u) *(u32x4*)(rowp + col) = o;
                }
            }
    }
};
struct Ep8Outproj {
    static constexpr bool PERM = true; static constexpr bool SKIP_BJ1 = false;
    const float* xin; const bf16_t* xb; bf16_t* xbo; const float* modl;
    struct Pre {}; __device__ __forceinline__ void prefetch(const g8::Unit&, int, int, Pre&) const {}
    __device__ __forceinline__ void operator()(const f32x4 (&acc)[2][2][4][2], const g8::Unit& u, int wr, int wc, int fr, int fq, const Pre&) const {
        const float* gt = modl + (size_t)((u.pm * 256) >> 13) * 6144 + 2 * 1024;
        if (xin) {
#pragma unroll
            for (int bj = 0; bj < 2; ++bj) {
                const int col = u.pn * 256 + wc * 64 + bj * 32 + fq * 8;
                const float4 g0 = *(const float4*)(gt + col), g1 = *(const float4*)(gt + col + 4);
                const float gg[8] = {g0.x, g0.y, g0.z, g0.w, g1.x, g1.y, g1.z, g1.w};
#pragma unroll
                for (int ai = 0; ai < 2; ++ai)
#pragma unroll
                    for (int m = 0; m < 4; ++m) {
                        const size_t off = (size_t)(u.pm * 256 + ai * 128 + wr * 64 + m * 16 + fr) * 1024 + col;
                        float x[8];
                        { const float4 a = *(const float4*)(xin + off), b4 = *(const float4*)(xin + off + 4); x[0] = a.x; x[1] = a.y; x[2] = a.z; x[3] = a.w; x[4] = b4.x; x[5] = b4.y; x[6] = b4.z; x[7] = b4.w; }
#pragma unroll
                        for (int n = 0; n < 2; ++n)
#pragma unroll
                            for (int r = 0; r < 4; ++r) x[n * 4 + r] += gg[n * 4 + r] * acc[ai][bj][m][n][r];
                        *(u32x4*)(xbo + off) = pack8(x);
                    }
            }
            return;
        }
        const size_t rbase = (size_t)(u.pm * 256 + wr * 64 + fr) * 1024 + u.pn * 256 + wc * 64 + fq * 8;
        u32x4 xr[2][2][4];
#pragma unroll
        for (int bj = 0; bj < 2; ++bj)
#pragma unroll
            for (int ai = 0; ai < 2; ++ai)
#pragma unroll
                for (int m = 0; m < 4; ++m) xr[bj][ai][m] = *(const u32x4*)(xb + rbase + (size_t)(ai * 128 + m * 16) * 1024 + bj * 32);
        __builtin_amdgcn_sched_barrier(0);
#pragma unroll
        for (int bj = 0; bj < 2; ++bj) {
            const int col = u.pn * 256 + wc * 64 + bj * 32 + fq * 8;
            const float4 g0 = *(const float4*)(gt + col), g1 = *(const float4*)(gt + col + 4);
            const float gg[8] = {g0.x, g0.y, g0.z, g0.w, g1.x, g1.y, g1.z, g1.w};
#pragma unroll
            for (int ai = 0; ai < 2; ++ai)
#pragma unroll
                for (int m = 0; m < 4; ++m) {
                    float x[8];
                    unpack8(xr[bj][ai][m], x);
#pragma unroll
                    for (int n = 0; n < 2; ++n)
#pragma unroll
                        for (int r = 0; r < 4; ++r) x[n * 4 + r] += gg[n * 4 + r] * acc[ai][bj][m][n][r];
                    *(u32x4*)(xbo + rbase + (size_t)(ai * 128 + m * 16) * 1024 + bj * 32) = pack8(x);
                }
        }
    }
};
struct Ep8Logit {
    static constexpr bool PERM = false;
    static constexpr bool SKIP_BJ1 = true;
    float* Lg;
    struct Pre {}; __device__ __forceinline__ void prefetch(const g8::Unit&, int, int, Pre&) const {}
    __device__ __forceinline__ void operator()(const f32x4 (&acc)[2][2][4][2], const g8::Unit& u, int wr, int wc, int fr, int fq, const Pre&) const {
#pragma unroll
        for (int ai = 0; ai < 2; ++ai)
#pragma unroll
            for (int m = 0; m < 4; ++m) {
                float* rowp = Lg + (size_t)(u.pm * 256 + ai * 128 + wr * 64 + m * 16 + fr) * 80;
#pragma unroll
                for (int n = 0; n < 2; ++n) {
                    const int col = wc * 32 + n * 16 + fq * 4;
                    if (col < 80) *(float4*)(rowp + col) = make_float4(acc[ai][0][m][n][0], acc[ai][0][m][n][1], acc[ai][0][m][n][2], acc[ai][0][m][n][3]);
                }
            }
    }
};
struct Ep8Moe1 {
    static constexpr bool PERM = true; static constexpr bool SKIP_BJ1 = false;
    bf16_t* Hd;
    struct Pre {}; __device__ __forceinline__ void prefetch(const g8::Unit&, int, int, Pre&) const {}
    __device__ __forceinline__ void operator()(const f32x4 (&acc)[2][2][4][2], const g8::Unit& u, int wr, int wc, int fr, int fq, const Pre&) const {
        const int jb = (u.pn & 1) * 128;
#pragma unroll
        for (int ai = 0; ai < 2; ++ai)
#pragma unroll
            for (int m = 0; m < 4; ++m) {
                bf16_t* rowp = Hd + (size_t)(u.pm * 256 + ai * 128 + wr * 64 + m * 16 + fr) * 256 + jb + wc * 32 + fq * 8;
                float h[8];
#pragma unroll
                for (int n = 0; n < 2; ++n)
#pragma unroll
                    for (int r = 0; r < 4; ++r) h[n * 4 + r] = siluf_(acc[ai][0][m][n][r]) * acc[ai][1][m][n][r];
                *(u32x4*)rowp = pack8(h);
            }
    }
};
template <int LINEAR = 0  >
struct Ep8Moe2 {
    static constexpr bool PERM = true; static constexpr bool SKIP_BJ1 = false;
    bf16_t* Y; const int* rowtok; const float* rowg;
    struct Pre { int v[8]; float g[8]; };
    __device__ __forceinline__ void prefetch(const g8::Unit& u, int wr, int fr, Pre& q) const {
#pragma unroll
        for (int ai = 0; ai < 2; ++ai)
#pragma unroll
            for (int m = 0; m < 4; ++m) {
                const int row = u.pm * 256 + ai * 128 + wr * 64 + m * 16 + fr;
                q.v[ai * 4 + m] = LINEAR ? (row % (2 * T_TOK)) : rowtok[row];
                q.g[ai * 4 + m] = LINEAR ? 1.0f : rowg[row];
            }
    }
    __device__ __forceinline__ void operator()(const f32x4 (&acc)[2][2][4][2], const g8::Unit& u, int wr, int wc, int fr, int fq, const Pre& q) const {
        const int n0 = (u.pn & 3) * 256;
#pragma unroll
        for (int ai = 0; ai < 2; ++ai)
#pragma unroll
            for (int m = 0; m < 4; ++m) {
                const int v = q.v[ai * 4 + m];
                if (v >= 0) {
                    const float g = q.g[ai * 4 + m];
                    bf16_t* yp = Y + ((size_t)(v & 1) * T_TOK + (size_t)(v >> 1)) * 1024 + n0 + wc * 64 + fq * 8;
#pragma unroll
                    for (int bj = 0; bj < 2; ++bj) {
                        u32x4 o; o.x = pk2(g * acc[ai][bj][m][0][0], g * acc[ai][bj][m][0][1]); o.y = pk2(g * acc[ai][bj][m][0][2], g * acc[ai][bj][m][0][3]);
                        o.z = pk2(g * acc[ai][bj][m][1][0], g * acc[ai][bj][m][1][1]); o.w = pk2(g * acc[ai][bj][m][1][2], g * acc[ai][bj][m][1][3]);
                        *(u32x4*)(yp + bj * 32) = o;
                    }
                }
            }
    }
};

#define MOD ((float*)(ws + OFF_MOD))
#define WIN ((bf16_t*)(ws + OFF_WIN))
#define WOUT ((bf16_t*)(ws + OFF_WOUT))
#define SGUW ((bf16_t*)(ws + OFF_SGUW))
#define LWU ((bf16_t*)(ws + OFF_LWU))
#define LAU ((bf16_t*)(ws + OFF_LAU))
#define LGU ((bf16_t*)(ws + OFF_LGU))
#define ROUTW ((bf16_t*)(ws + OFF_ROUTW))
#define GCD ((float*)(ws + OFF_GCD))
#define WGU ((bf16_t*)(ws + OFF_WGU))
#define WD ((bf16_t*)(ws + OFF_WD))
#define Hb ((bf16_t*)(ws + OFF_H))
#define GAB ((float*)(ws + OFF_GAB))
#define GW ((float*)(ws + OFF_GW))
__device__ __forceinline__ int gdn_slot(int u) { return (u & ~127) | (((u & 127) + 4 * (u >> 7)) & 127); }
#define Pb ((bf16_t*)(ws + OFF_P))
#define MIX ((bf16_t*)(ws + OFF_MIX))
#define RW_E ((bf16_t*)(ws + OFF_RW))
#define RW_CE ((float*)(ws + OFF_CE))
#define RW_KK ((bf16_t*)(ws + OFF_RW + 1 * RW_ARR))
#define RW_ZB ((bf16_t*)(ws + OFF_RW + 2 * RW_ARR))
#define RW_KM ((bf16_t*)(ws + OFF_RW + 3 * RW_ARR))
#define RW_R ((bf16_t*)(ws + OFF_RW + 4 * RW_ARR))
#define RW_V ((bf16_t*)(ws + OFF_RW + 5 * RW_ARR))
#define RW_G ((bf16_t*)(ws + OFF_RW + 6 * RW_ARR))
#define YR ((bf16_t*)(ws + OFF_YR))
#define LOGIT ((float*)(ws + OFF_P + PO_LOGIT))
#define TOKINF ((uint4*)(ws + OFF_P + PO_TOKINF))
#define CBASE ((unsigned*)(ws + OFF_P + PO_CBASE))
#define ROWTOK ((int*)(ws + OFF_P + PO_ROWTOK))
#define ROWG ((float*)(ws + OFF_P + PO_ROWG))
#define TILEE ((int*)(ws + OFF_P + PO_TILEE))
#define HID ((bf16_t*)(ws + OFF_P + PO_HID))
#define YB ((bf16_t*)(ws + OFF_P + PO_Y))
#define x_in INP(0)
#define xo (p.out)
#define XB ((bf16_t*)((char*)p.out + (size_t)T_TOK * 1024 * 2))
#define XB_LAST ((bf16_t*)(ws + OFF_RW))
#define XB_MID(l) ((l) == NLAYER - 1 ? XB_LAST : XB)
#define INP(k) (p.in[k])

__device__ __forceinline__ void ph_norm1(const Params& p, const int l_in) {
    extern __shared__ __attribute__((aligned(16))) char smem[];
    int tid_ = threadIdx.x; asm volatile("" : "+v"(tid_));
    int blk_ = blockIdx.x; asm volatile("" : "+s"(blk_));
    unsigned long long w64_ = (unsigned long long)p.ws; asm volatile("" : "+s"(w64_));
    char* ws_ = (char*)(__attribute__((address_space(1))) char*)w64_;
    int l_ = l_in; asm volatile("" : "+v"(l_)); const int l = __builtin_amdgcn_readfirstlane(l_);
    const int tid = tid_, lane = tid & 63, w = tid >> 6;
    int grid_ = gridDim.x; asm volatile("" : "+s"(grid_));
    const int blk = blk_, grid = grid_;
    const int fr = lane & 15, fq = lane >> 4;
    char* const ws = ws_;
    const float* const modl = MOD + (size_t)l * 8 * 6144;
    (void)lane; (void)w; (void)fr; (void)fq; (void)modl; (void)smem; (void)blk; (void)grid;
        const float* gn = INP(4) + l * 1024;
        const float* modp = (l > 0) ? (MOD + (size_t)(l - 1) * 8 * 6144) : nullptr;
        const int gw = blk * 8 + w, nw = grid * 8;
        unsigned gwp[8][8];
    #pragma unroll
        for (int o = 0; o < 8; ++o)
    #pragma unroll
            for (int j = 0; j < 4; ++j) { const float4 w4 = *(const float4*)(GW + (size_t)l * 8192 + o * 1024 + j * 256 + lane * 4); gwp[o][j * 2] = pk2(w4.x, w4.y); gwp[o][j * 2 + 1] = pk2(w4.z, w4.w); }
        for (int r0 = gw * 32; r0 < T_TOK; r0 += nw * 32) {
            const int b = r0 >> 13;
            float gs[16], sh[16], gf[16];
    #pragma unroll
            for (int j = 0; j < 4; ++j) {
                const int c = j * 256 + lane * 4;
                const float4 g4 = *(const float4*)(gn + c);
                const float4 sc4 = *(const float4*)(modl + b * 6144 + 1024 + c);
                const float4 sh4 = *(const float4*)(modl + b * 6144 + c);
                gs[j * 4 + 0] = g4.x * (1.f + sc4.x); gs[j * 4 + 1] = g4.y * (1.f + sc4.y); gs[j * 4 + 2] = g4.z * (1.f + sc4.z); gs[j * 4 + 3] = g4.w * (1.f + sc4.w);
                sh[j * 4 + 0] = sh4.x; sh[j * 4 + 1] = sh4.y; sh[j * 4 + 2] = sh4.z; sh[j * 4 + 3] = sh4.w;
                if (l > 0) { const float4 f4 = *(const float4*)(modp + b * 6144 + 5 * 1024 + c); gf[j * 4 + 0] = f4.x; gf[j * 4 + 1] = f4.y; gf[j * 4 + 2] = f4.z; gf[j * 4 + 3] = f4.w; }
                else { gf[j * 4 + 0] = 0.f; gf[j * 4 + 1] = 0.f; gf[j * 4 + 2] = 0.f; gf[j * 4 + 3] = 0.f; }
            }
            u32x2 cxb[4], cy0[4], cy1[4];
            float4 cxf[4];
            if (l > 0) {
    #pragma unroll
                for (int j = 0; j < 4; ++j) { const size_t o_ = (size_t)r0 * 1024 + j * 256 + lane * 4; cxb[j] = *(const u32x2*)(XB + o_); cy0[j] = __builtin_nontemporal_load((const u32x2*)(YB + o_)); cy1[j] = __builtin_nontemporal_load((const u32x2*)(YB + (size_t)T_TOK * 1024 + o_)); }
            } else {
    #pragma unroll
                for (int j = 0; j < 4; ++j) cxf[j] = *(const float4*)(x_in + (size_t)r0 * 1024 + j * 256 + lane * 4);
            }
            for (int r = r0; r < r0 + 32; ++r) {
                float xv[16]; float ss = 0.f;
                u32x2 nxb[4], ny0[4], ny1[4];
                float4 nxf[4];
                if (l > 0) {
                    const int rn = (r + 1 < r0 + 32) ? r + 1 : r;
    #pragma unroll
                    for (int j = 0; j < 4; ++j) { const size_t o_ = (size_t)rn * 1024 + j * 256 + lane * 4; nxb[j] = *(const u32x2*)(XB + o_); ny0[j] = __builtin_nontemporal_load((const u32x2*)(YB + o_)); ny1[j] = __builtin_nontemporal_load((const u32x2*)(YB + (size_t)T_TOK * 1024 + o_)); }
                } else {
                    const int rn = (r + 1 < r0 + 32) ? r + 1 : r;
    #pragma unroll
                    for (int j = 0; j < 4; ++j) nxf[j] = *(const float4*)(x_in + (size_t)rn * 1024 + j * 256 + lane * 4);
                }
    #pragma unroll
                for (int j = 0; j < 4; ++j) {
                    const int c = j * 256 + lane * 4;
                    float4 v;
                    if (l == 0) v = cxf[j];
                    else {
                        const u32x2 xb = cxb[j];
                        const u32x2 y0 = cy0[j];
                        const u32x2 y1 = cy1[j];
                        v.x = bflo(xb.x) + gf[j * 4 + 0] * (bflo(y0.x) + bflo(y1.x)); v.y = bfhi(xb.x) + gf[j * 4 + 1] * (bfhi(y0.x) + bfhi(y1.x));
                        v.z = bflo(xb.y) + gf[j * 4 + 2] * (bflo(y0.y) + bflo(y1.y)); v.w = bfhi(xb.y) + gf[j * 4 + 3] * (bfhi(y0.y) + bfhi(y1.y));
                        u32x2 xn; xn.x = pk2(v.x, v.y); xn.y = pk2(v.z, v.w);
                        *(u32x2*)(XB + (size_t)r * 1024 + c) = xn;
                    }
                    xv[j * 4 + 0] = v.x; xv[j * 4 + 1] = v.y; xv[j * 4 + 2] = v.z; xv[j * 4 + 3] = v.w;
                    ss += v.x * v.x + v.y * v.y + v.z * v.z + v.w * v.w;
                }
                ss = wave_sum(ss);
                const float rs = rsqrtf(ss * (1.0f / 1024.0f) + 1e-6f);
    #pragma unroll
                for (int i = 0; i < 16; ++i) xv[i] = xv[i] * rs * gs[i] + sh[i];
                unsigned hp[8];
    #pragma unroll
                for (int j = 0; j < 4; ++j) {
                    const int c = j * 256 + lane * 4;
                    u32x2 o;
                    o.x = pk2(xv[j * 4 + 0], xv[j * 4 + 1]);
                    o.y = pk2(xv[j * 4 + 2], xv[j * 4 + 3]);
                    *(u32x2*)(Hb + (size_t)r * 1024 + c) = o;
                    hp[j * 2] = o.x; hp[j * 2 + 1] = o.y;
                }
                float gd[8];
    #pragma unroll
                for (int o = 0; o < 8; ++o) {
                    float s = 0.f;
    #pragma unroll
                    for (int i = 0; i < 8; ++i) s = __builtin_amdgcn_fdot2_f32_bf16(__builtin_bit_cast(bf16x2_t, hp[i]), __builtin_bit_cast(bf16x2_t, gwp[o][i]), s, false);
                    gd[o] = s;
                }
    #pragma unroll
                for (int i = 0; i < 4; ++i) { const float keep = (lane & 1) ? gd[4 + i] : gd[i], send = (lane & 1) ? gd[i] : gd[4 + i]; gd[i] = keep + dpp_f<0xB1>(send); }
    #pragma unroll
                for (int i = 0; i < 2; ++i) { const float keep = (lane & 2) ? gd[2 + i] : gd[i], send = (lane & 2) ? gd[i] : gd[2 + i]; gd[i] = keep + dpp_f<0x4E>(send); }
                { const float keep = (lane & 4) ? gd[1] : gd[0], send = (lane & 4) ? gd[0] : gd[1]; gd[0] = keep + dpp_f<0x124>(send); }
                gd[0] += dpp_f<0x128>(gd[0]); gd[0] += __shfl_xor(gd[0], 16); gd[0] += __shfl_xor(gd[0], 32);
                if (lane < 8) GAB[(size_t)r * 8 + (((lane & 1) << 2) | (lane & 2) | ((lane >> 2) & 1))] = gd[0];
                if (l > 0) {
    #pragma unroll
                    for (int j = 0; j < 4; ++j) { cxb[j] = nxb[j]; cy0[j] = ny0[j]; cy1[j] = ny1[j]; }
                } else {
    #pragma unroll
                    for (int j = 0; j < 4; ++j) cxf[j] = nxf[j];
                }
            }
        }
}

template <int NOSTORE = 0>
__device__ __forceinline__ void ph_inproj(const Params& p, const int l_in) {
    extern __shared__ __attribute__((aligned(16))) char smem[];
    int tid_ = threadIdx.x; asm volatile("" : "+v"(tid_));
    int blk_ = blockIdx.x; asm volatile("" : "+s"(blk_));
    unsigned long long w64_ = (unsigned long long)p.ws; asm volatile("" : "+s"(w64_));
    char* ws_ = (char*)(__attribute__((address_space(1))) char*)w64_;
    int l_ = l_in; asm volatile("" : "+v"(l_)); const int l = __builtin_amdgcn_readfirstlane(l_);
    const int tid = tid_, lane = tid & 63, w = tid >> 6;
    int grid_ = gridDim.x; asm volatile("" : "+s"(grid_));
    const int blk = blk_, grid = grid_;
    const int fr = lane & 15, fq = lane >> 4;
    char* const ws = ws_;
    const float* const modl = MOD + (size_t)l * 8 * 6144;
    (void)lane; (void)w; (void)fr; (void)fq; (void)modl; (void)smem; (void)blk; (void)grid;
        g8::StaticOrder S; S.init(T_TOK, 3328, grid, blk);
        Ep8Inproj<NOSTORE> ep{Pb};
        gemm8<Ep8Inproj<NOSTORE>, g8::StaticOrder, false>(tid, (LAS unsigned char*)smem, (const char*)Hb, (const char*)(WIN + (size_t)l * WIN_ROWS * 1024), 1024, S, ep, 0u, 0u);
}

template <int SKIPST = 0  >
__device__ __forceinline__ void ph_rwprep(const Params& p, const int l_in, const int part = 2, const int first_in = -1, const int stride_in = 0) {
    extern __shared__ __attribute__((aligned(16))) char smem[];
    int tid_ = threadIdx.x; asm volatile("" : "+v"(tid_));
    int blk_ = blockIdx.x; asm volatile("" : "+s"(blk_));
    unsigned long long w64_ = (unsigned long long)p.ws; asm volatile("" : "+s"(w64_));
    char* ws_ = (char*)(__attribute__((address_space(1))) char*)w64_;
    int l_ = l_in; asm volatile("" : "+v"(l_)); const int l = __builtin_amdgcn_readfirstlane(l_);
    const int tid = tid_, lane = tid & 63, w = tid >> 6;
    int grid_ = gridDim.x; asm volatile("" : "+s"(grid_));
    const int blk = blk_, grid = grid_;
    const int fr = lane & 15, fq = lane >> 4;
    char* const ws = ws_;
    const float* const modl = MOD + (size_t)l * 8 * 6144;
    (void)lane; (void)w; (void)fr; (void)fq; (void)modl; (void)smem; (void)blk; (void)grid;
        bf16_t* X = (bf16_t*)smem;
        float* Kf = (float*)(smem + 33792);
        float* RS = (float*)(smem + 33792 + 65536);
        float* MU = (float*)(smem + 33792 + 65536 + 1024);
        for (int i = tid; i < 1024; i += 512) MU[i] = INP(17)[l * 1024 + i];
        lds_barrier();
        const float* w0 = INP(18) + l * 256; const float* a0 = INP(20) + l * 256;
        const float* kkp = INP(23) + l * 256; const float* kap = INP(24) + l * 256;
        const int nidx = part == 2 ? 1024 : (part == 0 ? 8 * RW_EARLY : 8 * (128 - RW_EARLY));
        int idx0_ = first_in < 0 ? blk : first_in; asm volatile("" : "+s"(idx0_));
        const int idxs = first_in < 0 ? grid : stride_in;
        for (int idx = idx0_; idx < nidx; idx += idxs) {
            const int tile = part == 2 ? idx : (part == 0 ? (idx / RW_EARLY) * 128 + idx % RW_EARLY : (idx / (128 - RW_EARLY)) * 128 + RW_EARLY + idx % (128 - RW_EARLY));
            const int t0 = tile * 64;
            {
                const int tok = tid >> 3, sub = tid & 7;
                const size_t t = (size_t)t0 + tok;
                const bool hasprev = ((t & (SEQ - 1)) != 0);
                const bf16_t* pc = Pb + t * PW + PC_RW;
                u32x4 cua[16], pua[16];
    #pragma unroll
                for (int it = 0; it < 16; ++it) cua[it] = *(const u32x4*)(pc + it * 64 + sub * 8);
    #pragma unroll
                for (int it = 0; it < 16; ++it) pua[it] = hasprev ? *(const u32x4*)(pc - PW + it * 64 + sub * 8) : (u32x4){0u, 0u, 0u, 0u};
    #pragma unroll
                for (int it = 0; it < 16; ++it) {
                    const int c = it * 64 + sub * 8;
                    const u32x4 cu = cua[it], pu = pua[it];
                    float cf[8], pf[8], ps[8];
                    unpack8(cu, cf); unpack8(pu, pf);
                    const float4 m0 = *(const float4*)(MU + c), m1 = *(const float4*)(MU + c + 4);
                    const float mm[8] = {m0.x, m0.y, m0.z, m0.w, m1.x, m1.y, m1.z, m1.w};
    #pragma unroll
                    for (int i = 0; i < 8; ++i) ps[i] = cf[i] + (pf[i] - cf[i]) * mm[i];
                    if (it < 4) { *(u32x4*)(RW_R + t * 256 + c) = pack8(ps); }
                    else if (it < 8) {
    #pragma unroll
                        for (int i = 0; i < 8; ++i) Kf[tok * 256 + (c - 256) + i] = ps[i];
                    }
                    else if (it < 12) { *(u32x4*)(RW_V + t * 256 + (c - 512)) = pack8(ps); }
                    else if (it == 12) {
    #pragma unroll
                        for (int i = 0; i < 8; ++i) ps[i] = tanhf_(ps[i]);
                        *(u32x4*)(X + tok * 264 + (c - 768)) = pack8(ps);
                    }
                    else if (it == 13) { *(u32x4*)(X + tok * 264 + 64 + (c - 832)) = pack8(ps); }
                    else {
    #pragma unroll
                        for (int i = 0; i < 8; ++i) ps[i] = sigmoidf_(ps[i]);
                        *(u32x4*)(X + tok * 264 + 128 + (c - 896)) = pack8(ps);
                    }
                }
            }
            lds_barrier();
            {
                const int tok = tid >> 3, sub = tid & 7, hd = sub >> 1, hf = sub & 1;
                float s = 0.f;
                for (int i = 0; i < 32; ++i) { const int ch = hd * 64 + hf * 32 + i; const float v = Kf[tok * 256 + ch] * kkp[ch]; s += v * v; }
                s += __shfl_xor(s, 1);
                if (hf == 0) RS[tok * 4 + hd] = rsqrtf(s + 1e-12f);
            }
            lds_barrier();
            {
#pragma unroll 1
                for (int mh = 0; mh < 2; ++mh) {
                f32x4 aw[2][2], aa[2][2], ag[2][2];
    #pragma unroll
                for (int m = 0; m < 2; ++m)
    #pragma unroll
                    for (int n = 0; n < 2; ++n) { aw[m][n] = (f32x4){0.f, 0.f, 0.f, 0.f}; aa[m][n] = aw[m][n]; ag[m][n] = aw[m][n]; }
    #pragma unroll
                for (int ks = 0; ks < 2; ++ks) {
                    bf16x8 bx[2], bxa[2];
    #pragma unroll
                    for (int m = 0; m < 2; ++m) { bx[m] = ld_frag(X + ((mh * 2 + m) * 16 + fr) * 264 + ks * 32 + fq * 8); bxa[m] = ld_frag(X + ((mh * 2 + m) * 16 + fr) * 264 + 64 + ks * 32 + fq * 8); }
    #pragma unroll
                    for (int n = 0; n < 2; ++n) {
                        const int chr = w * 32 + g8::perm32(n * 16 + fr);
                        const bf16x8 fw = ld_frag(LWU + ((size_t)l * 256 + chr) * 64 + ks * 32 + fq * 8);
                        const bf16x8 fa = ld_frag(LAU + ((size_t)l * 256 + chr) * 64 + ks * 32 + fq * 8);
    #pragma unroll
                        for (int m = 0; m < 2; ++m) { aw[m][n] = mfma16(fw, bx[m], aw[m][n]); aa[m][n] = mfma16(fa, bxa[m], aa[m][n]); }
                    }
                }
    #pragma unroll
                for (int ks = 0; ks < 4; ++ks) {
                    bf16x8 bx[2];
    #pragma unroll
                    for (int m = 0; m < 2; ++m) bx[m] = ld_frag(X + ((mh * 2 + m) * 16 + fr) * 264 + 128 + ks * 32 + fq * 8);
    #pragma unroll
                    for (int n = 0; n < 2; ++n) {
                        const int chr = w * 32 + g8::perm32(n * 16 + fr);
                        const bf16x8 fg = ld_frag(LGU + ((size_t)l * 256 + chr) * 128 + ks * 32 + fq * 8);
    #pragma unroll
                        for (int m = 0; m < 2; ++m) ag[m][n] = mfma16(fg, bx[m], ag[m][n]);
                    }
                }
                {
                    const int ch0 = w * 32 + fq * 8;
                    float w0a[8], a0a[8], kka[8], kaa[8];
    #pragma unroll
                    for (int n = 0; n < 2; ++n) {
                        const float4 w04 = *(const float4*)(w0 + ch0 + 4 * n), a04 = *(const float4*)(a0 + ch0 + 4 * n), kk4 = *(const float4*)(kkp + ch0 + 4 * n), ka4 = *(const float4*)(kap + ch0 + 4 * n);
                        w0a[4 * n] = w04.x; w0a[4 * n + 1] = w04.y; w0a[4 * n + 2] = w04.z; w0a[4 * n + 3] = w04.w;
                        a0a[4 * n] = a04.x; a0a[4 * n + 1] = a04.y; a0a[4 * n + 2] = a04.z; a0a[4 * n + 3] = a04.w;
                        kka[4 * n] = kk4.x; kka[4 * n + 1] = kk4.y; kka[4 * n + 2] = kk4.z; kka[4 * n + 3] = kk4.w;
                        kaa[4 * n] = ka4.x; kaa[4 * n + 1] = ka4.y; kaa[4 * n + 2] = ka4.z; kaa[4 * n + 3] = ka4.w;
                    }
                    float e2[2][8];
    #pragma unroll
                    for (int m = 0; m < 2; ++m) {
                        const int tok = (mh * 2 + m) * 16 + fr;
                        const size_t t = (size_t)t0 + tok;
                        const float rs = RS[tok * 4 + (ch0 >> 6)];
                        float e[8], kkv[8], zb[8], km[8], gg[8];
    #pragma unroll
                        for (int n = 0; n < 2; ++n)
    #pragma unroll
                            for (int r = 0; r < 4; ++r) {
                                const int q = 4 * n + r;
                                const float zw = w0a[q] + aw[m][n][r];
                                const float wlog = -softplusf_(-zw) - 0.5f;
                                e[q] = -fexp_(wlog);
                                const float a = sigmoidf_(a0a[q] + aa[m][n][r]);
                                const float kv = Kf[tok * 256 + ch0 + q];
                                kkv[q] = kv * kka[q] * rs;
                                km[q] = kv * (1.0f + (a - 1.0f) * kaa[q]);
                                zb[q] = kkv[q] * a;
                                gg[q] = ag[m][n][r];
                            }
    #pragma unroll
                        for (int q = 0; q < 8; ++q) e2[m][q] = e[q];
                        if (SKIPST) { if (e[0] + kkv[1] + zb[2] + km[3] + gg[0] == 123.456f) RS[0] = 1.f; continue; }
                        *(u32x4*)(RW_KK + t * 256 + ch0) = pack8(kkv);
                        *(u32x4*)(RW_ZB + t * 256 + ch0) = pack8(zb);
                        *(u32x4*)(RW_KM + t * 256 + ch0) = pack8(km);
                        *(u32x4*)(RW_G + t * 256 + ch0) = pack8(gg);
                    }
                    if (!SKIPST) {
    #pragma unroll
                        for (int q = 0; q < 8; ++q) {
                            float x0 = e2[0][q], x1 = e2[1][q];
                            const float tot0 = rowsum16(x0);
                            x0 += dpp_f<0x111>(x0); x0 += dpp_f<0x112>(x0); x0 += dpp_f<0x114>(x0); x0 += dpp_f<0x118>(x0);
                            x1 += dpp_f<0x111>(x1); x1 += dpp_f<0x112>(x1); x1 += dpp_f<0x114>(x1); x1 += dpp_f<0x118>(x1);
                            e2[0][q] = x0; e2[1][q] = x1 + tot0;
                        }
    #pragma unroll
                        for (int m = 0; m < 2; ++m) {
                            float* cp = RW_CE + ((size_t)t0 + (mh * 2 + m) * 16 + fr) * 256 + ch0;
                            *(float4*)cp = make_float4(fexp_(e2[m][0]), fexp_(e2[m][1]), fexp_(e2[m][2]), fexp_(e2[m][3])); *(float4*)(cp + 4) = make_float4(fexp_(e2[m][4]), fexp_(e2[m][5]), fexp_(e2[m][6]), fexp_(e2[m][7]));
                        }
                    }
                }
                }
            }
            lds_barrier();
        }
}

__device__ __forceinline__ void ph_conv(const Params& p, const int l_in, const int b_first, const int b_count) {
    extern __shared__ __attribute__((aligned(16))) char smem[];
    int tid_ = threadIdx.x; asm volatile("" : "+v"(tid_));
    int blk_ = blockIdx.x; asm volatile("" : "+s"(blk_));
    unsigned long long w64_ = (unsigned long long)p.ws; asm volatile("" : "+s"(w64_));
    char* ws_ = (char*)(__attribute__((address_space(1))) char*)w64_;
    int l_ = l_in; asm volatile("" : "+v"(l_)); const int l = __builtin_amdgcn_readfirstlane(l_);
    const int tid = tid_, lane = tid & 63, w = tid >> 6;
    int grid_ = gridDim.x; asm volatile("" : "+s"(grid_));
    const int blk = blk_, grid = grid_;
    const int fr = lane & 15, fq = lane >> 4;
    char* const ws = ws_;
    const float* const modl = MOD + (size_t)l * 8 * 6144;
    (void)lane; (void)w; (void)fr; (void)fq; (void)modl; (void)smem; (void)blk; (void)grid;
        const float* cw = INP(16) + l * 3 * 256;
        for (int item = b_first * 512 + tid; item < T_TOK * 32; item += b_count * 512) {
            const size_t t = (size_t)(item >> 5); const int c8 = (item & 31) * 8;
            const int pos = (int)(t & (SEQ - 1));
            const bf16_t* pr = Pb + t * PW;
            float acc[8];
    #pragma unroll
            for (int i = 0; i < 8; ++i) acc[i] = 0.f;
            u32x4 ra[3], rb[3];
    #pragma unroll
            for (int k = 0; k < 3; ++k) {
                const int back = (pos >= 2 - k) ? 2 - k : 0;
                ra[k] = *(const u32x4*)(pr - (size_t)back * PW + PC_CC + c8);
                rb[k] = *(const u32x4*)(pr - (size_t)back * PW + PC_CH + c8);
            }
            const u32x4 rg = *(const u32x4*)(pr + PC_CB + c8);
    #pragma unroll
            for (int k = 0; k < 3; ++k) {
                const float msk = (pos >= 2 - k) ? 1.f : 0.f;
                float a[8], b[8];
                unpack8(ra[k], a); unpack8(rb[k], b);
                const float4 w0 = *(const float4*)(cw + k * 256 + c8), w1 = *(const float4*)(cw + k * 256 + c8 + 4);
                const float ww[8] = {w0.x * msk, w0.y * msk, w0.z * msk, w0.w * msk, w1.x * msk, w1.y * msk, w1.z * msk, w1.w * msk};
    #pragma unroll
                for (int i = 0; i < 8; ++i) acc[i] += ww[i] * a[i] * b[i];
            }
            float g[8]; unpack8(rg, g);
    #pragma unroll
            for (int i = 0; i < 8; ++i) acc[i] *= g[i];
            *(u32x4*)(MIX + t * 1024 + 512 + c8) = pack8(acc);
        }
}

__device__ __forceinline__ void ph_sgu(const Params& p, const int l_in, const int b_first, const int b_count) {
    extern __shared__ __attribute__((aligned(16))) char smem[];
    int tid_ = threadIdx.x; asm volatile("" : "+v"(tid_));
    int blk_ = blockIdx.x; asm volatile("" : "+s"(blk_));
    unsigned long long w64_ = (unsigned long long)p.ws; asm volatile("" : "+s"(w64_));
    char* ws_ = (char*)(__attribute__((address_space(1))) char*)w64_;
    int l_ = l_in; asm volatile("" : "+v"(l_)); const int l = __builtin_amdgcn_readfirstlane(l_);
    const int tid = tid_, lane = tid & 63, w = tid >> 6;
    int grid_ = gridDim.x; asm volatile("" : "+s"(grid_));
    const int blk = blk_, grid = grid_;
    const int fr = lane & 15, fq = lane >> 4;
    char* const ws = ws_;
    const float* const modl = MOD + (size_t)l * 8 * 6144;
    (void)lane; (void)w; (void)fr; (void)fq; (void)modl; (void)smem; (void)blk; (void)grid;
        bf16_t* VT = (bf16_t*)smem;
        const float* lng = INP(12) + l * 256; const float* lnb = INP(13) + l * 256;
        const float* sb = INP(15) + (size_t)l * 4 * 128;
        for (int ci = b_first; ci < 512; ci += b_count) {
            const size_t t0 = (size_t)ci * 128;
            {
                const float4 g4 = *(const float4*)(lng + lane * 4), b4 = *(const float4*)(lnb + lane * 4);
                u32x2 raws[16];
    #pragma unroll
                for (int i = 0; i < 16; ++i) raws[i] = *(const u32x2*)(Pb + (t0 + w * 16 + i) * PW + PC_SV + lane * 4);
    #pragma unroll
                for (int i = 0; i < 16; ++i) {
                    const int s = w * 16 + i;
                    const u32x2 raw = raws[i];
                    float g[4] = {geluf_(bflo(raw.x)), geluf_(bfhi(raw.x)), geluf_(bflo(raw.y)), geluf_(bfhi(raw.y))};
                    const float mean = wave_sum(g[0] + g[1] + g[2] + g[3]) * (1.0f / 256.0f);
                    float d[4] = {g[0] - mean, g[1] - mean, g[2] - mean, g[3] - mean};
                    const float var = wave_sum(d[0] * d[0] + d[1] * d[1] + d[2] * d[2] + d[3] * d[3]) * (1.0f / 256.0f);
                    const float rs = rsqrtf(var + 1e-5f);
                    VT[(lane * 4 + 0) * 136 + s] = f2bf(d[0] * rs * g4.x + b4.x);
                    VT[(lane * 4 + 1) * 136 + s] = f2bf(d[1] * rs * g4.y + b4.y);
                    VT[(lane * 4 + 2) * 136 + s] = f2bf(d[2] * rs * g4.z + b4.z);
                    VT[(lane * 4 + 3) * 136 + s] = f2bf(d[3] * rs * g4.w + b4.w);
                }
            }
            lds_barrier();
            {
                const int hd = w >> 1;
                const bf16_t* Wh = SGUW + ((size_t)(l * 4 + hd)) * 128 * 128;
                u32x2 rawu[8][2];
    #pragma unroll
                for (int m = 0; m < 8; ++m)
    #pragma unroll
                    for (int n = 0; n < 2; ++n) rawu[m][n] = *(const u32x2*)(Pb + (t0 + m * 16 + fr) * PW + PC_SU + w * 32 + n * 16 + fq * 4);
                f32x4 acc[8][2];
    #pragma unroll
                for (int m = 0; m < 8; ++m) { acc[m][0] = (f32x4){0.f, 0.f, 0.f, 0.f}; acc[m][1] = acc[m][0]; }
    #pragma unroll
                for (int ks = 0; ks < 4; ++ks) {
                    const bf16x8 a0 = ld_frag(VT + (w * 32 + fr) * 136 + ks * 32 + fq * 8);
                    const bf16x8 a1 = ld_frag(VT + (w * 32 + 16 + fr) * 136 + ks * 32 + fq * 8);
    #pragma unroll
                    for (int m = 0; m < 8; ++m) {
                        if (ks <= (m >> 1)) {
                            const bf16x8 bw = ld_frag(Wh + (size_t)(m * 16 + fr) * 128 + ks * 32 + fq * 8);
                            acc[m][0] = mfma16(a0, bw, acc[m][0]); acc[m][1] = mfma16(a1, bw, acc[m][1]);
                        }
                    }
                }
    #pragma unroll
                for (int m = 0; m < 8; ++m) {
                    const int tok = m * 16 + fr;
                    const float bias = sb[hd * 128 + tok];
    #pragma unroll
                    for (int n = 0; n < 2; ++n) {
                        const int ch0 = w * 32 + n * 16 + fq * 4;
                        const u32x2 raw = rawu[m][n];
                        u32x2 o;
                        o.x = pk2(geluf_(bflo(raw.x)) * (acc[m][n][0] + bias), geluf_(bfhi(raw.x)) * (acc[m][n][1] + bias));
                        o.y = pk2(geluf_(bflo(raw.y)) * (acc[m][n][2] + bias), geluf_(bfhi(raw.y)) * (acc[m][n][3] + bias));
                        *(u32x2*)(MIX + (t0 + tok) * 1024 + 256 + ch0) = o;
                    }
                }
            }
            lds_barrier();
        }
}

template <int SKIP = 0  >
__device__ __forceinline__ void ph_gdn1(const Params& p, const int l_in, const int u_first, const int u_stride, const int u_end) {
    extern __shared__ __attribute__((aligned(16))) char smem[];
    int tid_ = threadIdx.x; asm volatile("" : "+v"(tid_));
    int blk_ = blockIdx.x; asm volatile("" : "+s"(blk_));
    unsigned long long w64_ = (unsigned long long)p.ws; asm volatile("" : "+s"(w64_));
    char* ws_ = (char*)(__attribute__((address_space(1))) char*)w64_;
    int l_ = l_in; asm volatile("" : "+v"(l_)); const int l = __builtin_amdgcn_readfirstlane(l_);
    const int tid = tid_, lane = tid & 63, w = tid >> 6;
    int grid_ = gridDim.x; asm volatile("" : "+s"(grid_));
    const int blk = blk_, grid = grid_;
    const int fr = lane & 15, fq = lane >> 4;
    char* const ws = ws_;
    const float* const modl = MOD + (size_t)l * 8 * 6144;
    (void)lane; (void)w; (void)fr; (void)fq; (void)modl; (void)smem; (void)blk; (void)grid;
        bf16_t* Qb = (bf16_t*)(smem);
        bf16_t* Kb = (bf16_t*)(smem + 9216);
        bf16_t* AT = (bf16_t*)(smem + 18432);
        bf16_t* UT = (bf16_t*)(smem + 27648);
        bf16_t* WT = (bf16_t*)(smem + 36864);
        bf16_t* KTT = (bf16_t*)(smem + 46080);
        float* XS = (float*)(smem + 55296);
        bf16_t* AmB = (bf16_t*)(smem + 88064);
        float* Ad = (float*)(smem + 97280);
        float* Tb = (float*)(smem + 101376);
        float* gcs = (float*)(smem + 105472);
        float* beta = gcs + 64; float* eg = gcs + 128; float* graw = gcs + 192;
        float* CW = (float*)(smem + 106496);
        for (int i = tid; i < 4 * 768; i += 512) CW[i] = INP(8)[(size_t)l * 4 * 768 + i];
        const float alog_all[4] = {INP(9)[l * 4 + 0], INP(9)[l * 4 + 1], INP(9)[l * 4 + 2], INP(9)[l * 4 + 3]};
        const float dtb_all[4] = {INP(10)[l * 4 + 0], INP(10)[l * 4 + 1], INP(10)[l * 4 + 2], INP(10)[l * 4 + 3]};
        lds_barrier();
        struct G1In { u32x4 rq[4], rk[4], rv[4]; float ga, gb; };
        auto g1_fetch = [&](int u, int tidx, G1In& x) {
            const int b = u >> 9, hd = (u >> 7) & 3, nch = u & 127;
            const size_t t0 = (size_t)b * SEQ + (size_t)nch * 64;
            const int i = tidx >> 3, sub = tidx & 7;
            const int pos = nch * 64 + i;
            const bf16_t* pr = Pb + (t0 + i) * PW;
    #pragma unroll
            for (int j = 0; j < 4; ++j) {
                const int back = (pos >= 3 - j) ? 3 - j : 0;
                const bf16_t* pp = pr - (size_t)back * PW + hd * 64 + sub * 8;
                x.rq[j] = *(const u32x4*)(pp + PC_Q); x.rk[j] = *(const u32x4*)(pp + PC_K); x.rv[j] = *(const u32x4*)(pp + PC_V);
            }
            x.ga = GAB[(t0 + i) * 8 + hd]; x.gb = GAB[(t0 + i) * 8 + 4 + hd];
        };
        G1In gin;
        if (u_first < u_end) g1_fetch(u_first, tid, gin);
        for (int u = u_first; u < u_end; u += u_stride) {
            int tidu_ = tid; asm volatile("" : "+v"(tidu_));
            const int tid = tidu_, lane = tid & 63, w = tid >> 6, fr = lane & 15, fq = lane >> 4;
            const int b = u >> 9, hd = (u >> 7) & 3, nch = u & 127;
            const size_t t0 = (size_t)b * SEQ + (size_t)nch * 64;
            {
                const int i = tid >> 3, sub = tid & 7;
                const int pos = nch * 64 + i;
                const bf16_t* pr = Pb + (t0 + i) * PW;
                float q[8], k[8], v[8];
    #pragma unroll
                for (int e = 0; e < 8; ++e) { q[e] = 0.f; k[e] = 0.f; v[e] = 0.f; }
                const float ga_raw = gin.ga, gb_raw = gin.gb;
    #pragma unroll
                for (int j = 0; j < 4; ++j) {
                    const float msk = (pos >= 3 - j && !(SKIP & 2)) ? 1.f : 0.f;
                    float a[8], bb[8], c[8];
                    unpack8(gin.rq[j], a); unpack8(gin.rk[j], bb); unpack8(gin.rv[j], c);
                    const float* wq = CW + j * 768 + hd * 64 + sub * 8;
                    const float4 q0 = *(const float4*)(wq), q1 = *(const float4*)(wq + 4);
                    const float4 k0 = *(const float4*)(wq + 256), k1 = *(const float4*)(wq + 260);
                    const float4 v0 = *(const float4*)(wq + 512), v1 = *(const float4*)(wq + 516);
                    const float wqa[8] = {q0.x, q0.y, q0.z, q0.w, q1.x, q1.y, q1.z, q1.w};
                    const float wka[8] = {k0.x, k0.y, k0.z, k0.w, k1.x, k1.y, k1.z, k1.w};
                    const float wva[8] = {v0.x, v0.y, v0.z, v0.w, v1.x, v1.y, v1.z, v1.w};
    #pragma unroll
                    for (int e = 0; e < 8; ++e) { q[e] += msk * wqa[e] * a[e]; k[e] += msk * wka[e] * bb[e]; v[e] += msk * wva[e] * c[e]; }
                }
                if (u + u_stride < u_end) g1_fetch(u + u_stride, tid, gin);
                float sq = 0.f, sk = 0.f;
    #pragma unroll
                for (int e = 0; e < 8; ++e) { q[e] = siluf_(q[e]); k[e] = siluf_(k[e]); v[e] = siluf_(v[e]); sq += q[e] * q[e]; sk += k[e] * k[e]; }
                sq += dpp_f<0xB1>(sq); sq += dpp_f<0x4E>(sq); sq += dpp_f<0x141>(sq);
                sk += dpp_f<0xB1>(sk); sk += dpp_f<0x4E>(sk); sk += dpp_f<0x141>(sk);
                const float rq = rsqrtf(sq + 1e-6f) * 0.125f, rk = rsqrtf(sk + 1e-6f);
    #pragma unroll
                for (int e = 0; e < 8; ++e) { q[e] *= rq; k[e] *= rk; }
                *(u32x4*)(Qb + i * 72 + sub * 8) = pack8(q);
                *(u32x4*)(Kb + i * 72 + sub * 8) = pack8(k);
                *(float4*)(XS + i * 128 + 64 + sub * 8) = make_float4(k[0], k[1], k[2], k[3]); *(float4*)(XS + i * 128 + 64 + sub * 8 + 4) = make_float4(k[4], k[5], k[6], k[7]);
                *(float4*)(XS + i * 128 + sub * 8) = make_float4(v[0], v[1], v[2], v[3]); *(float4*)(XS + i * 128 + sub * 8 + 4) = make_float4(v[4], v[5], v[6], v[7]);
                if (sub == 0) {
                    const float a = ga_raw, bb = gb_raw;
                    const float alg = hd == 0 ? alog_all[0] : hd == 1 ? alog_all[1] : hd == 2 ? alog_all[2] : alog_all[3];
                    const float dtb = hd == 0 ? dtb_all[0] : hd == 1 ? dtb_all[1] : hd == 2 ? dtb_all[2] : dtb_all[3];
                    graw[i] = -fexp_(alg) * softplusf_(a + dtb);
                    beta[i] = sigmoidf_(bb);
                }
            }
            lds_barrier();
            if (w == 0) {
                float g = graw[lane];
                g += dpp_f<0x111>(g); g += dpp_f<0x112>(g); g += dpp_f<0x114>(g); g += dpp_f<0x118>(g);
                const int gi_ = __float_as_int(g);
                const float t0_ = __int_as_float(__builtin_amdgcn_readlane(gi_, 15)), t1_ = __int_as_float(__builtin_amdgcn_readlane(gi_, 31)), t2_ = __int_as_float(__builtin_amdgcn_readlane(gi_, 47));
                g += (lane >= 48) ? (t0_ + t1_ + t2_) : (lane >= 32) ? (t0_ + t1_) : (lane >= 16) ? t0_ : 0.f;
                gcs[lane] = g; eg[lane] = fexp_(g);
            }
            lds_barrier();
            {
    #pragma unroll
                for (int q2 = 0; q2 < 2; ++q2) {
                    const int ti = w * 2 + q2, mt = ti >> 2, nt = ti & 3;
                    f32x4 ckk = (f32x4){0.f, 0.f, 0.f, 0.f}, cqk = ckk;
                    if (nt <= mt) {
    #pragma unroll
                        for (int ks = 0; ks < 2; ++ks) {
                            const bf16x8 fk = ld_frag(Kb + (mt * 16 + fr) * 72 + ks * 32 + fq * 8);
                            const bf16x8 fqv = ld_frag(Qb + (mt * 16 + fr) * 72 + ks * 32 + fq * 8);
                            const bf16x8 fb = ld_frag(Kb + (nt * 16 + fr) * 72 + ks * 32 + fq * 8);
                            ckk = mfma16(fk, fb, ckk); cqk = mfma16(fqv, fb, cqk);
                        }
                    }
                    const int jj = nt * 16 + fr;
                    const float gj = gcs[jj];
    #pragma unroll
                    for (int r = 0; r < 4; ++r) {
                        const int ii = mt * 16 + fq * 4 + r;
                        const float dec = (ii >= jj) ? fexp_(gcs[ii] - gj) : 0.f;
                        const float aval = (ii > jj) ? beta[ii] * ckk[r] * dec : 0.f;
                        AmB[ii * 72 + jj] = f2bf(-aval);
                        if (mt == nt) Ad[mt * 256 + (ii & 15) * 16 + (jj & 15)] = aval;
                        AT[ii * 72 + jj] = f2bf((ii >= jj) ? cqk[r] * dec : 0.f);
                    }
                }
            }
            lds_barrier();
            if (w == 0) {
                const int b = lane >> 4, c = lane & 15;
                const float* ad = Ad + b * 256;
                float x[16];
    #pragma unroll
                for (int i = 0; i < 16; ++i) {
                    float a = (i == c) ? 1.f : 0.f;
    #pragma unroll
                    for (int j = 0; j < i; ++j) a -= ad[i * 16 + j] * x[j];
                    x[i] = a;
                }
    #pragma unroll
                for (int i = 0; i < 16; ++i) Tb[b * 256 + i * 16 + c] = x[i];
            } else {
                const float glast = gcs[63];
                for (int idx = tid - 64; idx < 4096; idx += 448) {
                    const int d = idx & 63, j = idx >> 6;
                    KTT[d * 72 + j] = f2bf(bf2f(Kb[j * 72 + d]) * fexp_(glast - gcs[j]));
                }
                if (tid == 64) __hip_atomic_store(&GCD[u], fexp_(glast), __ATOMIC_RELAXED, __HIP_MEMORY_SCOPE_AGENT);
            }
            lds_barrier();
            if (!(SKIP & 1)) {
                const int cidx = w * 16 + fr;
                bf16_t* xt = (cidx < 64) ? (UT + cidx * 72) : (WT + (cidx - 64) * 72);
                const bf16x8 zf = {0, 0, 0, 0, 0, 0, 0, 0};
    #pragma unroll
                for (int b = 0; b < 4; ++b) {
                    f32x4 G;
    #pragma unroll
                    for (int r = 0; r < 4; ++r) { const int i = b * 16 + fq * 4 + r; float v = beta[i] * XS[i * 128 + cidx]; if (cidx >= 64) v *= eg[i]; G[r] = v; }
    #pragma unroll
                    for (int ks = 0; ks < (b + 1) / 2; ++ks) {
                        const int k0 = ks * 32 + fq * 8;
                        const bool ok = k0 < b * 16;
                        const bf16x8 af = ok ? ld_frag(AmB + (b * 16 + fr) * 72 + k0) : zf;
                        const bf16x8 bfv = ok ? ld_frag(xt + k0) : zf;
                        G = mfma16(af, bfv, G);
                    }
                    f32x4 X = (f32x4){0.f, 0.f, 0.f, 0.f};
    #pragma unroll
                    for (int ks = 0; ks < 4; ++ks) X = __builtin_amdgcn_mfma_f32_16x16x4f32(Tb[b * 256 + fr * 16 + fq * 4 + ks], G[ks], X, 0, 0, 0);
                    u32x2 o; o.x = pk2(X[0], X[1]); o.y = pk2(X[2], X[3]);
                    *(u32x2*)(xt + b * 16 + fq * 4) = o;
                }
            }
            lds_barrier();
            if (!(SKIP & 4)) {
                bf16_t* ub = Hb + (size_t)gdn_slot(u) * 16384;
                const int prod = w >> 1, half = w & 1;
                const bf16_t* Xs = (prod == 0 || prod == 2) ? KTT : AT;
                const bf16_t* Ys = (prod == 0 || prod == 1) ? WT : UT;
                f32x4 acc[2][4];
    #pragma unroll
                for (int m = 0; m < 2; ++m)
    #pragma unroll
                    for (int n = 0; n < 4; ++n) acc[m][n] = (f32x4){0.f, 0.f, 0.f, 0.f};
    #pragma unroll
                for (int ks = 0; ks < 2; ++ks) {
                    bf16x8 fx[2], fy[4];
    #pragma unroll
                    for (int m = 0; m < 2; ++m) fx[m] = ld_frag(Xs + ((half * 2 + m) * 16 + fr) * 72 + ks * 32 + fq * 8);
    #pragma unroll
                    for (int n = 0; n < 4; ++n) fy[n] = ld_frag(Ys + (n * 16 + fr) * 72 + ks * 32 + fq * 8);
                    if (prod != 2) {
    #pragma unroll
                        for (int m = 0; m < 2; ++m)
    #pragma unroll
                            for (int n = 0; n < 4; ++n) acc[m][n] = mfma16(fy[n], fx[m], acc[m][n]);
                    } else {
    #pragma unroll
                        for (int m = 0; m < 2; ++m)
    #pragma unroll
                            for (int n = 0; n < 4; ++n) acc[m][n] = mfma16(fx[m], fy[n], acc[m][n]);
                    }
                }
    #pragma unroll
                for (int m = 0; m < 2; ++m) {
                    const int mt = half * 2 + m;
    #pragma unroll
                    for (int n = 0; n < 4; ++n) {
                        u32x2 o;
                        if (prod == 0) {
                            o.x = pk2(-acc[m][n][0], -acc[m][n][1]); o.y = pk2(-acc[m][n][2], -acc[m][n][3]);
                            *(u32x2*)(ub + (mt * 2 + (n >> 1)) * 512 + lane * 8 + (n & 1) * 4) = o;
                        } else if (prod == 1) {
                            const int ii = mt * 16 + fr; const float e = eg[ii];
                            const u32x2 qv = *(const u32x2*)(Qb + ii * 72 + n * 16 + fq * 4);
                            o.x = pk2(bflo(qv.x) * e - acc[m][n][0], bfhi(qv.x) * e - acc[m][n][1]); o.y = pk2(bflo(qv.y) * e - acc[m][n][2], bfhi(qv.y) * e - acc[m][n][3]);
                            *(u32x2*)(ub + 4096 + (mt * 2 + (n >> 1)) * 512 + lane * 8 + (n & 1) * 4) = o;
                        } else if (prod == 2) {
                            o.x = pk2(acc[m][n][0], acc[m][n][1]); o.y = pk2(acc[m][n][2], acc[m][n][3]);
                            *(u32x2*)(ub + 8192 + (n * 2 + (mt >> 1)) * 512 + lane * 8 + (mt & 1) * 4) = o;
                        } else {
                            o.x = pk2(acc[m][n][0], acc[m][n][1]); o.y = pk2(acc[m][n][2], acc[m][n][3]);
                            *(u32x2*)(ub + 12288 + (n * 2 + (mt >> 1)) * 512 + lane * 8 + (mt & 1) * 4) = o;
                        }
                    }
                }
            }
            lds_barrier();
        }
}

template <int MODE  >
__device__ __forceinline__ void ph_scan(const Params& p, const int l_in) {
    extern __shared__ __attribute__((aligned(16))) char smem[];
    int tid_ = threadIdx.x; asm volatile("" : "+v"(tid_));
    int blk_ = blockIdx.x; asm volatile("" : "+s"(blk_));
    unsigned long long w64_ = (unsigned long long)p.ws; asm volatile("" : "+s"(w64_));
    char* ws_ = (char*)(__attribute__((address_space(1))) char*)w64_;
    int l_ = l_in; asm volatile("" : "+v"(l_)); const int l = __builtin_amdgcn_readfirstlane(l_);
    const int tid = tid_, lane = tid & 63, w = tid >> 6;
    int grid_ = gridDim.x; asm volatile("" : "+s"(grid_));
    const int blk = blk_, grid = grid_;
    const int fr = lane & 15, fq = lane >> 4;
    char* const ws = ws_;
    const float* const modl = MOD + (size_t)l * 8 * 6144;
    (void)lane; (void)w; (void)fr; (void)fq; (void)modl; (void)smem; (void)blk; (void)grid;
        unsigned* const late_cnt = (unsigned*)(ws + OFF_CNT) + 1024 + l * 64;
        if (blk >= 128 && MODE == 0 && grid == 256) {
            ph_rwprep(p, l, 1, blk - 128, 128);
            asm volatile("s_waitcnt vmcnt(0)" ::: "memory");
            __syncthreads();
            if (tid == 0) {
                __builtin_amdgcn_fence(__ATOMIC_RELEASE, "agent");
                asm volatile("s_waitcnt vmcnt(0)" ::: "memory");
                __hip_atomic_fetch_add(late_cnt, 1u, __ATOMIC_RELAXED, __HIP_MEMORY_SCOPE_AGENT);
            }
        }
        if (blk >= 128 && !DBG_NO_GDN && MODE != 1 && MODE < 8) {
            if (MODE != 3 && MODE != 5) { ph_conv(p, l, blk - 128, grid - 128); ph_sgu(p, l, blk - 128, grid - 128); }
            if (MODE != 4) ph_gdn1(p, l, GDN_U1 + blk - 128, grid - 128, 4096);
            unsigned* sb = (unsigned*)(ws + OFF_CNT) + l * 64;
            asm volatile("s_waitcnt vmcnt(0)" ::: "memory");
            __syncthreads();
            if (tid == 0) {
                __builtin_amdgcn_fence(__ATOMIC_RELEASE, "agent");
                asm volatile("s_waitcnt vmcnt(0)" ::: "memory");
                __hip_atomic_fetch_add(sb, 1u, __ATOMIC_RELAXED, __HIP_MEMORY_SCOPE_AGENT);
                if (blk < 160) {
                    unsigned sp = 0;
                    while (__hip_atomic_load(sb, __ATOMIC_RELAXED, __HIP_MEMORY_SCOPE_AGENT) < (unsigned)(grid - 128)) { __builtin_amdgcn_s_sleep(2); if (++sp > (1u << 24)) break; }
                    __builtin_amdgcn_fence(__ATOMIC_ACQUIRE, "agent");
                    asm volatile("s_waitcnt vmcnt(0)" ::: "memory");
                }
            }
            __syncthreads();
        }
        for (int role = blk; role < 160; role += grid) {
            if (role < 128) {
                if (DBG_NO_RWKV || DBG_RWKV_NOSCAN || MODE >= 2) continue;
                const int bh = role >> 2, rg = role & 3, b = bh >> 2, hd = bh & 3;
                const size_t tb = (size_t)b * SEQ;
                constexpr int SST = 340;
                float* ybuf = (float*)smem;
                float* tilebuf = ybuf + 2 * 8192;
                static_assert(2 * 33 * SST * 4 + 2 * 8192 * 4 <= LDS_XB_OFF, "RWKV scan LDS image overlaps the grid barrier's LDS words");
                f32x2 sA = {0.f, 0.f}, sB = {0.f, 0.f}; float dcur = 0.f;
                const int kq = lane & 15, rsub = lane >> 4;
                int li = tid - 256;
                struct LT { float4 c0, c1; u32x4 kraw, zraw, mraw, rraw; unsigned vv; };
                auto fetch_tile = [&](int tt_, LT& x) {
                    const int tt = tt_ < 256 ? tt_ : 255;
                    const int s = li >> 3, part = li & 7;
                    const size_t tbase = (tb + (size_t)tt * 32) * 256;
                    const unsigned vo16 = (unsigned)((s * 256 + hd * 64 + part * 8) * 2), vo32 = vo16 * 2u, vov = (unsigned)((s * 256 + hd * 64 + rg * 16 + part * 2) * 2);
                    x.c0 = *(const float4*)((const char*)(RW_CE + tbase) + vo32); x.c1 = *(const float4*)((const char*)(RW_CE + tbase + 4) + vo32);
                    x.kraw = *(const u32x4*)((const char*)(RW_KK + tbase + 256) + vo16);
                    x.zraw = *(const u32x4*)((const char*)(RW_ZB + tbase) + vo16); x.mraw = *(const u32x4*)((const char*)(RW_KM + tbase) + vo16); x.rraw = *(const u32x4*)((const char*)(RW_R + tbase) + vo16);
                    x.vv = *(const unsigned*)((const char*)(RW_V + tbase) + vov);
                };
                auto commit_tile = [&](int tt, int buf, const LT& x) {
                    const int s = li >> 3, part = li & 7;
                    const int pos = tt * 32 + s;
                    float* dst = tilebuf + (size_t)buf * (33 * SST) + s * SST;
                    const float4 c0 = x.c0, c1 = x.c1;
                    u32x4 kraw = x.kraw;
                    if (!(pos + 1 < SEQ)) kraw = (u32x4){0u, 0u, 0u, 0u};
                    const u32x4 zraw = x.zraw, mraw = x.mraw, rraw = x.rraw;
                    const unsigned vv = x.vv;
                    const float ce[8] = {c0.x, c0.y, c0.z, c0.w, c1.x, c1.y, c1.z, c1.w};
                    float P[8], kn[8], f[8], o[8];
    #pragma unroll
                    for (int i = 0; i < 8; ++i) P[i] = ce[i];
                    unpack8(kraw, kn);
    #pragma unroll
                    for (int i = 0; i < 8; ++i) o[i] = P[i] * kn[i];
                    *(float4*)(dst + part * 8) = make_float4(o[0], o[1], o[2], o[3]); *(float4*)(dst + part * 8 + 4) = make_float4(o[4], o[5], o[6], o[7]);
                    unpack8(rraw, f);
    #pragma unroll
                    for (int i = 0; i < 8; ++i) o[i] = f[i] * P[i];
                    *(float4*)(dst + 192 + part * 8) = make_float4(o[0], o[1], o[2], o[3]); *(float4*)(dst + 192 + part * 8 + 4) = make_float4(o[4], o[5], o[6], o[7]);
                    if (s == 31) { float* pl = tilebuf + (size_t)buf * (33 * SST) + 32 * SST + part * 8;
                        *(float4*)pl = make_float4(P[0], P[1], P[2], P[3]); *(float4*)(pl + 4) = make_float4(P[4], P[5], P[6], P[7]); }
    #pragma unroll
                    for (int i = 0; i < 8; ++i) P[i] = rcpf_(ce[i]);
                    float al = 0.f, be = 0.f;
                    unpack8(zraw, f);
    #pragma unroll
                    for (int i = 0; i < 8; ++i) { al += f[i] * kn[i]; o[i] = f[i] * P[i]; }
                    *(float4*)(dst + 64 + part * 8) = make_float4(o[0], o[1], o[2], o[3]); *(float4*)(dst + 64 + part * 8 + 4) = make_float4(o[4], o[5], o[6], o[7]);
                    unpack8(mraw, f);
    #pragma unroll
                    for (int i = 0; i < 8; ++i) { be += f[i] * kn[i]; o[i] = f[i] * P[i]; }
                    *(float4*)(dst + 128 + part * 8) = make_float4(o[0], o[1], o[2], o[3]); *(float4*)(dst + 128 + part * 8 + 4) = make_float4(o[4], o[5], o[6], o[7]);
                    al += __shfl_xor(al, 1); al += __shfl_xor(al, 2); al += __shfl_xor(al, 4);
                    be += __shfl_xor(be, 1); be += __shfl_xor(be, 2); be += __shfl_xor(be, 4);
                    {
                        const float v0 = bflo(vv), v1 = bfhi(vv);
                        *(float4*)(dst + 256 + part * 8) = make_float4(v0, al, v0 * be * (1.0f / 32.0f), 0.f);
                        *(float4*)(dst + 256 + part * 8 + 4) = make_float4(v1, al, v1 * be * (1.0f / 32.0f), 0.f);
                    }
                };
                auto flush_y = [&](int tt, int buf) {
                    const int s = li >> 3, part = li & 7;
                    const float* yb = ybuf + buf * 8192 + s * 256 + part * 32;
                    float y2[2];
    #pragma unroll
                    for (int r = 0; r < 2; ++r) {
                        const float4 a = *(const float4*)(yb + r * 16), b4 = *(const float4*)(yb + r * 16 + 4), c4 = *(const float4*)(yb + r * 16 + 8), d4 = *(const float4*)(yb + r * 16 + 12);
                        y2[r] = ((a.x + a.y) + (a.z + a.w)) + ((b4.x + b4.y) + (b4.z + b4.w)) + ((c4.x + c4.y) + (c4.z + c4.w)) + ((d4.x + d4.y) + (d4.z + d4.w));
                    }
                    *(unsigned*)((char*)(YR + ((size_t)(bh * 4 + rg) * SEQ + (size_t)tt * 32) * 16) + (unsigned)((s * 16 + part * 2) * 2)) = pk2(y2[0], y2[1]);
                };
                LT R0;
                if (w >= 4) { fetch_tile(0, R0); commit_tile(0, 0, R0); fetch_tile(1, R0); }
                lds_barrier();
                if (w < 4) __builtin_amdgcn_s_setprio(3);
                for (int tt = 0; tt < 256; ++tt) {
                    const int buf = tt & 1;
                    if (w >= 4) {
                        asm volatile("" : "+v"(li));
                        if (MODE == 0 && grid == 256 && tt == 2 * RW_EARLY - 4) {
                            unsigned sp = 0;
                            while (__hip_atomic_load(late_cnt, __ATOMIC_RELAXED, __HIP_MEMORY_SCOPE_AGENT) < 128u) { __builtin_amdgcn_s_sleep(2); if (++sp > (1u << 24)) break; }
                            __builtin_amdgcn_fence(__ATOMIC_ACQUIRE, "agent");
                        }
                        if (tt + 1 < 256) commit_tile(tt + 1, buf ^ 1, R0);
                        fetch_tile(tt + 2, R0);
                        if (tt > 0) flush_y(tt - 1, buf ^ 1);
                    } else {
                        const int lr = w * 4 + rsub;
                        int o_vec = (2 * 8192 + buf * (33 * SST) + kq * 4) * 4, o_rec = (2 * 8192 + buf * (33 * SST) + 256 + lr * 4) * 4, o_y = (buf * 8192 + lr * 16 + kq) * 4;
                        asm volatile("" : "+v"(o_vec), "+v"(o_rec), "+v"(o_y));
                        const float* tv = (const float*)(smem + o_vec); const float* trc = (const float*)(smem + o_rec); float* yb = (float*)(smem + o_y);
                        float4 cu = *(const float4*)(tv), czb = *(const float4*)(tv + 64), ckm = *(const float4*)(tv + 128), cr = *(const float4*)(tv + 192);
                        typedef float f32x3_t __attribute__((ext_vector_type(3)));
                        f32x3_t crec = *(const f32x3_t*)(trc);
    #pragma unroll 8
                        for (int s = 0; s < 32; ++s) {
                            const int sn = ((s + 1) & 31) * SST;
                            const float4 nu = *(const float4*)(tv + sn), nzb = *(const float4*)(tv + sn + 64), nkm = *(const float4*)(tv + sn + 128), nr = *(const float4*)(tv + sn + 192);
                            const f32x3_t nrec = *(const f32x3_t*)(trc + sn);
                            __builtin_amdgcn_sched_barrier(0);
                            const f32x2 uA = {cu.x, cu.y}, uB = {cu.z, cu.w}, zA = {czb.x, czb.y}, zB = {czb.z, czb.w}, kA = {ckm.x, ckm.y}, kB = {ckm.z, ckm.w};
                            const f32x2 rA = {cr.x, cr.y}, rB = {cr.z, cr.w};
                            const f32x2 gg = {crec.z, crec.z};
                            const f32x2 ep = sA * uA + (sB * uB + gg);
                            const float e = rowsum16(ep.x + ep.y);
                            const f32x2 nd = {-dcur, -dcur}, vv = {crec.x, crec.x};
                            const f32x2 tA = kA * vv + sA, tB = kB * vv + sB;
                            sA = zA * nd + tA;
                            sB = zB * nd + tB;
                            const f32x2 yp = sA * rA + sB * rB;
                            yb[s * 256] = yp.x + yp.y;
                            dcur = e - dcur * crec.y;
                            cu = nu; czb = nzb; ckm = nkm; cr = nr; crec = nrec;
                            __builtin_amdgcn_sched_barrier(0);
                        }
                        {
                            const float4 pl = *(const float4*)(tv + 32 * SST);
                            const f32x2 pA = {pl.x, pl.y}, pB = {pl.z, pl.w};
                            sA = sA * pA; sB = sB * pB;
                        }
                    }
                    lds_barrier();
                }
                __builtin_amdgcn_s_setprio(0);
                if (w >= 4) flush_y(255, 1);
                lds_barrier();
            } else {
                if (DBG_NO_GDN || MODE == 1 || MODE == 4 || MODE == 5 || MODE == 6) continue;
                const int bh = role - 128, b = bh >> 2, hd = bh & 3;
                {
                    const int c0 = w * 16;
                    const unsigned vM = (unsigned)(fr * 2048 + c0 * 2 + fq * 8);
                    f32x4 S[4];
    #pragma unroll
                    for (int t = 0; t < 4; ++t) S[t] = (f32x4){0.f, 0.f, 0.f, 0.f};
                    const int lw = tid - 256;
                    struct LU { u32x4 d[8]; float cd; };
                    auto fetch = [&](int n, LU& x) {
                        const int u = b * 512 + hd * 128 + (n < 128 ? n : 127);
                        const char* ub = (const char*)Hb + (size_t)gdn_slot(u) * 32768;
    #pragma unroll
                        for (int i = 0; i < 8; ++i) x.d[i] = *(const u32x4*)((ub + i * 4096) + (unsigned)(lw * 16));
                        x.cd = GCD[u];
                    };
                    auto iter = [&](int it, LU& x) {
                        if (w >= 4) {
                            if (it < 128) {
                                char* Ls = smem + (it & 1) * 32768;
    #pragma unroll
                                for (int i = 0; i < 8; ++i) *(u32x4*)(Ls + i * 4096 + lw * 16) = x.d[i];
                                if (lw == 0) *(float*)(smem + 65536 + (it & 1) * 16) = x.cd;
                                fetch(it + 2, x);
                            }
                        } else if (it >= 1 && it <= 128) {
                            const int n = it - 1;
                            const char* Ls = smem + (n & 1) * 32768;
                            const float cd = *(const float*)(smem + 65536 + (n & 1) * 16);
                            u32x4 nq[2], oq[2];
    #pragma unroll
                            for (int pr = 0; pr < 2; ++pr) { nq[pr] = *(const u32x4*)(Ls + 16384 + (w * 2 + pr) * 1024 + lane * 16); oq[pr] = *(const u32x4*)(Ls + 24576 + (w * 2 + pr) * 1024 + lane * 16); }
                            bf16x8 bS[2];
    #pragma unroll
                            for (int ks = 0; ks < 2; ++ks) {
                                u32x4 t4; t4.x = pk2(S[2 * ks][0], S[2 * ks][1]); t4.y = pk2(S[2 * ks][2], S[2 * ks][3]); t4.z = pk2(S[2 * ks + 1][0], S[2 * ks + 1][1]); t4.w = pk2(S[2 * ks + 1][2], S[2 * ks + 1][3]);
                                bS[ks] = __builtin_bit_cast(bf16x8, t4);
                            }
                            const size_t t0 = (size_t)b * SEQ + (size_t)n * 64;
    #pragma unroll
                            for (int mt = 0; mt < 4; ++mt) {
                                const unsigned nlo = (mt & 1) ? nq[mt >> 1].z : nq[mt >> 1].x, nhi = (mt & 1) ? nq[mt >> 1].w : nq[mt >> 1].y;
                                f32x4 sn = (f32x4){cd * S[mt][0] + bflo(nlo), cd * S[mt][1] + bfhi(nlo), cd * S[mt][2] + bflo(nhi), cd * S[mt][3] + bfhi(nhi)};
                                const bf16x8 w0 = *(const bf16x8*)(Ls + (mt * 2 + 0) * 1024 + lane * 16), w1 = *(const bf16x8*)(Ls + (mt * 2 + 1) * 1024 + lane * 16);
                                sn = mfma16(w0, bS[0], sn); sn = mfma16(w1, bS[1], sn);
                                S[mt] = sn;
                            }
    #pragma unroll
                            for (int mt = 0; mt < 4; ++mt) {
                                const unsigned olo = (mt & 1) ? oq[mt >> 1].z : oq[mt >> 1].x, ohi = (mt & 1) ? oq[mt >> 1].w : oq[mt >> 1].y;
                                f32x4 oa = (f32x4){bflo(olo), bfhi(olo), bflo(ohi), bfhi(ohi)};
                                const bf16x8 p0 = *(const bf16x8*)(Ls + 8192 + (mt * 2 + 0) * 1024 + lane * 16), p1 = *(const bf16x8*)(Ls + 8192 + (mt * 2 + 1) * 1024 + lane * 16);
                                oa = mfma16(bS[0], p0, oa); oa = mfma16(bS[1], p1, oa);
                                u32x2 ov; ov.x = pk2(oa[0], oa[1]); ov.y = pk2(oa[2], oa[3]);
                                *(u32x2*)(((char*)MIX + (t0 + mt * 16) * 2048 + hd * 128) + vM) = ov;
                            }
                        }
                        lds_barrier();
                    };
                    LU R0, R1;
                    if (w >= 4) { fetch(0, R0); fetch(1, R1); }
    #pragma unroll 1
                    for (int it = 0; it < 130; it += 2) {
                        iter(it, R0);
                        iter(it + 1, R1);
                    }
                }
                lds_barrier();
            }
        }
        {
            int cw, ncw;
            if (grid > 160) { cw = blk - 160; ncw = grid - 160; } else { cw = blk; ncw = grid; }
            float* tile = (float*)smem;
            if (cw >= 0 && MODE != 1 && MODE != 5 && MODE != 7 && MODE < 8) {
                auto make_job = [&](int idx) {
                    const int which = idx >> 12, rem = idx & 4095, e = rem >> 6, r2 = rem & 63;
                    TrJob j;
                    if (which < 2) { const int kt = r2 >> 2, nt = r2 & 3;
                        j.src = INP(32) + ((size_t)l * 64 + e) * 1024 * 256; if (which == 1) j.src = INP(33) + ((size_t)l * 64 + e) * 1024 * 256;
                        j.ld = 256; j.k0 = kt * 64; j.n0 = nt * 64; j.Ndim = 256; j.dst = WGU + (size_t)e * 512 * 1024; j.dst_ld = 1024; j.mode = 1; j.up = which; }
                    else { const int kt = r2 >> 4, nt = r2 & 15;
                        j.src = INP(34) + ((size_t)l * 64 + e) * 256 * 1024; j.ld = 1024; j.k0 = kt * 64; j.n0 = nt * 64; j.Ndim = 1024; j.dst = WD + (size_t)e * 1024 * 256; j.dst_ld = 256; j.mode = 0; j.up = 0; }
                    return j;
                };
                for (int idx = cw; idx < 12288; idx += 2 * ncw) {
                    const bool haveB = idx + ncw < 12288;
                    const TrJob ja = make_job(idx), jb = make_job(haveB ? idx + ncw : idx);
                    tr_pair(tid, tile, tile + 64 * 65 + 16, ja, jb, haveB);
                }
            }
        }
}

__device__ __forceinline__ void ph_post(const Params& p, const int l_in) {
    extern __shared__ __attribute__((aligned(16))) char smem[];
    int tid_ = threadIdx.x; asm volatile("" : "+v"(tid_));
    int blk_ = blockIdx.x; asm volatile("" : "+s"(blk_));
    unsigned long long w64_ = (unsigned long long)p.ws; asm volatile("" : "+s"(w64_));
    char* ws_ = (char*)(__attribute__((address_space(1))) char*)w64_;
    int l_ = l_in; asm volatile("" : "+v"(l_)); const int l = __builtin_amdgcn_readfirstlane(l_);
    const int tid = tid_, lane = tid & 63, w = tid >> 6;
    int grid_ = gridDim.x; asm volatile("" : "+s"(grid_));
    const int blk = blk_, grid = grid_;
    const int fr = lane & 15, fq = lane >> 4;
    char* const ws = ws_;
    const float* const modl = MOD + (size_t)l * 8 * 6144;
    (void)lane; (void)w; (void)fr; (void)fq; (void)modl; (void)smem; (void)blk; (void)grid;
        const float* ng = INP(11) + l * 64;
        const float* gng = INP(26) + l * 256; const float* gnb = INP(27) + l * 256; const float* rk = INP(25) + l * 256;
        const int ch = lane * 4;
        const float4 ng4 = *(const float4*)(ng + (ch & 63));
        const float4 gg4 = *(const float4*)(gng + ch), gb4 = *(const float4*)(gnb + ch), rk4 = *(const float4*)(rk + ch);
        struct PostIn { u32x2 ov, zv, yv, rv, kv, vv, gv; };
        auto load_in = [&](size_t t) {
            PostIn q;
            q.ov = *(const u32x2*)(MIX + t * 1024 + ch);
            q.zv = *(const u32x2*)(Pb + t * PW + PC_Z + ch);
            q.yv = *(const u32x2*)(YR + ((size_t)(((t >> 13) * 4 + (lane >> 4)) * 4 + ((lane & 15) >> 2)) * SEQ + (t & (SEQ - 1))) * 16 + (lane & 3) * 4);
            q.rv = *(const u32x2*)(RW_R + t * 256 + ch);
            q.kv = *(const u32x2*)(RW_KM + t * 256 + ch);
            q.vv = *(const u32x2*)(RW_V + t * 256 + ch);
            q.gv = *(const u32x2*)(RW_G + t * 256 + ch);
            return q;
        };
        const size_t tstride = (size_t)grid * 8;
        size_t t = (size_t)blk * 8 + w;
        PostIn cur = load_in(t < T_TOK ? t : 0);
        for (; t < T_TOK; t += tstride) {
            const PostIn nxt = load_in(t + tstride < T_TOK ? t + tstride : t);
            {
                const u32x2 ov = cur.ov, zv = cur.zv;
                const float o[4] = {bflo(ov.x), bfhi(ov.x), bflo(ov.y), bfhi(ov.y)};
                const float z[4] = {bflo(zv.x), bfhi(zv.x), bflo(zv.y), bfhi(zv.y)};
                const float ms = rowsum16(o[0] * o[0] + o[1] * o[1] + o[2] * o[2] + o[3] * o[3]) * (1.0f / 64.0f);
                const float rs = rsqrtf(ms + 1e-6f);
                u32x2 r;
                r.x = pk2(o[0] * rs * ng4.x * siluf_(z[0]), o[1] * rs * ng4.y * siluf_(z[1]));
                r.y = pk2(o[2] * rs * ng4.z * siluf_(z[2]), o[3] * rs * ng4.w * siluf_(z[3]));
                *(u32x2*)(MIX + t * 1024 + ch) = r;
            }
            {
                const u32x2 yv = cur.yv, rv = cur.rv, kv = cur.kv, vv = cur.vv, gv = cur.gv;
                const float y[4] = {bflo(yv.x), bfhi(yv.x), bflo(yv.y), bfhi(yv.y)};
                const float mean = rowsum16(y[0] + y[1] + y[2] + y[3]) * (1.0f / 64.0f);
                const float d[4] = {y[0] - mean, y[1] - mean, y[2] - mean, y[3] - mean};
                const float var = rowsum16(d[0] * d[0] + d[1] * d[1] + d[2] * d[2] + d[3] * d[3]) * (1.0f / 64.0f);
                const float rs = rsqrtf(var + 64e-5f);
                const float bon = rowsum16(bflo(rv.x) * bflo(kv.x) * rk4.x + bfhi(rv.x) * bfhi(kv.x) * rk4.y + bflo(rv.y) * bflo(kv.y) * rk4.z + bfhi(rv.y) * bfhi(kv.y) * rk4.w);
                u32x2 r;
                r.x = pk2((d[0] * rs * gg4.x + gb4.x + bon * bflo(vv.x)) * bflo(gv.x), (d[1] * rs * gg4.y + gb4.y + bon * bfhi(vv.x)) * bfhi(gv.x));
                r.y = pk2((d[2] * rs * gg4.z + gb4.z + bon * bflo(vv.y)) * bflo(gv.y), (d[3] * rs * gg4.w + gb4.w + bon * bfhi(vv.y)) * bfhi(gv.y));
                *(u32x2*)(MIX + t * 1024 + 768 + ch) = r;
            }
            cur = nxt;
        }
}

template <int PROBE = 0>
__device__ __forceinline__ void ph_outproj(const Params& p, const int l_in) {
    extern __shared__ __attribute__((aligned(16))) char smem[];
    int tid_ = threadIdx.x; asm volatile("" : "+v"(tid_));
    int blk_ = blockIdx.x; asm volatile("" : "+s"(blk_));
    unsigned long long w64_ = (unsigned long long)p.ws; asm volatile("" : "+s"(w64_));
    char* ws_ = (char*)(__attribute__((address_space(1))) char*)w64_;
    int l_ = l_in; asm volatile("" : "+v"(l_)); const int l = __builtin_amdgcn_readfirstlane(l_);
    const int tid = tid_, lane = tid & 63, w = tid >> 6;
    int grid_ = gridDim.x; asm volatile("" : "+s"(grid_));
    const int blk = blk_, grid = grid_;
    const int fr = lane & 15, fq = lane >> 4;
    char* const ws = ws_;
    const float* const modl = MOD + (size_t)l * 8 * 6144;
    (void)lane; (void)w; (void)fr; (void)fq; (void)modl; (void)smem; (void)blk; (void)grid;
        g8::StaticOrder S; S.init(T_TOK, 1024, grid, blk);
        Ep8Outproj ep{(l == 0) ? x_in : (const float*)nullptr, XB, PROBE ? XB_LAST : XB_MID(l), modl};
        gemm8<Ep8Outproj, g8::StaticOrder, false>(tid, (LAS unsigned char*)smem, (const char*)MIX, (const char*)(WOUT + (size_t)l * 1024 * 1024), 1024, S, ep, 0u, 0u);
}

__device__ __forceinline__ void ph_norm2(const Params& p, const int l_in, const int own_tile  ) {
    extern __shared__ __attribute__((aligned(16))) char smem[];
    int tid_ = threadIdx.x; asm volatile("" : "+v"(tid_));
    int blk_ = blockIdx.x; asm volatile("" : "+s"(blk_));
    unsigned long long w64_ = (unsigned long long)p.ws; asm volatile("" : "+s"(w64_));
    char* ws_ = (char*)(__attribute__((address_space(1))) char*)w64_;
    int l_ = l_in; asm volatile("" : "+v"(l_)); const int l = __builtin_amdgcn_readfirstlane(l_);
    const int tid = tid_, lane = tid & 63, w = tid >> 6;
    int grid_ = gridDim.x; asm volatile("" : "+s"(grid_));
    const int blk = blk_, grid = grid_;
    const int fr = lane & 15, fq = lane >> 4;
    char* const ws = ws_;
    const float* const modl = MOD + (size_t)l * 8 * 6144;
    (void)lane; (void)w; (void)fr; (void)fq; (void)modl; (void)smem; (void)blk; (void)grid;
        const float* gn = INP(5) + l * 1024;
        const int gw = blk * 8 + w, nw = grid * 8;
        for (int r0 = (own_tile >= 0 ? own_tile * 256 + w * 32 : gw * 32); r0 < (own_tile >= 0 ? own_tile * 256 + w * 32 + 32 : T_TOK); r0 += nw * 32) {
            const int b = r0 >> 13;
            float gs[16], sh[16];
    #pragma unroll
            for (int j = 0; j < 4; ++j) {
                const int c = j * 256 + lane * 4;
                const float4 g4 = *(const float4*)(gn + c);
                const float4 sc4 = *(const float4*)(modl + b * 6144 + 4 * 1024 + c);
                const float4 sh4 = *(const float4*)(modl + b * 6144 + 3 * 1024 + c);
                gs[j * 4 + 0] = g4.x * (1.f + sc4.x); gs[j * 4 + 1] = g4.y * (1.f + sc4.y); gs[j * 4 + 2] = g4.z * (1.f + sc4.z); gs[j * 4 + 3] = g4.w * (1.f + sc4.w);
                sh[j * 4 + 0] = sh4.x; sh[j * 4 + 1] = sh4.y; sh[j * 4 + 2] = sh4.z; sh[j * 4 + 3] = sh4.w;
            }
            const bf16_t* xsrc = XB_MID(l);
            u32x2 cur[4][4], nxt[4][4];
    #pragma unroll
            for (int q = 0; q < 4; ++q)
    #pragma unroll
                for (int j = 0; j < 4; ++j) cur[q][j] = *(const u32x2*)(xsrc + (size_t)(r0 + q) * 1024 + j * 256 + lane * 4);
            for (int rg = r0; rg < r0 + 32; rg += 4) {
                const int rn = (rg + 4 < r0 + 32) ? rg + 4 : rg;
    #pragma unroll
                for (int q = 0; q < 4; ++q)
    #pragma unroll
                    for (int j = 0; j < 4; ++j) nxt[q][j] = *(const u32x2*)(xsrc + (size_t)(rn + q) * 1024 + j * 256 + lane * 4);
    #pragma unroll
                for (int q = 0; q < 4; ++q) {
                    const int r = rg + q;
                    float xv[16]; float ss = 0.f;
    #pragma unroll
                    for (int j = 0; j < 4; ++j) {
                        const u32x2 xb = cur[q][j];
                        const float4 v = make_float4(bflo(xb.x), bfhi(xb.x), bflo(xb.y), bfhi(xb.y));
                        xv[j * 4 + 0] = v.x; xv[j * 4 + 1] = v.y; xv[j * 4 + 2] = v.z; xv[j * 4 + 3] = v.w;
                        ss += v.x * v.x + v.y * v.y + v.z * v.z + v.w * v.w;
                    }
                    ss = wave_sum(ss);
                    const float rs = rsqrtf(ss * (1.0f / 1024.0f) + 1e-6f);
    #pragma unroll
                    for (int j = 0; j < 4; ++j) {
                        const int c = j * 256 + lane * 4;
                        u32x2 o;
                        o.x = pk2(xv[j * 4 + 0] * rs * gs[j * 4 + 0] + sh[j * 4 + 0], xv[j * 4 + 1] * rs * gs[j * 4 + 1] + sh[j * 4 + 1]);
                        o.y = pk2(xv[j * 4 + 2] * rs * gs[j * 4 + 2] + sh[j * 4 + 2], xv[j * 4 + 3] * rs * gs[j * 4 + 3] + sh[j * 4 + 3]);
                        *(u32x2*)(Hb + (size_t)r * 1024 + c) = o;
                    }
                }
    #pragma unroll
                for (int q = 0; q < 4; ++q)
    #pragma unroll
                    for (int j = 0; j < 4; ++j) cur[q][j] = nxt[q][j];
            }
        }
        for (int i = blk * 512 + tid; i < MAXROWS; i += grid * 512) ROWTOK[i] = -1;
}

__device__ __forceinline__ void ph_router(const Params& p, const int l_in, const int own_tile) {
    extern __shared__ __attribute__((aligned(16))) char smem[];
    int tid_ = threadIdx.x; asm volatile("" : "+v"(tid_));
    int blk_ = blockIdx.x; asm volatile("" : "+s"(blk_));
    unsigned long long w64_ = (unsigned long long)p.ws; asm volatile("" : "+s"(w64_));
    char* ws_ = (char*)(__attribute__((address_space(1))) char*)w64_;
    int l_ = l_in; asm volatile("" : "+v"(l_)); const int l = __builtin_amdgcn_readfirstlane(l_);
    const int tid = tid_, lane = tid & 63, w = tid >> 6;
    int grid_ = gridDim.x; asm volatile("" : "+s"(grid_));
    const int blk = blk_, grid = grid_;
    const int fr = lane & 15, fq = lane >> 4;
    char* const ws = ws_;
    const float* const modl = MOD + (size_t)l * 8 * 6144;
    (void)lane; (void)w; (void)fr; (void)fq; (void)modl; (void)smem; (void)blk; (void)grid;
        Ep8Logit ep{LOGIT};
        if (own_tile >= 0) { g8::OneUnit S{own_tile}; gemm8<Ep8Logit, g8::OneUnit, false>(tid, (LAS unsigned char*)smem, (const char*)Hb, (const char*)(ROUTW + (size_t)l * RT_ROWS * 1024), 1024, S, ep, 0u, 0u); }
        else { g8::StaticOrder S; S.init(T_TOK, RT_ROWS, grid, blk); gemm8<Ep8Logit, g8::StaticOrder, false>(tid, (LAS unsigned char*)smem, (const char*)Hb, (const char*)(ROUTW + (size_t)l * RT_ROWS * 1024), 1024, S, ep, 0u, 0u); }
}

__device__ __forceinline__ void ph_route1(const Params& p, const int l_in, const int own_tile) {
    extern __shared__ __attribute__((aligned(16))) char smem[];
    int tid_ = threadIdx.x; asm volatile("" : "+v"(tid_));
    int blk_ = blockIdx.x; asm volatile("" : "+s"(blk_));
    unsigned long long w64_ = (unsigned long long)p.ws; asm volatile("" : "+s"(w64_));
    char* ws_ = (char*)(__attribute__((address_space(1))) char*)w64_;
    int l_ = l_in; asm volatile("" : "+v"(l_)); const int l = __builtin_amdgcn_readfirstlane(l_);
    const int tid = tid_, lane = tid & 63, w = tid >> 6;
    int grid_ = gridDim.x; asm volatile("" : "+s"(grid_));
    const int blk = blk_, grid = grid_;
    const int fr = lane & 15, fq = lane >> 4;
    char* const ws = ws_;
    const float* const modl = MOD + (size_t)l * 8 * 6144;
    (void)lane; (void)w; (void)fr; (void)fq; (void)modl; (void)smem; (void)blk; (void)grid;
        const float* bg = INP(29) + l * 8; const float* br = INP(31) + l * 64;
        for (int c = (own_tile >= 0 ? own_tile : blk); c < (own_tile >= 0 ? own_tile + 1 : 256); c += grid) {
            int e0 = 0, e1 = 0; float g0 = 0.f, g1 = 0.f;
            const int t = c * 256 + tid;
            if (tid < 256) {
                const float* lg = LOGIT + (size_t)t * 80;
                float gl[8]; float mx = -3.0e38f; int gs = 0;
    #pragma unroll
                for (int i = 0; i < 8; ++i) { gl[i] = lg[i] + bg[i]; if (gl[i] > mx) { mx = gl[i]; gs = i; } }
                float den = 0.f;
    #pragma unroll
                for (int i = 0; i < 8; ++i) den += fexp_(gl[i] - mx);
                const float pg = 1.0f / den;
                float v1 = -3.0e38f, v2 = -3.0e38f; int i1 = 0, i2 = 0;
                for (int i = 0; i < 8; ++i) {
                    const float v = lg[8 + gs * 8 + i] + br[gs * 8 + i];
                    if (v > v1) { v2 = v1; i2 = i1; v1 = v; i1 = i; } else if (v > v2) { v2 = v; i2 = i; }
                }
                const float q1 = 1.0f / (1.0f + fexp_(v2 - v1));
                g0 = q1 * pg; g1 = (1.0f - q1) * pg;
                e0 = gs * 8 + i1; e1 = gs * 8 + i2;
            }
            unsigned r0 = 0, r1 = 0;
            unsigned* WC = (unsigned*)(smem + 2048);
            if (tid < 256) {
                const unsigned long long lower = (1ull << lane) - 1ull;
                for (int e = 0; e < 64; ++e) {
                    const unsigned long long m0 = __ballot(e0 == e), m1 = __ballot(e1 == e);
                    const unsigned below = (unsigned)__popcll(m0 & lower) + (unsigned)__popcll(m1 & lower);
                    if (e0 == e) r0 = below;
                    if (e1 == e) r1 = below;
                    if (lane == 0) WC[w * 64 + e] = (unsigned)__popcll(m0) + (unsigned)__popcll(m1);
                }
            }
            __syncthreads();
            if (tid < 256) {
                for (int ww = 0; ww < w; ++ww) { r0 += WC[ww * 64 + e0]; r1 += WC[ww * 64 + e1]; }
                TOKINF[t] = make_uint4((unsigned)e0 | ((unsigned)e1 << 8), __float_as_uint(g0), __float_as_uint(g1), r0 | (r1 << 16));
            }
            if (tid < 64) CBASE[c * 64 + tid] = WC[tid] + WC[64 + tid] + WC[128 + tid] + WC[192 + tid];
            __syncthreads();
        }
}

__device__ __forceinline__ void ph_route2(const Params& p, const int l_in) {
    extern __shared__ __attribute__((aligned(16))) char smem[];
    int tid_ = threadIdx.x; asm volatile("" : "+v"(tid_));
    int blk_ = blockIdx.x; asm volatile("" : "+s"(blk_));
    unsigned long long w64_ = (unsigned long long)p.ws; asm volatile("" : "+s"(w64_));
    char* ws_ = (char*)(__attribute__((address_space(1))) char*)w64_;
    int l_ = l_in; asm volatile("" : "+v"(l_)); const int l = __builtin_amdgcn_readfirstlane(l_);
    const int tid = tid_, lane = tid & 63, w = tid >> 6;
    int grid_ = gridDim.x; asm volatile("" : "+s"(grid_));
    const int blk = blk_, grid = grid_;
    const int fr = lane & 15, fq = lane >> 4;
    char* const ws = ws_;
    const float* const modl = MOD + (size_t)l * 8 * 6144;
    (void)lane; (void)w; (void)fr; (void)fq; (void)modl; (void)smem; (void)blk; (void)grid;
        unsigned* pst = (unsigned*)smem;
        unsigned* tot = pst + 80;
        unsigned* PRE = pst + 256;
        {
            unsigned* PS = pst + 256 + 256 * 64;
            const int e = tid & 63, part = tid >> 6;
            unsigned cv[32]; unsigned s = 0;
    #pragma unroll
            for (int i = 0; i < 32; ++i) { cv[i] = CBASE[(part * 32 + i) * 64 + e]; }
    #pragma unroll
            for (int i = 0; i < 32; ++i) s += cv[i];
            PS[part * 64 + e] = s;
            __syncthreads();
            if (tid < 64) { unsigned a = 0; for (int q = 0; q < 8; ++q) a += PS[q * 64 + tid]; tot[tid] = a; }
            for (int c = blk; c < 256; c += grid) {
                const int cp = c >> 5, ci = c & 31;
                if (part == cp) {
                    unsigned a = 0;
                    for (int q = 0; q < cp; ++q) a += PS[q * 64 + e];
    #pragma unroll
                    for (int i = 0; i < 32; ++i) a += (i < ci) ? cv[i] : 0u;
                    PRE[c * 64 + e] = a;
                }
            }
        }
        __syncthreads();
        if (tid == 0) {
            unsigned run = 0;
            for (int e = 0; e < 64; ++e) { pst[e] = run; run += (tot[e] + 255u) & ~255u; }
            pst[64] = run;
        }
        __syncthreads();
        if (blk == 0) {
            if (tid < 64) { for (unsigned tl = pst[tid] >> 8; tl < (pst[tid + 1] >> 8); ++tl) TILEE[tl] = tid; }
            if (tid == 0) TILEE[1023] = (int)(pst[64] >> 8);
        }
        for (int c = blk; c < 256; c += grid) {
            if (tid < 256) {
                const int t = c * 256 + tid;
                const uint4 ti = TOKINF[t];
                const int e0 = ti.x & 255, e1 = (ti.x >> 8) & 255;
                const unsigned r0 = pst[e0] + PRE[c * 64 + e0] + (ti.w & 0xffffu);
                const unsigned r1 = pst[e1] + PRE[c * 64 + e1] + (ti.w >> 16);
                ROWTOK[r0] = t * 2; ROWG[r0] = __uint_as_float(ti.y);
                ROWTOK[r1] = t * 2 + 1; ROWG[r1] = __uint_as_float(ti.z);
            }
        }
        __syncthreads();
}

__device__ __forceinline__ void ph_moe1(const Params& p, const int l_in) {
    extern __shared__ __attribute__((aligned(16))) char smem[];
    int tid_ = threadIdx.x; asm volatile("" : "+v"(tid_));
    int blk_ = blockIdx.x; asm volatile("" : "+s"(blk_));
    unsigned long long w64_ = (unsigned long long)p.ws; asm volatile("" : "+s"(w64_));
    char* ws_ = (char*)(__attribute__((address_space(1))) char*)w64_;
    int l_ = l_in; asm volatile("" : "+v"(l_)); const int l = __builtin_amdgcn_readfirstlane(l_);
    const int tid = tid_, lane = tid & 63, w = tid >> 6;
    int grid_ = gridDim.x; asm volatile("" : "+s"(grid_));
    const int blk = blk_, grid = grid_;
    const int fr = lane & 15, fq = lane >> 4;
    char* const ws = ws_;
    const float* const modl = MOD + (size_t)l * 8 * 6144;
    (void)lane; (void)w; (void)fr; (void)fq; (void)modl; (void)smem; (void)blk; (void)grid;
        g8::MoeOrder<2> S; S.ntiles = TILEE[1023]; S.x = blk & 7; S.j = blk >> 3; S.nj = (grid - S.x + 7) >> 3; S.tile_e = TILEE; S.rowtok = ROWTOK; S.prime(lane);
        Ep8Moe1 ep{HID};
        gemm8<Ep8Moe1, g8::MoeOrder<2>, true>(tid, (LAS unsigned char*)smem, (const char*)ws, (const char*)WGU, 1024, S, ep, (unsigned)OFF_H, (unsigned)(OFF_WIN + (size_t)PWV * 1024 * 2));
}

template <int LINEAR = 0>
__device__ __forceinline__ void ph_moe2(const Params& p, const int l_in) {
    extern __shared__ __attribute__((aligned(16))) char smem[];
    int tid_ = threadIdx.x; asm volatile("" : "+v"(tid_));
    int blk_ = blockIdx.x; asm volatile("" : "+s"(blk_));
    unsigned long long w64_ = (unsigned long long)p.ws; asm volatile("" : "+s"(w64_));
    char* ws_ = (char*)(__attribute__((address_space(1))) char*)w64_;
    int l_ = l_in; asm volatile("" : "+v"(l_)); const int l = __builtin_amdgcn_readfirstlane(l_);
    const int tid = tid_, lane = tid & 63, w = tid >> 6;
    int grid_ = gridDim.x; asm volatile("" : "+s"(grid_));
    const int blk = blk_, grid = grid_;
    const int fr = lane & 15, fq = lane >> 4;
    char* const ws = ws_;
    const float* const modl = MOD + (size_t)l * 8 * 6144;
    (void)lane; (void)w; (void)fr; (void)fq; (void)modl; (void)smem; (void)blk; (void)grid;
        g8::MoeOrder<4> S; S.ntiles = TILEE[1023]; S.x = blk & 7; S.j = blk >> 3; S.nj = (grid - S.x + 7) >> 3; S.tile_e = TILEE; S.rowtok = ROWTOK; S.prime(lane);
        Ep8Moe2<LINEAR> ep{YB, ROWTOK, ROWG};
        gemm8<Ep8Moe2<LINEAR>, g8::MoeOrder<4>, false>(tid, (LAS unsigned char*)smem, (const char*)HID, (const char*)WD, 256, S, ep, 0u, 0u);
}

__device__ __forceinline__ void ph_prologue(const Params& p, const int l_in) {
    extern __shared__ __attribute__((aligned(16))) char smem[];
    int tid_ = threadIdx.x; asm volatile("" : "+v"(tid_));
    int blk_ = blockIdx.x; asm volatile("" : "+s"(blk_));
    unsigned long long w64_ = (unsigned long long)p.ws;
    char* ws_ = (char*)(__attribute__((address_space(1))) char*)w64_;
    int l_ = l_in; asm volatile("" : "+v"(l_)); const int l = __builtin_amdgcn_readfirstlane(l_);
    const int tid = tid_, lane = tid & 63, w = tid >> 6;
    int grid_ = gridDim.x; asm volatile("" : "+s"(grid_));
    const int blk = blk_, grid = grid_;
    const int fr = lane & 15, fq = lane >> 4;
    char* const ws = ws_;
    const float* const modl = MOD + (size_t)l * 8 * 6144;
    (void)lane; (void)w; (void)fr; (void)fq; (void)modl; (void)smem; (void)blk; (void)grid;
        {
            float* cact = (float*)smem;
            float* red = (float*)(smem + 32768);
            for (int i = tid; i < 8192; i += 512) { const float c = INP(1)[i]; cact[i] = siluf_(c); }
            __syncthreads();
            const int ol = tid & 63, ks = tid >> 6;
            for (int g = blk; g < 384; g += grid) {
                const int gid = g * 64 + ol; const int l = gid / 6144, n = gid % 6144;
                const float* wp = INP(2) + (size_t)l * 1024 * 6144 + (size_t)(ks * 128) * 6144 + n;
                float acc[8];
    #pragma unroll
                for (int b = 0; b < 8; ++b) acc[b] = 0.f;
    #pragma unroll 8
                for (int k = 0; k < 128; ++k) {
                    const float wv = wp[(size_t)k * 6144];
    #pragma unroll
                    for (int b = 0; b < 8; ++b) acc[b] += cact[b * 1024 + ks * 128 + k] * wv;
                }
    #pragma unroll
                for (int b = 0; b < 8; ++b) red[(ks * 8 + b) * 64 + ol] = acc[b];
                __syncthreads();
                {
                    const int b = tid >> 6;
                    float s = 0.f;
    #pragma unroll
                    for (int q = 0; q < 8; ++q) s += red[(q * 8 + b) * 64 + ol];
                    MOD[(size_t)(l * 8 + b) * 6144 + n] = s + INP(3)[l * 6144 + n];
                }
                __syncthreads();
            }
        }
        float* tile = (float*)smem;
        for (int jb = blk; jb < 4608; jb += grid) {
            int j = jb;
            if (j < 3392) { const int l = j / 848, r = j % 848, kt = r / 53, nt = r % 53;
                tr_tile(tid, tile, INP(6) + (size_t)l * 1024 * 3336, 3336, kt * 64, nt * 64, 3336, WIN + (size_t)l * WIN_ROWS * 1024, 1024, RmWin()); continue; }
            j -= 3392;
            if (j < 1024) { const int l = j >> 8, r = j & 255, kt = r >> 4, nt = r & 15;
                tr_tile(tid, tile, INP(7) + (size_t)l * 1024 * 1024, 1024, kt * 64, nt * 64, 1024, WOUT + (size_t)l * 1024 * 1024, 1024, RmId()); continue; }
            j -= 1024;
            if (j < 16) { const int l = j >> 2, nt = j & 3;
                tr_tile(tid, tile, INP(19) + (size_t)l * 64 * 256, 256, 0, nt * 64, 256, LWU + (size_t)l * 256 * 64, 64, RmId()); continue; }
            j -= 16;
            if (j < 16) { const int l = j >> 2, nt = j & 3;
                tr_tile(tid, tile, INP(21) + (size_t)l * 64 * 256, 256, 0, nt * 64, 256, LAU + (size_t)l * 256 * 64, 64, RmId()); continue; }
            j -= 16;
            if (j < 32) { const int l = j >> 3, r = j & 7, kt = r >> 2, nt = r & 3;
                tr_tile(tid, tile, INP(22) + (size_t)l * 128 * 256, 256, kt * 64, nt * 64, 256, LGU + (size_t)l * 256 * 128, 128, RmId()); continue; }
            j -= 32;
            if (j < 64) { const int l = j >> 4, kt = j & 15;
                tr_tile(tid, tile, INP(30) + (size_t)l * 1024 * 64, 64, kt * 64, 0, 64, ROUTW + (size_t)l * RT_ROWS * 1024, 1024, RmOff{8}); continue; }
            j -= 64;
            { const int l = j >> 4, kt = j & 15;
                tr_tile(tid, tile, INP(28) + (size_t)l * 1024 * 8, 8, kt * 64, 0, 8, ROUTW + (size_t)l * RT_ROWS * 1024, 1024, RmId()); }
        }
        const int gt = blk * 512 + tid, ngt = grid * 512;
        for (int i = gt; i < 4 * (WIN_ROWS - PWV) * 128; i += ngt) { const int l = i / ((WIN_ROWS - PWV) * 128), r = i % ((WIN_ROWS - PWV) * 128); *(u32x4*)(WIN + ((size_t)l * WIN_ROWS + PWV) * 1024 + (size_t)r * 8) = (u32x4){0u, 0u, 0u, 0u}; }
        for (int i = gt; i < 4 * (RT_ROWS - 72) * 128; i += ngt) { const int l = i / ((RT_ROWS - 72) * 128), r = i % ((RT_ROWS - 72) * 128); *(u32x4*)(ROUTW + ((size_t)l * RT_ROWS + 72) * 1024 + (size_t)r * 8) = (u32x4){0u, 0u, 0u, 0u}; }
        for (int i = gt; i < 4 * 4 * 128 * 128; i += ngt) { const int s = i & 127, t = (i >> 7) & 127; SGUW[i] = (s <= t) ? f2bf(INP(14)[i]) : (bf16_t)0; }
        for (int i = gt; i < 4 * 8 * 1024; i += ngt) { const int l = i >> 13, j = (i >> 10) & 7, k = i & 1023; GW[i] = INP(6)[((size_t)l * 1024 + k) * 3336 + 1024 + j]; }
}

__device__ __forceinline__ void ph_final(const Params& p, const int l_in) {
    extern __shared__ __attribute__((aligned(16))) char smem[];
    int tid_ = threadIdx.x; asm volatile("" : "+v"(tid_));
    int blk_ = blockIdx.x; asm volatile("" : "+s"(blk_));
    unsigned long long w64_ = (unsigned long long)p.ws; asm volatile("" : "+s"(w64_));
    char* ws_ = (char*)(__attribute__((address_space(1))) char*)w64_;
    int l_ = l_in; asm volatile("" : "+v"(l_)); const int l = __builtin_amdgcn_readfirstlane(l_);
    const int tid = tid_, lane = tid & 63, w = tid >> 6;
    int grid_ = gridDim.x; asm volatile("" : "+s"(grid_));
    const int blk = blk_, grid = grid_;
    const int fr = lane & 15, fq = lane >> 4;
    char* const ws = ws_;
    const float* const modl = MOD + (size_t)l * 8 * 6144;
    (void)lane; (void)w; (void)fr; (void)fq; (void)modl; (void)smem; (void)blk; (void)grid;
        const float* gn = INP(35);
        const float* modp = MOD + (size_t)(NLAYER - 1) * 8 * 6144;
        const int gw = blk * 8 + w, nw = grid * 8;
        for (int r0 = gw * 32; r0 < T_TOK; r0 += nw * 32) {
            const int b = r0 >> 13;
            float gs[16], gf[16];
    #pragma unroll
            for (int j = 0; j < 4; ++j) {
                const int c = j * 256 + lane * 4;
                const float4 g4 = *(const float4*)(gn + c);
                const float4 f4 = *(const float4*)(modp + b * 6144 + 5 * 1024 + c);
                gs[j * 4 + 0] = g4.x; gs[j * 4 + 1] = g4.y; gs[j * 4 + 2] = g4.z; gs[j * 4 + 3] = g4.w;
                gf[j * 4 + 0] = f4.x; gf[j * 4 + 1] = f4.y; gf[j * 4 + 2] = f4.z; gf[j * 4 + 3] = f4.w;
            }
            u32x2 cxb[4], cy0[4], cy1[4];
    #pragma unroll
            for (int j = 0; j < 4; ++j) { const size_t o_ = (size_t)r0 * 1024 + j * 256 + lane * 4; cxb[j] = *(const u32x2*)(XB_LAST + o_); cy0[j] = __builtin_nontemporal_load((const u32x2*)(YB + o_)); cy1[j] = __builtin_nontemporal_load((const u32x2*)(YB + (size_t)T_TOK * 1024 + o_)); }
            for (int r = r0; r < r0 + 32; ++r) {
                float xv[16]; float ss = 0.f;
                u32x2 nxb[4], ny0[4], ny1[4];
                {
                    const int rn = (r + 1 < r0 + 32) ? r + 1 : r;
    #pragma unroll
                    for (int j = 0; j < 4; ++j) { const size_t o_ = (size_t)rn * 1024 + j * 256 + lane * 4; nxb[j] = *(const u32x2*)(XB_LAST + o_); ny0[j] = __builtin_nontemporal_load((const u32x2*)(YB + o_)); ny1[j] = __builtin_nontemporal_load((const u32x2*)(YB + (size_t)T_TOK * 1024 + o_)); }
                }
    #pragma unroll
                for (int j = 0; j < 4; ++j) {
                    const int c = j * 256 + lane * 4;
                    const u32x2 xb = cxb[j];
                    float4 v = make_float4(bflo(xb.x), bfhi(xb.x), bflo(xb.y), bfhi(xb.y));
#if !DBG_NO_MOE
                    const u32x2 y0 = cy0[j];
                    const u32x2 y1 = cy1[j];
                    v.x += gf[j * 4 + 0] * (bflo(y0.x) + bflo(y1.x)); v.y += gf[j * 4 + 1] * (bfhi(y0.x) + bfhi(y1.x));
                    v.z += gf[j * 4 + 2] * (bflo(y0.y) + bflo(y1.y)); v.w += gf[j * 4 + 3] * (bfhi(y0.y) + bfhi(y1.y));
#endif
                    xv[j * 4 + 0] = v.x; xv[j * 4 + 1] = v.y; xv[j * 4 + 2] = v.z; xv[j * 4 + 3] = v.w;
                    ss += v.x * v.x + v.y * v.y + v.z * v.z + v.w * v.w;
                }
                ss = wave_sum(ss);
                const float rs = rsqrtf(ss * (1.0f / 1024.0f) + 1e-6f);
    #pragma unroll
                for (int j = 0; j < 4; ++j) {
                    const int c = j * 256 + lane * 4;
                    float* dstp = xo + (size_t)r * 1024 + c;
                    { const f32x4 ov_ = {xv[j * 4 + 0] * rs * gs[j * 4 + 0], xv[j * 4 + 1] * rs * gs[j * 4 + 1], xv[j * 4 + 2] * rs * gs[j * 4 + 2], xv[j * 4 + 3] * rs * gs[j * 4 + 3]};
                      __builtin_nontemporal_store(ov_, (f32x4*)dstp); }
                }
    #pragma unroll
                for (int j = 0; j < 4; ++j) { cxb[j] = nxb[j]; cy0[j] = ny0[j]; cy1[j] = ny1[j]; }
            }
        }
}

#ifdef TEST_PHASE
#define TK(name) __global__ void __launch_bounds__(512, 2) tk_##name(Params p, int l) { ph_##name(p, l); }
TK(prologue) TK(norm1) TK(inproj) TK(post) TK(outproj) TK(route2) TK(moe1) TK(final)
#endif

__global__ void __launch_bounds__(512, 2) mega(Params p) {
    extern __shared__ __attribute__((aligned(16))) char smem_all[];
    if (threadIdx.x == 0) *(uint4*)(smem_all + LDS_XB_OFF) = make_uint4(0u, 0u, 0u, 0u);
    __syncthreads();
    XcdBarrier bar = xcd_barrier_post((unsigned*)(p.ws + OFF_BAR), (volatile LAS unsigned*)(smem_all + LDS_XB_OFF));
    ph_prologue(p, 0);
    xcd_barrier(bar);
    if (TIME_DUP == 11) { ph_prologue(p, 0); xcd_barrier(bar); ph_prologue(p, 0); xcd_barrier(bar); ph_prologue(p, 0); xcd_barrier(bar); ph_prologue(p, 0); xcd_barrier(bar); }
    for (int l = 0; l < NLAYER; ++l) {
        ph_norm1(p, l);   xcd_barrier(bar);
        ph_inproj(p, l);  xcd_barrier(bar);
        if (TIME_DUP == 1) { ph_inproj(p, l);  xcd_barrier(bar); }
        if (TIME_DUP == 32) { ph_inproj<1>(p, l);  xcd_barrier(bar); }
        if (TIME_DUP == 30) { xcd_barrier(bar); xcd_barrier(bar); xcd_barrier(bar); xcd_barrier(bar); }
#if !DBG_NO_RWKV
        ph_rwprep(p, l, gridDim.x == 256 ? 0 : 2);
#endif
        if (TIME_DUP == 7) ph_gdn1(p, l, blockIdx.x, gridDim.x, 4096);
        if (GDN_U1 > 0 && !DBG_NO_GDN) ph_gdn1(p, l, blockIdx.x, gridDim.x, GDN_U1);
        xcd_barrier(bar);
        if (TIME_DUP == 8) { ph_rwprep(p, l); xcd_barrier(bar); }
        if (TIME_DUP == 19) { ph_rwprep<1>(p, l); xcd_barrier(bar); }
        ph_scan<0>(p, l);    xcd_barrier(bar);
        if (TIME_DUP == 3) { ph_scan<0>(p, l);    xcd_barrier(bar); }
        if (TIME_DUP == 9) { ph_scan<1>(p, l);    xcd_barrier(bar); }
        if (TIME_DUP == 10) { ph_scan<2>(p, l);    xcd_barrier(bar); }
        if (TIME_DUP == 20) { ph_scan<3>(p, l);    xcd_barrier(bar); }
        if (TIME_DUP == 21) { ph_scan<4>(p, l);    xcd_barrier(bar); }
        if (TIME_DUP == 22) { ph_scan<5>(p, l);    xcd_barrier(bar); }
        if (TIME_DUP == 23) { ph_scan<6>(p, l);    xcd_barrier(bar); }
        if (TIME_DUP == 24) { ph_scan<7>(p, l);    xcd_barrier(bar); }
        if (TIME_DUP == 25) { ph_scan<8>(p, l);    xcd_barrier(bar); }
        if (TIME_DUP == 26) { ph_scan<9>(p, l);    xcd_barrier(bar); }
        if (TIME_DUP == 27) { ph_scan<10>(p, l);    xcd_barrier(bar); }
        ph_post(p, l);    xcd_barrier(bar);
        ph_outproj(p, l); xcd_barrier(bar);
        if (TIME_DUP == 31) { ph_outproj<1>(p, l); xcd_barrier(bar); }
#if !DBG_NO_MOE
        if (gridDim.x == 256) {
            const int own = ((int)blockIdx.x & 7) * 32 + ((int)blockIdx.x >> 3);
            ph_norm2(p, l, own);
            asm volatile("s_waitcnt vmcnt(0)" ::: "memory"); __syncthreads();
            ph_router(p, l, own);
            asm volatile("s_waitcnt vmcnt(0)" ::: "memory"); __syncthreads();
            ph_route1(p, l, own);  xcd_barrier(bar);
        } else {
            ph_norm2(p, l, -1);   xcd_barrier(bar);
            ph_router(p, l, -1);  xcd_barrier(bar);
            ph_route1(p, l, -1);  xcd_barrier(bar);
        }
        if (TIME_DUP == 6) { ph_norm2(p, l, -1);   xcd_barrier(bar); }
        ph_route2(p, l);  xcd_barrier(bar);
        if (TIME_DUP == 5) { ph_router(p, l, -1);  xcd_barrier(bar); ph_route1(p, l, -1);  xcd_barrier(bar); ph_route2(p, l);  xcd_barrier(bar); }
        ph_moe1(p, l);    xcd_barrier(bar);
        if (TIME_DUP == 17) { ph_moe2<1>(p, l);    xcd_barrier(bar); }
        ph_moe2(p, l);    xcd_barrier(bar);
        if (TIME_DUP == 4) { ph_moe1(p, l);    xcd_barrier(bar); ph_moe2(p, l);    xcd_barrier(bar); }
        if (TIME_DUP == 15) { ph_moe1(p, l);    xcd_barrier(bar); }
        if (TIME_DUP == 16) { ph_moe2(p, l);    xcd_barrier(bar); }
#endif
    }
    ph_final(p, 0);
}


extern "C" void kernel_launch(void* const* d_in, const int* in_sizes, int n_in,
                              void* d_out, int out_size, void* d_ws, size_t ws_size,
                              hipStream_t stream) {
    static int grid = 0;
    if (!grid) {
        int dev = 0, cus = 0, per_cu = 0;
        hipGetDevice(&dev);
        hipDeviceGetAttribute(&cus, hipDeviceAttributeMultiprocessorCount, dev);
        hipFuncSetAttribute((const void*)mega, hipFuncAttributeMaxDynamicSharedMemorySize, LDS_BYTES);
        hipOccupancyMaxActiveBlocksPerMultiprocessor(&per_cu, mega, 512, LDS_BYTES);
        grid = (per_cu >= 1 && cus >= 192) ? cus : 0;
    }
    if (grid <= 0 || n_in < 36 || ws_size < WS_NEED) { fprintf(stderr, "kernel_launch: cannot launch (grid %d, ws %zu need %zu)\n", grid, ws_size, (size_t)WS_NEED); return; }
    hipMemsetAsync(d_ws, 0, ZERO_BYTES, stream);
    Params p{};
    for (int i = 0; i < 36; ++i) p.in[i] = (const float*)d_in[i];
    p.out = (float*)d_out;
    p.ws = (char*)d_ws;
    hipLaunchKernelGGL(mega, dim3(grid), dim3(512), LDS_BYTES, stream, p);
}
```
